# Optimizing an MI355X kernel written in HIP

```python
import math
import jax, jax.numpy as jnp
from jax import lax
import numpy as np

D_MODEL = 1024
BATCH = 8
SEQ = 2048
DEPTH = 2

N_GROUPS = 4
GROUP_WIDTH = D_MODEL // N_GROUPS
HEAD_DIM = 64
GROUP_HEADS = GROUP_WIDTH // HEAD_DIM
CONV_CH = GROUP_WIDTH
CONV_WIDTH = 3
NSA_HEADS = GROUP_HEADS
CMP_LEN = 32
CMP_STRIDE = 16
SLC_LEN = 64
N_SLC = 16
WINDOW = 512
CMP_HIDDEN = GROUP_WIDTH
MLA_HEADS = GROUP_HEADS
Q_LORA = 3 * GROUP_WIDTH // 4
KV_LORA = GROUP_WIDTH // 2
NOPE_DIM = HEAD_DIM
ROPE_DIM = HEAD_DIM // 2
V_DIM = HEAD_DIM
ROPE_THETA = 10000.0
SB_HEADS = GROUP_HEADS
N_BUCKETS = 32
MAX_DISTANCE = 128
D_FF = 4 * D_MODEL
Q_BLOCK = 128
EPS = 1e-6

A_SIZES = [CONV_CH] * 3
NSA_SIZES = [NSA_HEADS * HEAD_DIM] + [HEAD_DIM] * 6 + [3 * NSA_HEADS]
MLA_SIZES = [Q_LORA, KV_LORA, ROPE_DIM]
SB_SIZES = [SB_HEADS * HEAD_DIM] * 3
IN_SIZES = A_SIZES + NSA_SIZES + MLA_SIZES + SB_SIZES
IN_COLS = sum(IN_SIZES)

kernel_name = "hymba_style_conv_nsa_mla_stickbreaking_hybrid"

f32 = jnp.float32


def rms_norm(x, w):
    x32 = x.astype(f32)
    y = x32 * lax.rsqrt(jnp.mean(x32 * x32, axis=-1, keepdims=True) + EPS)
    return (y * w.astype(f32)).astype(x.dtype)


def masked_softmax(logits, mask):
    logits = jnp.where(mask, logits, -jnp.inf)
    m = jnp.max(logits, axis=-1, keepdims=True)
    m = jnp.where(jnp.isfinite(m), m, 0.0)
    p = jnp.exp(logits - m)
    s = jnp.sum(p, axis=-1, keepdims=True)
    return p / jnp.where(s > 0, s, 1.0)


def t5_bucket(dist):
    max_exact = N_BUCKETS // 2
    d = jnp.maximum(dist, 0)
    large = max_exact + (jnp.log(jnp.maximum(d, 1).astype(f32) / max_exact)
                         / math.log(MAX_DISTANCE / max_exact) * (N_BUCKETS - max_exact)).astype(jnp.int32)
    large = jnp.minimum(large, N_BUCKETS - 1)
    return jnp.where(d < max_exact, d, large)


def rope_tables(S):
    inv = 1.0 / (ROPE_THETA ** (jnp.arange(0, ROPE_DIM, 2, dtype=f32) / ROPE_DIM))
    ang = jnp.arange(S, dtype=f32)[:, None] * inv[None, :]
    return jnp.cos(ang), jnp.sin(ang)


def apply_rope(x, cos, sin):
    x32 = x.astype(f32)
    x1, x2 = jnp.split(x32, 2, axis=-1)
    c = cos[:, None, :]
    s = sin[:, None, :]
    return jnp.concatenate([x1 * c - x2 * s, x1 * s + x2 * c], axis=-1).astype(x.dtype)


def split_cols(h, sizes):
    return jnp.split(h, np.cumsum(sizes)[:-1].tolist(), axis=-1)


def short_conv_mixer(b_gate, c_gate, u, conv_w, conv_b):
    v = c_gate * u
    y = lax.conv_general_dilated(v, conv_w[:, None, :].astype(v.dtype), window_strides=(1,),
                                 padding=[(CONV_WIDTH - 1, 0)], dimension_numbers=('NWC', 'WIO', 'NWC'),
                                 feature_group_count=v.shape[-1])
    return b_gate * (y + conv_b)


def compress_tokens(kv, cmp_idx, pos, w1, w2):
    B = kv.shape[0]
    blocks = kv[:, cmp_idx] + pos
    hdn = jax.nn.silu(blocks.reshape(B, blocks.shape[1], -1) @ w1)
    return hdn @ w2


def cmp_slc_overlap(n_cmp, n_slc):
    starts = np.arange(n_cmp) * CMP_STRIDE
    ends = starts + CMP_LEN
    s0 = np.arange(n_slc) * SLC_LEN
    s1 = s0 + SLC_LEN
    ov = np.clip(np.minimum(ends[:, None], s1[None]) - np.maximum(starts[:, None], s0[None]), 0, None)
    return (ov / CMP_LEN).astype(np.float32)


def nsa_mixer(q, kc_raw, vc_raw, ks, vs, kw, vw, gate_logits, qn, kn, cmp_pos, cmp_w1, cmp_w2, rel_bias):
    B, S, H, Dh = q.shape
    scale = Dh ** -0.5
    q = rms_norm(q, qn)
    tpos = jnp.arange(S)
    n_cmp = (S - CMP_LEN) // CMP_STRIDE + 1
    cmp_idx = np.arange(n_cmp)[:, None] * CMP_STRIDE + np.arange(CMP_LEN)[None, :]
    kc = rms_norm(compress_tokens(kc_raw, cmp_idx, cmp_pos[0], cmp_w1[0], cmp_w2[0]), kn[0])
    vc = compress_tokens(vc_raw, cmp_idx, cmp_pos[1], cmp_w1[1], cmp_w2[1])
    cmp_end = jnp.arange(n_cmp) * CMP_STRIDE + CMP_LEN - 1
    dist_c = tpos[:, None] - cmp_end[None, :]
    bias_c = rel_bias[t5_bucket(dist_c)].transpose(2, 0, 1)
    logits_c = jnp.einsum('bshd,bnd->bhsn', q, kc).astype(f32) * scale + bias_c
    p_c = masked_softmax(logits_c, dist_c >= 0)
    o_cmp = jnp.einsum('bhsn,bnd->bshd', p_c.astype(vc.dtype), vc)
    n_slc = S // SLC_LEN
    n_sel = min(N_SLC, n_slc)
    score = jnp.einsum('bhsn,nj->bsj', p_c, jnp.asarray(cmp_slc_overlap(n_cmp, n_slc)))
    blk = jnp.arange(n_slc)[None, :]
    t_blk = (tpos // SLC_LEN)[:, None]
    valid = blk * SLC_LEN <= tpos[:, None]
    forced = (blk == 0) | (blk == t_blk) | (blk == t_blk - 1)
    score = jnp.where(forced, jnp.inf, jnp.where(valid, score, -jnp.inf))
    _, sel = lax.top_k(score, n_sel)
    nq = S // Q_BLOCK
    ks_blocks = rms_norm(ks, kn[1]).reshape(B, n_slc, SLC_LEN, Dh)
    vs_blocks = vs.reshape(B, n_slc, SLC_LEN, Dh)
    kw_pad = jnp.pad(rms_norm(kw, kn[2]), ((0, 0), (WINDOW, 0), (0, 0)))
    vw_pad = jnp.pad(vw, ((0, 0), (WINDOW, 0), (0, 0)))
    band = WINDOW + Q_BLOCK
    qi = jnp.arange(Q_BLOCK)
    ki = jnp.arange(band)
    dist_w = qi[:, None] + WINDOW - ki[None, :]
    bias_w = rel_bias[t5_bucket(dist_w)].transpose(2, 0, 1)
    in_window = (dist_w >= 0) & (dist_w < WINDOW)
    bidx = jnp.arange(B)[:, None, None]

    def block(args):
        q_blk, sel_blk, t0 = args
        t_q = t0 + qi
        kg = ks_blocks[bidx, sel_blk]
        vg = vs_blocks[bidx, sel_blk]
        kpos = (sel_blk[..., None] * SLC_LEN + jnp.arange(SLC_LEN)).reshape(B, Q_BLOCK, -1)
        dist_s = t_q[None, :, None] - kpos
        bias_s = rel_bias[t5_bucket(dist_s)].transpose(0, 3, 1, 2)
        logits_s = jnp.einsum('bqhd,bqnkd->bhqnk', q_blk, kg).reshape(B, H, Q_BLOCK, -1).astype(f32) * scale + bias_s
        p_s = masked_softmax(logits_s, (dist_s >= 0)[:, None])
        o_s = jnp.einsum('bhqnk,bqnkd->bqhd', p_s.reshape(B, H, Q_BLOCK, n_sel, SLC_LEN).astype(vg.dtype), vg)
        kb = lax.dynamic_slice_in_dim(kw_pad, t0, band, axis=1)
        vb = lax.dynamic_slice_in_dim(vw_pad, t0, band, axis=1)
        mask_w = in_window & (t0 - WINDOW + ki >= 0)[None, :]
        logits_w = jnp.einsum('bqhd,bkd->bhqk', q_blk, kb).astype(f32) * scale + bias_w
        p_w = masked_softmax(logits_w, mask_w)
        o_w = jnp.einsum('bhqk,bkd->bqhd', p_w.astype(vb.dtype), vb)
        return o_s, o_w

    q_blocks = q.reshape(B, nq, Q_BLOCK, H, Dh).swapaxes(0, 1)
    sel_blocks = sel.reshape(B, nq, Q_BLOCK, n_sel).swapaxes(0, 1)
    o_slc, o_win = lax.map(block, (q_blocks, sel_blocks, jnp.arange(nq) * Q_BLOCK))
    o_slc = o_slc.swapaxes(0, 1).reshape(B, S, H, Dh)
    o_win = o_win.swapaxes(0, 1).reshape(B, S, H, Dh)
    g = jax.nn.sigmoid(gate_logits.astype(f32)).reshape(B, S, H, 3).astype(q.dtype)
    out = g[..., 0:1] * o_cmp + g[..., 1:2] * o_slc + g[..., 2:3] * o_win
    return out.reshape(B, S, H * Dh)


def causal_block_attention(q, k, v, scale):
    B, S, H, _ = q.shape
    nq = S // Q_BLOCK
    kpos = jnp.arange(S)

    def one(args):
        q_blk, t0 = args
        logits = jnp.einsum('bqhd,bkhd->bhqk', q_blk, k).astype(f32) * scale
        mask = kpos[None, :] <= (t0 + jnp.arange(Q_BLOCK))[:, None]
        p = masked_softmax(logits, mask)
        return jnp.einsum('bhqk,bkhd->bqhd', p.astype(v.dtype), v)

    qb = q.reshape(B, nq, Q_BLOCK, H, -1).swapaxes(0, 1)
    out = lax.map(one, (qb, jnp.arange(nq) * Q_BLOCK))
    return out.swapaxes(0, 1).reshape(B, S, H, -1)


def mla_mixer(c_q, c_kv, k_rope, qa_norm, kv_norm, wq_b, wkv_b, qn, kn, cos, sin):
    B, S, _ = c_q.shape
    q = (rms_norm(c_q, qa_norm) @ wq_b).reshape(B, S, MLA_HEADS, NOPE_DIM + ROPE_DIM)
    q = jnp.concatenate([q[..., :NOPE_DIM], apply_rope(q[..., NOPE_DIM:], cos, sin)], axis=-1)
    kv = (rms_norm(c_kv, kv_norm) @ wkv_b).reshape(B, S, MLA_HEADS, NOPE_DIM + V_DIM)
    k_nope, v = kv[..., :NOPE_DIM], kv[..., NOPE_DIM:]
    k_r = apply_rope(k_rope[:, :, None, :], cos, sin)
    k = jnp.concatenate([k_nope, jnp.broadcast_to(k_r, (B, S, MLA_HEADS, ROPE_DIM))], axis=-1)
    q = rms_norm(q, qn)
    k = rms_norm(k, kn)
    o = causal_block_attention(q, k, v, (NOPE_DIM + ROPE_DIM) ** -0.5)
    return o.reshape(B, S, MLA_HEADS * V_DIM)


def stick_breaking_mixer(q, k, v):
    B, S, H, Dh = q.shape
    scale = Dh ** -0.5
    nq = S // Q_BLOCK
    kpos = jnp.arange(S)

    def one(args):
        q_blk, t0 = args
        z = jnp.einsum('bqhd,bkhd->bhqk', q_blk, k).astype(f32) * scale
        strict = kpos[None, :] < (t0 + jnp.arange(Q_BLOCK))[:, None]
        log_1m = jnp.where(strict, jax.nn.log_sigmoid(-z), 0.0)
        rem = lax.cumsum(log_1m, axis=3, reverse=True) - log_1m
        a = jnp.where(strict, jnp.exp(jax.nn.log_sigmoid(z) + rem), 0.0)
        return jnp.einsum('bhqk,bkhd->bqhd', a.astype(v.dtype), v)

    qb = q.reshape(B, nq, Q_BLOCK, H, Dh).swapaxes(0, 1)
    out = lax.map(one, (qb, jnp.arange(nq) * Q_BLOCK))
    return out.swapaxes(0, 1).reshape(B, S, H * Dh)


def setup_inputs(seed: int = 0) -> dict:
    key = jax.random.key(seed)
    ks = jax.random.split(key, 24)
    L = DEPTH
    nrm = lambda k, shape, s: jax.random.normal(k, shape, f32) * s
    gain = lambda k, shape: 1.0 + 0.02 * jax.random.normal(k, shape, f32)
    qk_dim = NOPE_DIM + ROPE_DIM
    return {
        "x": jax.random.normal(ks[0], (BATCH, SEQ, D_MODEL), f32),
        "rel_bias": nrm(ks[1], (N_BUCKETS, NSA_HEADS), 0.5),
        "norm1_w": gain(ks[2], (L, D_MODEL)),
        "w_in": nrm(ks[3], (L, D_MODEL, IN_COLS), D_MODEL ** -0.5),
        "conv_w": nrm(ks[4], (L, CONV_WIDTH, CONV_CH), CONV_WIDTH ** -0.5),
        "conv_b": nrm(ks[5], (L, CONV_CH), 0.02),
        "nsa_q_norm": gain(ks[6], (L, HEAD_DIM)),
        "nsa_k_norm": gain(ks[7], (L, 3, HEAD_DIM)),
        "cmp_pos": nrm(ks[8], (L, 2, CMP_LEN, HEAD_DIM), 0.1),
        "cmp_w1": nrm(ks[9], (L, 2, CMP_LEN * HEAD_DIM, CMP_HIDDEN), (CMP_LEN * HEAD_DIM) ** -0.5),
        "cmp_w2": nrm(ks[10], (L, 2, CMP_HIDDEN, HEAD_DIM), CMP_HIDDEN ** -0.5),
        "mla_q_a_norm": gain(ks[11], (L, Q_LORA)),
        "mla_kv_norm": gain(ks[12], (L, KV_LORA)),
        "mla_wq_b": nrm(ks[13], (L, Q_LORA, MLA_HEADS * qk_dim), Q_LORA ** -0.5),
        "mla_wkv_b": nrm(ks[14], (L, KV_LORA, MLA_HEADS * (NOPE_DIM + V_DIM)), KV_LORA ** -0.5),
        "mla_q_norm": gain(ks[15], (L, qk_dim)),
        "mla_k_norm": gain(ks[16], (L, qk_dim)),
        "out_norm_w": gain(ks[17], (L, D_MODEL)),
        "w_out": nrm(ks[18], (L, D_MODEL, D_MODEL), D_MODEL ** -0.5),
        "norm2_w": gain(ks[19], (L, D_MODEL)),
        "ffn_w1": nrm(ks[20], (L, D_MODEL, D_FF), D_MODEL ** -0.5),
        "ffn_w2": nrm(ks[21], (L, D_FF, D_MODEL), D_FF ** -0.5),
    }


def reference(x, rel_bias, norm1_w, w_in, conv_w, conv_b, nsa_q_norm, nsa_k_norm, cmp_pos, cmp_w1, cmp_w2,
              mla_q_a_norm, mla_kv_norm, mla_wq_b, mla_wkv_b, mla_q_norm, mla_k_norm, out_norm_w, w_out,
              norm2_w, ffn_w1, ffn_w2):
    B, S, D = x.shape
    cos, sin = rope_tables(S)
    for l in range(DEPTH):
        h = rms_norm(x, norm1_w[l])
        cols = split_cols(h @ w_in[l], IN_SIZES)
        a_b, a_c, a_u = cols[0:3]
        n_q, n_kc, n_vc, n_ks, n_vs, n_kw, n_vw, n_g = cols[3:11]
        m_cq, m_ckv, m_kr = cols[11:14]
        s_q, s_k, s_v = cols[14:17]
        y_a = short_conv_mixer(a_b, a_c, a_u, conv_w[l], conv_b[l])
        y_b = nsa_mixer(n_q.reshape(B, S, NSA_HEADS, HEAD_DIM), n_kc, n_vc, n_ks, n_vs, n_kw, n_vw, n_g,
                        nsa_q_norm[l], nsa_k_norm[l], cmp_pos[l], cmp_w1[l], cmp_w2[l], rel_bias)
        y_c = mla_mixer(m_cq, m_ckv, m_kr, mla_q_a_norm[l], mla_kv_norm[l], mla_wq_b[l], mla_wkv_b[l],
                        mla_q_norm[l], mla_k_norm[l], cos, sin)
        y_d = stick_breaking_mixer(s_q.reshape(B, S, SB_HEADS, HEAD_DIM), s_k.reshape(B, S, SB_HEADS, HEAD_DIM),
                                   s_v.reshape(B, S, SB_HEADS, HEAD_DIM))
        y = jnp.concatenate([y_a, y_b, y_c, y_d], axis=-1).reshape(B, S, N_GROUPS, GROUP_WIDTH)
        y = rms_norm(y, out_norm_w[l].reshape(N_GROUPS, GROUP_WIDTH)).reshape(B, S, D)
        x = x + y @ w_out[l]
        h2 = rms_norm(x, norm2_w[l])
        x = x + jnp.square(jax.nn.relu(h2 @ ffn_w1[l])) @ ffn_w2[l]
    return x
```

```cpp
#include <hip/hip_runtime.h>
#include <cstdio>
#include <cstdint>
#include <cmath>
namespace pg8 {
#define PG8_LAS __attribute__((address_space(3)))
typedef unsigned short bf16_t;
typedef short bf16x8 __attribute__((ext_vector_type(8)));
typedef float f32x4 __attribute__((ext_vector_type(4)));
typedef unsigned u32x4 __attribute__((ext_vector_type(4)));
constexpr int BM = 256, BK = 64, HALF = 128, HTB = HALF * BK * 2  , STAGE_BYTES = 8 * HTB, NXCD = 8, WGM = 8;

__host__ __device__ __forceinline__ int lds_byte(int r, int c) { const int st = (r >> 4) * 2 + (c >> 5), rr = r & 15, cc = c & 31, ob = rr * 64 + cc * 2; return st * 1024 + (ob ^ (((ob >> 9) & 1) << 5)); }
__host__ __device__ __forceinline__ void stage_rc(int b, int& R, int& C) { const int st = b / 1024, sb = b % 1024, swz = sb ^ (((sb >> 9) & 1) << 5); R = (st >> 1) * 16 + swz / 64; C = (st & 1) * 32 + (swz % 64) / 2; }
__host__ __device__ __forceinline__ int perm32(int rho) { const int n = rho >> 4, i = rho & 15; return 8 * (i >> 2) + 4 * n + (i & 3); }

struct Unit { int pm, pn; };
struct Gemm { const bf16_t* A; const bf16_t* Bt; int M, N, K; };

struct StaticOrder {
    int nM, nN, nwg, G, c;
    __host__ __device__ void init(int M, int N, int G_, int c_) { nM = M / BM; nN = N / BM; nwg = nM * nN; G = G_; c = c_; }
    __host__ __device__ bool next(int i, Unit& u) const {
        const long L = (long)i * G + c; if (L >= nwg) return false;
        int wgid = (int)L; { const int q = nwg / NXCD, r = nwg % NXCD, xcd = wgid % NXCD, off = wgid / NXCD; wgid = (xcd < r ? xcd * (q + 1) : r * (q + 1) + (xcd - r) * q) + off; }
        const int nig = WGM * nN, gid = wgid / nig, fm = gid * WGM, gsz = (nM - fm) < WGM ? (nM - fm) : WGM;
        u.pm = fm + ((wgid % nig) % gsz); u.pn = (wgid % nig) / gsz; return true;
    }
    __device__ __forceinline__ void a_ready(const Unit&) const {}
    __device__ __forceinline__ void done(const Unit&) const {}
};

__device__ __forceinline__ unsigned cvt_pk_bf16(float lo, float hi) { unsigned r; asm volatile("v_cvt_pk_bf16_f32 %0, %1, %2" : "=v"(r) : "v"(lo), "v"(hi)); return r; }
typedef float f32x2 __attribute__((ext_vector_type(2)));
__device__ __forceinline__ f32x2 gelu_pk(f32x2 v) {
    const f32x2 av = __builtin_elementwise_abs(v), d = av * 0.2316418882f + 1.0f;
    f32x2 t; t.x = __builtin_amdgcn_rcpf(d.x); t.y = __builtin_amdgcn_rcpf(d.y);
    f32x2 q = t * 0.5307027145f + (-0.7265760135f); q = q * t + 0.7107068705f; q = q * t + (-0.142248368f); q = q * t + 0.127414796f; q = q * t;
    const f32x2 s = (v * v) * (-0.72134752044f);
    f32x2 e; e.x = __builtin_amdgcn_exp2f(s.x); e.y = __builtin_amdgcn_exp2f(s.y);
    const f32x2 m = v * (q * e), r = v - m;
    f32x2 o; o.x = v.x < 0.f ? m.x : r.x; o.y = v.y < 0.f ? m.y : r.y; return o;
}

template <int ACT  > struct EpiBf16 {
    static constexpr bool PERM = true, AFTER_DRAIN = false; static_assert(ACT == 0 || ACT == 1, "EpiBf16: ACT is 0 (none) or 1 (gelu_pk)");
    bf16_t* O; int ldc; const float* bias; int split_cols; size_t split_stride; float scale0;
    __device__ __forceinline__ void operator()(const f32x4 (&acc)[2][2][4][2], const Unit& u, int wr, int wc, int fr, int fq) const {
        const int row0 = u.pm * BM + wr * 64 + fr; int colt = u.pn * BM; bf16_t* base = O;
        float sc = 1.f; if (split_cols) { const int t = colt / split_cols; base += (size_t)t * split_stride; colt -= t * split_cols; if (t == 0) sc = scale0; }
        const int col0 = colt + wc * 32 + 8 * fq, bcol0 = u.pn * BM + wc * 32 + 8 * fq;
        f32x4 bv[2][2];
#pragma unroll
        for (int bj = 0; bj < 2; ++bj)
#pragma unroll
            for (int n = 0; n < 2; ++n) bv[bj][n] = bias ? *(const f32x4*)(bias + bcol0 + bj * HALF + 4 * n) : (f32x4){0.f, 0.f, 0.f, 0.f};
#pragma unroll
        for (int ai = 0; ai < 2; ++ai)
#pragma unroll
            for (int m = 0; m < 4; ++m) { bf16_t* rowp = base + (size_t)(row0 + ai * HALF + m * 16) * ldc + col0;
#pragma unroll
                for (int bj = 0; bj < 2; ++bj) { f32x4 v0 = acc[ai][bj][m][0] + bv[bj][0], v1 = acc[ai][bj][m][1] + bv[bj][1];
                    if (ACT == 1) { f32x2 a = gelu_pk((f32x2){v0[0], v0[1]}), b = gelu_pk((f32x2){v0[2], v0[3]}), c = gelu_pk((f32x2){v1[0], v1[1]}), d = gelu_pk((f32x2){v1[2], v1[3]});
                        v0 = (f32x4){a.x, a.y, b.x, b.y}; v1 = (f32x4){c.x, c.y, d.x, d.y}; }
                    v0 = v0 * sc; v1 = v1 * sc; u32x4 w; w.x = cvt_pk_bf16(v0[0], v0[1]); w.y = cvt_pk_bf16(v0[2], v0[3]); w.z = cvt_pk_bf16(v1[0], v1[1]); w.w = cvt_pk_bf16(v1[2], v1[3]);
                    *(u32x4*)(rowp + bj * HALF) = w; } }
    }
};

template <class Epi, class Sched, bool ALIGN_EPI = false, bool SP2 = false>
__device__ __forceinline__ void gemm_phase(PG8_LAS unsigned char* lds, const Gemm g, const Sched& S, const Epi& E) {
    int tid_ = threadIdx.x; asm volatile("" : "+v"(tid_));
    const int tid = tid_, wid = __builtin_amdgcn_readfirstlane(tid >> 6), lane = tid & 63, wr = wid >> 2, wc = wid & 3, fr = lane & 15, fq = lane >> 4;
    const int K = g.K, nt = K / BK;
    unsigned voffA[2], voffB[2];
#pragma unroll
    for (int i = 0; i < 2; ++i) { int R, C; stage_rc(tid * 16 + i * 8192, R, C); const int Rb = Epi::PERM ? ((R & ~31) + perm32(R & 31)) : R;
        voffA[i] = (unsigned)(R * K + C) * 2u; voffB[i] = (unsigned)(Rb * K + C) * 2u; }
    const size_t kstep = (size_t)(BK * 2);
    const size_t hstep = (size_t)HALF * K * 2;
    const size_t tstep = 2 * hstep;
    const unsigned ldsw = (unsigned)wid * 1024u;
    const int aoff = lds_byte(wr * 64 + fr, fq * 8), boff = lds_byte(wc * 32 + fr, fq * 8);
#define PG8_SA(b, h) (((b) * 2 + (h)) * HTB)
#define PG8_SB(b, h) ((4 + (b) * 2 + (h)) * HTB)
#define PG8_STAGE(bufoff, gbase, voff) do { _Pragma("unroll") for (int _i = 0; _i < 2; ++_i) \
        __builtin_amdgcn_global_load_lds((const unsigned*)((const char*)(gbase) + (voff)[_i]), (PG8_LAS unsigned*)(lds + (bufoff) + ldsw + _i * 8192), 16, 0, 0); } while (0)
#define PG8_LDA(dst, b, h) do { _Pragma("unroll") for (int m = 0; m < 4; ++m) _Pragma("unroll") for (int k = 0; k < 2; ++k) dst[m][k] = *(const PG8_LAS bf16x8*)(lds + PG8_SA(b, h) + aoff + m * 2048 + k * 1024); } while (0)
#define PG8_LDB(dst, b, h) do { _Pragma("unroll") for (int n = 0; n < 2; ++n) _Pragma("unroll") for (int k = 0; k < 2; ++k) dst[n][k] = *(const PG8_LAS bf16x8*)(lds + PG8_SB(b, h) + boff + n * 2048 + k * 1024); } while (0)
#define PG8_MMA(ai, bj, At, Bt) do { __builtin_amdgcn_s_setprio(1); _Pragma("unroll") for (int m = 0; m < 4; ++m) _Pragma("unroll") for (int n = 0; n < 2; ++n) _Pragma("unroll") for (int k = 0; k < 2; ++k) \
        acc[ai][bj][m][n] = __builtin_amdgcn_mfma_f32_16x16x32_bf16(Bt[n][k], At[m][k], acc[ai][bj][m][n], 0, 0, 0); __builtin_amdgcn_s_setprio(0); } while (0)
#define PG8_WAIT_V(n) asm volatile("s_waitcnt vmcnt(" #n ")" ::: "memory")
#define PG8_WAIT_L(n) asm volatile("s_waitcnt lgkmcnt(" #n ")" ::: "memory")
#define PG8_BAR __builtin_amdgcn_s_barrier()
#define PG8_SCHED __builtin_amdgcn_sched_barrier(0)
    Unit cur, nxt; int ui = 0;
    if (!S.next(0, cur)) return;
    f32x4 acc[2][2][4][2];
#pragma unroll
    for (int a = 0; a < 2; ++a)
#pragma unroll
        for (int b = 0; b < 2; ++b)
#pragma unroll
            for (int m = 0; m < 4; ++m)
#pragma unroll
                for (int n = 0; n < 2; ++n) acc[a][b][m][n] = (f32x4){0.f, 0.f, 0.f, 0.f};
    bf16x8 At[4][2], B0[2][2], B1[2][2];
    const char* cA = (const char*)g.A + (size_t)cur.pm * tstep; const char* cB = (const char*)g.Bt + (size_t)cur.pn * tstep;
    S.a_ready(cur);
    if constexpr (SP2) {
        PG8_STAGE(PG8_SB(0, 0), cB, voffB); PG8_STAGE(PG8_SB(0, 1), cB + hstep, voffB); PG8_STAGE(PG8_SA(0, 0), cA, voffA); PG8_STAGE(PG8_SA(0, 1), cA + hstep, voffA);
        if (wr == 1) PG8_BAR;
        PG8_WAIT_V(2); PG8_BAR;
        PG8_STAGE(PG8_SB(1, 0), cB + kstep, voffB); PG8_STAGE(PG8_SA(1, 0), cA + kstep, voffA); PG8_STAGE(PG8_SB(1, 1), cB + hstep + kstep, voffB);
        PG8_WAIT_V(6); PG8_BAR;
    } else {
        PG8_STAGE(PG8_SB(0, 0), cB, voffB); PG8_STAGE(PG8_SA(0, 0), cA, voffA); PG8_STAGE(PG8_SB(0, 1), cB + hstep, voffB); PG8_STAGE(PG8_SA(0, 1), cA + hstep, voffA);
        if (wr == 1) PG8_BAR;
        PG8_WAIT_V(4); PG8_BAR;
        PG8_STAGE(PG8_SB(1, 0), cB + kstep, voffB); PG8_STAGE(PG8_SA(1, 0), cA + kstep, voffA); PG8_STAGE(PG8_SB(1, 1), cB + hstep + kstep, voffB);
        PG8_WAIT_V(6); PG8_BAR;
    }
    for (;;) {
        const bool has_next = S.next(ui + 1, nxt);
        const char* nA = has_next ? (const char*)g.A + (size_t)nxt.pm * tstep : cA; const char* nB = has_next ? (const char*)g.Bt + (size_t)nxt.pn * tstep : cB;
        for (int t = 0; t < nt; t += 2) {
            const bool last = (t == nt - 2);
            const char* a1 = cA + (size_t)(t + 1) * kstep;
            const char* a2 = last ? nA : cA + (size_t)(t + 2) * kstep; const char* b2 = last ? nB : cB + (size_t)(t + 2) * kstep;
            const char* a3 = a2 + kstep; const char* b3 = b2 + kstep;
            if (last && has_next) S.a_ready(nxt);
            if constexpr (SP2) {
            PG8_LDB(B0, 0, 0); PG8_LDB(B1, 0, 1); PG8_SCHED; PG8_LDA(At, 0, 0); PG8_STAGE(PG8_SA(1, 1), a1 + hstep, voffA);
            PG8_WAIT_V(8); PG8_WAIT_L(0); PG8_BAR; PG8_MMA(0, 0, At, B0); PG8_MMA(0, 1, At, B1); PG8_BAR; PG8_SCHED;
            PG8_LDA(At, 0, 1); PG8_STAGE(PG8_SB(0, 0), b2, voffB); PG8_STAGE(PG8_SB(0, 1), b2 + hstep, voffB); PG8_STAGE(PG8_SA(0, 0), a2, voffA);
            PG8_WAIT_V(8); PG8_WAIT_L(0); PG8_BAR; PG8_MMA(1, 0, At, B0); PG8_MMA(1, 1, At, B1); PG8_BAR; PG8_SCHED;
            PG8_LDB(B0, 1, 0); PG8_LDB(B1, 1, 1); PG8_SCHED; PG8_LDA(At, 1, 0); PG8_STAGE(PG8_SA(0, 1), a2 + hstep, voffA);
            PG8_WAIT_V(8); PG8_WAIT_L(0); PG8_BAR; PG8_MMA(0, 0, At, B0); PG8_MMA(0, 1, At, B1); PG8_BAR; PG8_SCHED;
            PG8_LDA(At, 1, 1); PG8_STAGE(PG8_SB(1, 0), b3, voffB); PG8_STAGE(PG8_SB(1, 1), b3 + hstep, voffB); PG8_STAGE(PG8_SA(1, 0), a3, voffA);
            PG8_WAIT_V(8); PG8_WAIT_L(0); PG8_BAR; PG8_MMA(1, 0, At, B0); PG8_MMA(1, 1, At, B1); PG8_BAR; PG8_SCHED;
            } else {
            PG8_LDB(B0, 0, 0); PG8_SCHED; PG8_LDA(At, 0, 0); PG8_STAGE(PG8_SA(1, 1), a1 + hstep, voffA);
            PG8_WAIT_L(8); PG8_BAR; PG8_WAIT_L(0); PG8_MMA(0, 0, At, B0); PG8_BAR; PG8_SCHED;
            PG8_LDB(B1, 0, 1); PG8_STAGE(PG8_SB(0, 0), b2, voffB);
            PG8_BAR; PG8_WAIT_L(0); PG8_MMA(0, 1, At, B1); PG8_BAR;
            PG8_LDA(At, 0, 1); PG8_STAGE(PG8_SA(0, 0), a2, voffA);
            PG8_BAR; PG8_WAIT_L(0); PG8_MMA(1, 0, At, B0); PG8_BAR; PG8_SCHED;
            PG8_STAGE(PG8_SB(0, 1), b2 + hstep, voffB);
            PG8_WAIT_V(6); PG8_BAR; PG8_MMA(1, 1, At, B1); PG8_BAR;
            PG8_LDB(B0, 1, 0); PG8_SCHED; PG8_LDA(At, 1, 0); PG8_STAGE(PG8_SA(0, 1), a2 + hstep, voffA);
            PG8_WAIT_L(8); PG8_BAR; PG8_WAIT_L(0); PG8_MMA(0, 0, At, B0); PG8_BAR; PG8_SCHED;
            PG8_LDB(B1, 1, 1); PG8_STAGE(PG8_SB(1, 0), b3, voffB);
            PG8_BAR; PG8_WAIT_L(0); PG8_MMA(0, 1, At, B1); PG8_BAR;
            PG8_LDA(At, 1, 1); PG8_STAGE(PG8_SA(1, 0), a3, voffA);
            PG8_BAR; PG8_WAIT_L(0); PG8_MMA(1, 0, At, B0); PG8_BAR; PG8_SCHED;
            PG8_STAGE(PG8_SB(1, 1), b3 + hstep, voffB);
            PG8_WAIT_V(6); PG8_BAR; PG8_MMA(1, 1, At, B1); PG8_BAR;
            }
        }
        if constexpr (ALIGN_EPI) { if (wr == 0) PG8_BAR; }
        if constexpr (!Epi::AFTER_DRAIN) { E(acc, cur, wr, wc, fr, fq); S.done(cur); }
        if (!has_next) break;
#pragma unroll
        for (int a = 0; a < 2; ++a)
#pragma unroll
            for (int b = 0; b < 2; ++b)
#pragma unroll
                for (int m = 0; m < 4; ++m)
#pragma unroll
                    for (int n = 0; n < 2; ++n) acc[a][b][m][n] = (f32x4){0.f, 0.f, 0.f, 0.f};
        cur = nxt; cA = nA; cB = nB; ++ui;
        if constexpr (ALIGN_EPI) { if (wr == 1) PG8_BAR; }
    }
    PG8_WAIT_V(0);
    if constexpr (!ALIGN_EPI) { if (wr == 0) PG8_BAR; }
    PG8_BAR;
    if constexpr (Epi::AFTER_DRAIN) { E.fused(acc, cur, wr, wc, fr, fq, lds, wid, lane); S.done(cur); }
#undef PG8_SA
#undef PG8_SB
#undef PG8_STAGE
#undef PG8_LDA
#undef PG8_LDB
#undef PG8_MMA
#undef PG8_WAIT_V
#undef PG8_WAIT_L
#undef PG8_BAR
#undef PG8_SCHED
}
}

#ifndef PG8_SP2
#define PG8_SP2 true
#endif
#ifndef PG8_ALIGN
#define PG8_ALIGN true
#endif
namespace pg8 {
template <int ACT> struct EpiBf16S {
    static constexpr bool PERM = true, AFTER_DRAIN = false;
    bf16_t* O; int ldc; const float* rs;
    __device__ __forceinline__ void operator()(const f32x4 (&acc)[2][2][4][2], const Unit& u, int wr, int wc, int fr, int fq) const {
        const int row0 = u.pm * BM + wr * 64 + fr, col0 = u.pn * BM + wc * 32 + 8 * fq;
#pragma unroll
        for (int ai = 0; ai < 2; ++ai)
#pragma unroll
            for (int m = 0; m < 4; ++m) { const int r = row0 + ai * HALF + m * 16; const float s = rs ? rs[r] : 1.f; bf16_t* rowp = O + (size_t)r * ldc + col0;
#pragma unroll
                for (int bj = 0; bj < 2; ++bj) { f32x4 v0 = acc[ai][bj][m][0] * s, v1 = acc[ai][bj][m][1] * s;
                    if (ACT == 2) {
#pragma unroll
                        for (int e = 0; e < 4; ++e) { const float a = fmaxf(v0[e], 0.f), b = fmaxf(v1[e], 0.f); v0[e] = a * a; v1[e] = b * b; } }
                    u32x4 w; w.x = cvt_pk_bf16(v0[0], v0[1]); w.y = cvt_pk_bf16(v0[2], v0[3]); w.z = cvt_pk_bf16(v1[0], v1[1]); w.w = cvt_pk_bf16(v1[2], v1[3]);
                    *(u32x4*)(rowp + bj * HALF) = w; } }
    }
};
struct EpiResF32 {
    static constexpr bool PERM = false, AFTER_DRAIN = false;
    const float* base; float* out; int ldc;
    __device__ __forceinline__ void operator()(const f32x4 (&acc)[2][2][4][2], const Unit& u, int wr, int wc, int fr, int fq) const {
        const int col0 = u.pn * BM + wc * 32 + 4 * fq;
#pragma unroll
        for (int ai = 0; ai < 2; ++ai)
#pragma unroll
            for (int m = 0; m < 4; ++m) { const size_t off = (size_t)(u.pm * BM + ai * HALF + wr * 64 + m * 16 + fr) * ldc + col0;
#pragma unroll
                for (int bj = 0; bj < 2; ++bj)
#pragma unroll
                    for (int n = 0; n < 2; ++n) { const f32x4 bs = *(const f32x4*)(base + off + bj * HALF + n * 16); *(f32x4*)(out + off + bj * HALF + n * 16) = bs + acc[ai][bj][m][n]; }
                asm volatile("" ::: "memory"); }
    }
};
}
#define GAS __attribute__((address_space(1)))
#define LAS __attribute__((address_space(3)))
typedef unsigned short bf16;
typedef unsigned v4u __attribute__((ext_vector_type(4)));
typedef float f32x4 __attribute__((ext_vector_type(4)));
typedef short bf16x8 __attribute__((ext_vector_type(8)));
typedef GAS unsigned gu32;
typedef GAS unsigned long long gu64;
#define RLX_AGENT __ATOMIC_RELAXED, __HIP_MEMORY_SCOPE_AGENT
#define LDS_WAIT() asm volatile("s_waitcnt lgkmcnt(0)" ::: "memory")
#define VM_WAIT() asm volatile("s_waitcnt vmcnt(0)" ::: "memory")
__device__ __forceinline__ unsigned long long rt() { return __builtin_amdgcn_s_memrealtime(); }
__device__ __forceinline__ unsigned f2bf(float f) { unsigned u = __builtin_bit_cast(unsigned, f); return (u + 0x7fffu + ((u >> 16) & 1u)) >> 16; }
__device__ __forceinline__ unsigned pk2(float lo, float hi) { return f2bf(lo) | (f2bf(hi) << 16); }

#define XB_TMO      128
#define XB_XCNT(j)  (256  + 64 * (j))
#define XB_XSUB(j)  (1280 + 64 * (j))
#define XB_XGEN(j)  (2304 + 64 * (j))
#define XB_TOP      3328
#define XB_TOPGEN   3392
#define XCD_BAR_WORDS 3456
#define XB_SPIN_CAP (1u << 18)

__device__ __forceinline__ unsigned xb_ld(unsigned* p)              { return __hip_atomic_load(p, __ATOMIC_RELAXED, __HIP_MEMORY_SCOPE_AGENT); }
__device__ __forceinline__ unsigned xb_add(unsigned* p, unsigned v) { return __hip_atomic_fetch_add(p, v, __ATOMIC_RELAXED, __HIP_MEMORY_SCOPE_AGENT); }
__device__ __forceinline__ unsigned xb_xcc_id() { return (unsigned)__builtin_amdgcn_s_getreg((3 << 11) | 20) & 0xFu; }
#define XB_SPIN(cond, bar) do { unsigned _sp = 0; while (cond) { __builtin_amdgcn_s_sleep(1); \
    if ((++_sp & 255u) == 0u) { if (xb_ld(&(bar)[XB_TMO])) break; if (_sp > XB_SPIN_CAP) { atomicAdd(&(bar)[XB_TMO], 1u); break; } } } } while (0)

struct XcdBarrier {
    unsigned* bar; unsigned x;
    volatile LAS unsigned* st;
};

__device__ __forceinline__ XcdBarrier xcd_barrier_post(unsigned* bar, volatile LAS unsigned* st) {
    XcdBarrier b; b.bar = bar; b.x = xb_xcc_id(); b.st = st;
    if (threadIdx.x == 0) (void)xb_add(&bar[XB_XCNT(b.x)], 1u);
    return b;
}
__device__ __forceinline__ void xcd_barrier_complete(unsigned* bar, unsigned x, unsigned& nloc, unsigned& nx) {
    const unsigned G = gridDim.x * gridDim.y * gridDim.z;
    unsigned sum, cnt, mine, sp = 0u;
    for (;;) {
        sum = 0u; cnt = 0u; mine = 0u;
#pragma unroll
        for (unsigned j = 0; j < 16; ++j) { const unsigned c = xb_ld(&bar[XB_XCNT(j)]); sum += c; cnt += (c > 0u) ? 1u : 0u; mine = (j == x) ? c : mine; }
        if (sum == G) break;
        __builtin_amdgcn_s_sleep(1);
        if ((++sp & 255u) == 0u) { if (xb_ld(&bar[XB_TMO])) break; if (sp > XB_SPIN_CAP) { atomicAdd(&bar[XB_TMO], 1u); break; } }
    }
    nloc = mine > 0u ? mine : 1u; nx = cnt > 0u ? cnt : 1u;
}

__device__ __forceinline__ void xcd_barrier(const XcdBarrier& b) {
    asm volatile("s_waitcnt vmcnt(0)" ::: "memory");
    __syncthreads();
    if (threadIdx.x == 0) {
        unsigned* bar = b.bar;
        __builtin_amdgcn_s_waitcnt(0);
        unsigned nloc = b.st[0], nx = b.st[1];
        if (nloc == 0u) { xcd_barrier_complete(bar, b.x, nloc, nx); b.st[0] = nloc; b.st[1] = nx; }
        const unsigned old = xb_add(&bar[XB_XSUB(b.x)], 1u);
        const unsigned gen = old / nloc;
        if (old + 1u == (gen + 1u) * nloc) {
            __builtin_amdgcn_fence(__ATOMIC_RELEASE, "agent");
            asm volatile("s_waitcnt vmcnt(0)" ::: "memory");
            const unsigned og = xb_add(&bar[XB_TOP], 1u);
            const unsigned tg = og / nx;
            if (og + 1u == (tg + 1u) * nx) xb_add(&bar[XB_TOPGEN], 1u);
            else XB_SPIN(xb_ld(&bar[XB_TOPGEN]) == tg, bar);
            __builtin_amdgcn_fence(__ATOMIC_ACQUIRE, "agent");
            xb_add(&bar[XB_XGEN(b.x)], 1u);
            asm volatile("s_waitcnt vmcnt(0)" ::: "memory");
        } else {
            XB_SPIN(xb_ld(&bar[XB_XGEN(b.x)]) == gen, bar);
            __builtin_amdgcn_fence(__ATOMIC_ACQUIRE, "agent");
            asm volatile("s_waitcnt vmcnt(0)" ::: "memory");
        }
    }
    __syncthreads();
}
constexpr int NWAVES = 8;
#ifndef MK_ONE_LAUNCH
#define MK_ONE_LAUNCH 1
#endif
constexpr int BATCH = 8, SEQ = 2048, D = 1024, M = BATCH * SEQ, DEPTH = 2, FF = 4096, NIN = 2540, NP = 2560;
constexpr int NCMP = 127;
constexpr float EPS = 1e-6f;
constexpr int C_AB = 0, C_AC = 256, C_AU = 512, C_NQ = 768, C_KC = 1024, C_VC = 1088, C_KS = 1152, C_VS = 1216, C_KW = 1280, C_VW = 1344,
              C_CQ = 1408, C_CKV = 1600, C_KR = 1728, C_SQ = 1760, C_SK = 2016, C_SV = 2272, C_NG = 2528;
enum { I_X = 0, I_RELB, I_N1W, I_WIN, I_CONVW, I_CONVB, I_NQN, I_NKN, I_CPOS, I_CW1, I_CW2, I_QAN, I_KVN, I_WQB, I_WKVB, I_MQN, I_MKN, I_ONW, I_WOUT, I_N2W, I_FW1, I_FW2, N_INPUTS };
constexpr size_t MiB = 1u << 20;
constexpr size_t WS_CTL = 0, CTL_ZERO_BYTES = 64 * 1024;
constexpr size_t WS_ROPE = 1 * MiB;
constexpr size_t WS_TB = WS_ROPE + 262144;
constexpr size_t WS_CB1 = WS_TB + 4096;
constexpr size_t WS_KCV = WS_CB1 + 65536;
constexpr size_t WS_WIN = 2 * MiB, WS_WO = 12 * MiB, WS_W1 = 16 * MiB, WS_W2 = 32 * MiB;
constexpr size_t WS_QM = 48 * MiB, WS_KM = 60 * MiB, WS_VM = 72 * MiB, WS_QN = 80 * MiB, WS_KS = 88 * MiB, WS_KW = 90 * MiB;
constexpr size_t WS_XN = 96 * MiB, WS_P = 128 * MiB, WS_Y = 208 * MiB, WS_H = 128 * MiB, WS_END = 256 * MiB;
static_assert(WS_KCV + 262144 <= WS_WIN, "tables");
constexpr int RING_OFF = 0, RING_BYTES = 131072;
constexpr int LDSCTL_OFF = RING_BYTES, MISC_OFF = LDSCTL_OFF + 320, TB_OFF = RING_BYTES + 1024;
constexpr int LDS_BYTES = 147456;

typedef unsigned short bf16;
struct Args { const float* in[N_INPUTS]; float* out; unsigned char* ws; int ph_lo, ph_hi; };
typedef const __attribute__((address_space(4))) Args* ArgsP;
#define OPQ_V(x) asm volatile("" : "+v"(x))
template <class T> __device__ __forceinline__ T opq_ptr(T p) { const unsigned long long u = (unsigned long long)p; unsigned lo = (unsigned)__builtin_amdgcn_readfirstlane((int)(unsigned)u), hi = (unsigned)__builtin_amdgcn_readfirstlane((int)(unsigned)(u >> 32));
    asm volatile("" : "+s"(lo), "+s"(hi)); return (T)(((unsigned long long)hi << 32) | lo); }
#define OPQ_S(x) ((x) = opq_ptr(x))

__device__ __forceinline__ float wsum(float v) {
#pragma unroll
    for (int o = 1; o < 64; o <<= 1) v += __shfl_xor(v, o);
    return v;
}
__device__ __forceinline__ float wmaxf(float v) {
#pragma unroll
    for (int o = 1; o < 64; o <<= 1) v = fmaxf(v, __shfl_xor(v, o));
    return v;
}
__device__ __forceinline__ float bf2f(bf16 b) { return __uint_as_float((unsigned)b << 16); }
__device__ __forceinline__ float bflo(unsigned w) { return __uint_as_float(w << 16); }
__device__ __forceinline__ float bfhi(unsigned w) { return __uint_as_float(w & 0xffff0000u); }
__device__ __forceinline__ bf16 f2b(float f) { return (bf16)f2bf(f); }

struct Frame {
    unsigned char* lds; int tid, lane, wave, vcu, G;
    ArgsP a; unsigned char* ws;
};

__device__ __forceinline__ int win_dst(int n) { return n < 1408 ? n : (n < 1420 ? 2528 + (n - 1408) : n - 12); }
template <bool WINMAP> __device__ __forceinline__ void transpose_item(const float* W, int K, int N, bf16* WT, float* scr, int item, int lane) {
    const int nblk = (N + 31) / 32, kb = item / nblk, nb = item % nblk, k0 = 64 * kb, n0 = 32 * nb;
    { const int n = n0 + (lane & 31);
#pragma unroll 8
      for (int i = 0; i < 32; ++i) { const int kk = 2 * i + (lane >> 5); scr[kk * 33 + (lane & 31)] = n < N ? W[(size_t)(k0 + kk) * N + n] : 0.f; } }
    LDS_WAIT(); asm volatile("" ::: "memory");
    const int c = lane & 7;
#pragma unroll
    for (int j = 0; j < 4; ++j) { const int nl = (lane >> 3) + 8 * j, n = n0 + nl; const float* s = scr + (8 * c) * 33 + nl;
        v4u o; o.x = pk2(s[0 * 33], s[1 * 33]); o.y = pk2(s[2 * 33], s[3 * 33]); o.z = pk2(s[4 * 33], s[5 * 33]); o.w = pk2(s[6 * 33], s[7 * 33]);
        if (n < N) { const int dn = WINMAP ? win_dst(n) : n; *(v4u*)(WT + (size_t)dn * K + k0 + 8 * c) = o; } }
    LDS_WAIT(); asm volatile("" ::: "memory");
}
__device__ __forceinline__ void rms_row_to_bf16(const float* xrow, const float* w, bf16* orow, int lane) {
    const f32x4* xr = (const f32x4*)xrow + lane; const f32x4* wr = (const f32x4*)w + lane;
    f32x4 v[4]; float s = 0.f;
#pragma unroll
    for (int j = 0; j < 4; ++j) { v[j] = xr[64 * j]; s += (v[j].x * v[j].x + v[j].y * v[j].y) + (v[j].z * v[j].z + v[j].w * v[j].w); }
    const float rstd = 1.0f / sqrtf(wsum(s) * (1.f / D) + EPS);
    unsigned long long* o8 = (unsigned long long*)orow + lane;
#pragma unroll
    for (int j = 0; j < 4; ++j) { const f32x4 g = wr[64 * j];
        o8[64 * j] = (unsigned long long)pk2(v[j].x * rstd * g.x, v[j].y * rstd * g.y) | ((unsigned long long)pk2(v[j].z * rstd * g.z, v[j].w * rstd * g.w) << 32); }
}
__device__ __forceinline__ void sincos_d(float angf, float& c, float& s) {
    const double a = (double)angf; const double kq = __builtin_rint(a * 0.63661977236758134308); const int q = (int)kq;
    double r = __builtin_fma(-kq, 1.5707963267948966192, a); r = __builtin_fma(-kq, 6.123233995736766e-17, r);
    const double r2 = r * r;
    double sp = -1.0 / 39916800.0; sp = sp * r2 + 1.0 / 362880.0; sp = sp * r2 - 1.0 / 5040.0; sp = sp * r2 + 1.0 / 120.0; sp = sp * r2 - 1.0 / 6.0; sp = sp * r2 + 1.0; sp *= r;
    double cp = 1.0 / 479001600.0; cp = cp * r2 - 1.0 / 3628800.0; cp = cp * r2 + 1.0 / 40320.0; cp = cp * r2 - 1.0 / 720.0; cp = cp * r2 + 1.0 / 24.0; cp = cp * r2 - 0.5; cp = cp * r2 + 1.0;
    const int qq = q & 3;
    const double sv = (qq == 0) ? sp : (qq == 1) ? cp : (qq == 2) ? -sp : -cp;
    const double cv = (qq == 0) ? cp : (qq == 1) ? -sp : (qq == 2) ? -cp : sp;
    c = (float)cv; s = (float)sv;
}
__device__ __forceinline__ int t5_bucket(int d) {
    if (d < 16) return d;
    int b = 16 + (int)(logf((float)d / 16.0f) / logf(8.0f) * 16.0f);
    return b < 31 ? b : 31;
}

__device__ __forceinline__ void p0_prologue(Frame F) {
    OPQ_V(F.lane); OPQ_V(F.tid); OPQ_S(F.ws); OPQ_S(F.a);
    float* scr = (float*)(F.lds + RING_OFF + F.wave * 16384);
    const int gw = F.vcu * NWAVES + F.wave, NGW = F.G * NWAVES;
    const int gt = F.vcu * (NWAVES * 64) + F.tid, NT = F.G * NWAVES * 64;
    constexpr int I_IN = (D / 64) * ((NIN + 31) / 32), I_O = (D / 64) * (D / 32), I_1 = (D / 64) * (FF / 32), I_2 = (FF / 64) * (D / 32), I_L = I_IN + I_O + I_1 + I_2;
    for (int it = gw; it < DEPTH * I_L; it += NGW) {
        const int l = it / I_L; int r = it % I_L;
        if (r < I_IN) { transpose_item<true>(F.a->in[I_WIN] + (size_t)l * D * NIN, D, NIN, (bf16*)(F.ws + WS_WIN) + (size_t)l * NP * D, scr, r, F.lane); continue; } r -= I_IN;
        if (r < I_O) { transpose_item<false>(F.a->in[I_WOUT] + (size_t)l * D * D, D, D, (bf16*)(F.ws + WS_WO) + (size_t)l * D * D, scr, r, F.lane); continue; } r -= I_O;
        if (r < I_1) { transpose_item<false>(F.a->in[I_FW1] + (size_t)l * D * FF, D, FF, (bf16*)(F.ws + WS_W1) + (size_t)l * FF * D, scr, r, F.lane); continue; } r -= I_1;
        transpose_item<false>(F.a->in[I_FW2] + (size_t)l * FF * D, FF, D, (bf16*)(F.ws + WS_W2) + (size_t)l * D * FF, scr, r, F.lane);
    }
    for (int i = gt; i < DEPTH * 20 * D / 8; i += NT) { const int l = i / (20 * D / 8), r = i % (20 * D / 8); *(v4u*)((bf16*)(F.ws + WS_WIN) + (size_t)l * NP * D + (size_t)NIN * D + (size_t)r * 8) = (v4u){0u, 0u, 0u, 0u}; }
    for (int i = gt; i < SEQ * 16; i += NT) { const int t = i >> 4, j = i & 15;
        const double pb = (j & 3) == 0 ? 1.0 : (j & 3) == 1 ? 0.56234132519034908 : (j & 3) == 2 ? 0.31622776601683794 : 0.17782794100389228;
        const int e = j >> 2; const double ps = e == 0 ? 1.0 : e == 1 ? 0.1 : e == 2 ? 0.01 : 0.001;
        const float inv = (float)(pb * ps); const float ang = (float)t * inv; float c, s; sincos_d(ang, c, s);
        ((float*)(F.ws + WS_ROPE))[i] = c; ((float*)(F.ws + WS_ROPE))[SEQ * 16 + i] = s; }
    for (int i = gt; i < 128 * 4; i += NT) { const int d = i >> 2, h = i & 3; ((float*)(F.ws + WS_TB))[i] = F.a->in[I_RELB][t5_bucket(d) * 4 + h]; }
    for (int it = gw; it < DEPTH * 2 * 16 * 4; it += NGW) { const int hb = it & 3, ks = (it >> 2) & 15, lb = it >> 6;
        const float* pos = F.a->in[I_CPOS] + (size_t)lb * 2048; const float* w1 = F.a->in[I_CW1] + (size_t)lb * 2048 * 256 + hb * 64 + F.lane; float a = 0.f;
        for (int k = ks * 128; k < ks * 128 + 128; ++k) a += pos[k] * w1[(size_t)k * 256];
        ((float*)(F.ws + WS_CB1))[(lb * 16 + ks) * 256 + hb * 64 + F.lane] = a; }
    for (int m = gw; m < M; m += NGW) rms_row_to_bf16(F.a->in[I_X] + (size_t)m * D, F.a->in[I_N1W], (bf16*)(F.ws + WS_XN) + (size_t)m * D, F.lane);
}
__device__ __forceinline__ void rms_phase(Frame F, const float* X, const float* w, bf16* O) {
    OPQ_V(F.lane); OPQ_S(X); OPQ_S(w); OPQ_S(O);
    const int gw = F.vcu * NWAVES + F.wave, NGW = F.G * NWAVES;
    for (int m = gw; m < M; m += NGW) rms_row_to_bf16(X + (size_t)m * D, w, O + (size_t)m * D, F.lane);
}

__device__ __forceinline__ void prep_phase(Frame F, int l) {
    OPQ_V(F.lane); OPQ_V(F.tid); OPQ_S(F.ws); OPQ_S(F.a);
    const int lane = F.lane; const int gw = F.vcu * NWAVES + F.wave, NGW = F.G * NWAVES;
    float* scr = (float*)(F.lds + RING_OFF + F.wave * 16384);
    float* cq = scr;
    float* ckv = scr + 384;
    float* qraw = scr + 640;
    float* kvraw = scr + 1408;
    float* krs = scr + 2432;
    const bf16* P = (const bf16*)(F.ws + WS_P);
    const float* qan = F.a->in[I_QAN] + l * 192; const float* kvn = F.a->in[I_KVN] + l * 128;
    const float* wq = F.a->in[I_WQB] + (size_t)l * 192 * 384; const float* wkv = F.a->in[I_WKVB] + (size_t)l * 128 * 512;
    const float* mqn = F.a->in[I_MQN] + l * 96; const float* mkn = F.a->in[I_MKN] + l * 96;
    const float* nqn = F.a->in[I_NQN] + l * 64; const float* nkn = F.a->in[I_NKN] + l * 192;
    const float* cw = F.a->in[I_CONVW] + l * 768; const float* cb = F.a->in[I_CONVB] + l * 256; const float* onw = F.a->in[I_ONW] + l * 1024;
    const float* cosT = (const float*)(F.ws + WS_ROPE); const float* sinT = cosT + SEQ * 16;
    bf16* QM = (bf16*)(F.ws + WS_QM); bf16* KM = (bf16*)(F.ws + WS_KM); bf16* VM = (bf16*)(F.ws + WS_VM);
    bf16* QN = (bf16*)(F.ws + WS_QN); bf16* KSn = (bf16*)(F.ws + WS_KS); bf16* KWn = (bf16*)(F.ws + WS_KW); bf16* Y = (bf16*)(F.ws + WS_Y);
    for (int task = gw; task < M / 2; task += NGW) {
        const int m0 = task * 2;
#pragma unroll
        for (int tk = 0; tk < 2; ++tk) { const bf16* pr = P + (size_t)(m0 + tk) * NP;
            float v0 = bf2f(pr[C_CQ + lane]), v1 = bf2f(pr[C_CQ + 64 + lane]), v2 = bf2f(pr[C_CQ + 128 + lane]);
            float rstd = 1.0f / sqrtf(wsum(v0 * v0 + v1 * v1 + v2 * v2) * (1.f / 192.f) + EPS);
            cq[tk * 192 + lane] = v0 * rstd * qan[lane]; cq[tk * 192 + 64 + lane] = v1 * rstd * qan[64 + lane]; cq[tk * 192 + 128 + lane] = v2 * rstd * qan[128 + lane];
            float u0 = bf2f(pr[C_CKV + lane]), u1 = bf2f(pr[C_CKV + 64 + lane]);
            rstd = 1.0f / sqrtf(wsum(u0 * u0 + u1 * u1) * (1.f / 128.f) + EPS);
            ckv[tk * 128 + lane] = u0 * rstd * kvn[lane]; ckv[tk * 128 + 64 + lane] = u1 * rstd * kvn[64 + lane];
            const int t = (m0 + tk) % SEQ;
            if (lane < 32) { const int i = lane & 15; const float c = cosT[t * 16 + i], s = sinT[t * 16 + i];
                const float x1 = bf2f(pr[C_KR + i]), x2 = bf2f(pr[C_KR + 16 + i]);
                krs[tk * 32 + lane] = lane < 16 ? x1 * c - x2 * s : x1 * s + x2 * c; } }
        LDS_WAIT(); asm volatile("" ::: "memory");
        { float a0[6], a1[6];
#pragma unroll
          for (int i = 0; i < 6; ++i) { a0[i] = 0.f; a1[i] = 0.f; }
          for (int k = 0; k < 192; ++k) { const float x0 = cq[k], x1 = cq[192 + k];
#pragma unroll
              for (int i = 0; i < 6; ++i) { const float w = wq[(size_t)k * 384 + lane + 64 * i]; a0[i] += x0 * w; a1[i] += x1 * w; } }
#pragma unroll
          for (int i = 0; i < 6; ++i) { qraw[lane + 64 * i] = a0[i]; qraw[384 + lane + 64 * i] = a1[i]; } }
        { float a0[8], a1[8];
#pragma unroll
          for (int i = 0; i < 8; ++i) { a0[i] = 0.f; a1[i] = 0.f; }
          for (int k = 0; k < 128; ++k) { const float x0 = ckv[k], x1 = ckv[128 + k];
#pragma unroll
              for (int i = 0; i < 8; ++i) { const float w = wkv[(size_t)k * 512 + lane + 64 * i]; a0[i] += x0 * w; a1[i] += x1 * w; } }
#pragma unroll
          for (int i = 0; i < 8; ++i) { kvraw[lane + 64 * i] = a0[i]; kvraw[512 + lane + 64 * i] = a1[i]; } }
        LDS_WAIT(); asm volatile("" ::: "memory");
#pragma unroll
        for (int tk = 0; tk < 2; ++tk) { const int m = m0 + tk, t = m % SEQ; const bf16* pr = P + (size_t)m * NP;
            const int i16 = lane & 15; const float c = cosT[t * 16 + i16], s = sinT[t * 16 + i16];
            for (int h = 0; h < 4; ++h) {
                const float* qh = qraw + tk * 384 + h * 96;
                const float qn_ = qh[lane];
                float qr_ = 0.f;
                if (lane < 32) { const float x1 = qh[64 + i16], x2 = qh[80 + i16]; qr_ = lane < 16 ? x1 * c - x2 * s : x1 * s + x2 * c; }
                float rstd = 1.0f / sqrtf(wsum(qn_ * qn_ + qr_ * qr_) * (1.f / 96.f) + EPS);
                bf16* qo = QM + ((size_t)m * 4 + h) * 96;
                qo[lane] = f2b(qn_ * rstd * mqn[lane]); if (lane < 32) qo[64 + lane] = f2b(qr_ * rstd * mqn[64 + lane]);
                const float kn_ = kvraw[tk * 512 + h * 128 + lane]; const float kr_ = lane < 32 ? krs[tk * 32 + lane] : 0.f;
                rstd = 1.0f / sqrtf(wsum(kn_ * kn_ + kr_ * kr_) * (1.f / 96.f) + EPS);
                bf16* ko = KM + ((size_t)m * 4 + h) * 96;
                ko[lane] = f2b(kn_ * rstd * mkn[lane]); if (lane < 32) ko[64 + lane] = f2b(kr_ * rstd * mkn[64 + lane]);
                VM[(size_t)m * 256 + h * 64 + lane] = f2b(kvraw[tk * 512 + h * 128 + 64 + lane]);
                const float nq = bf2f(pr[C_NQ + h * 64 + lane]);
                rstd = 1.0f / sqrtf(wsum(nq * nq) * (1.f / 64.f) + EPS);
                QN[(size_t)m * 256 + h * 64 + lane] = f2b(nq * rstd * nqn[lane]);
            }
            { const float ks = bf2f(pr[C_KS + lane]); float rstd = 1.0f / sqrtf(wsum(ks * ks) * (1.f / 64.f) + EPS); KSn[(size_t)m * 64 + lane] = f2b(ks * rstd * nkn[64 + lane]);
              const float kw = bf2f(pr[C_KW + lane]); rstd = 1.0f / sqrtf(wsum(kw * kw) * (1.f / 64.f) + EPS); KWn[(size_t)m * 64 + lane] = f2b(kw * rstd * nkn[128 + lane]); }
            { float ya[4]; float ss = 0.f;
#pragma unroll
              for (int i = 0; i < 4; ++i) { const int ch = lane + 64 * i;
                  const float v0 = bf2f(pr[C_AC + ch]) * bf2f(pr[C_AU + ch]);
                  const float v1 = t >= 1 ? bf2f(pr[C_AC + ch - NP]) * bf2f(pr[C_AU + ch - NP]) : 0.f;
                  const float v2 = t >= 2 ? bf2f(pr[C_AC + ch - 2 * NP]) * bf2f(pr[C_AU + ch - 2 * NP]) : 0.f;
                  const float y = cw[ch] * v2 + cw[256 + ch] * v1 + cw[512 + ch] * v0;
                  ya[i] = bf2f(pr[C_AB + ch]) * (y + cb[ch]); ss += ya[i] * ya[i]; }
              const float rstd = 1.0f / sqrtf(wsum(ss) * (1.f / 256.f) + EPS);
#pragma unroll
              for (int i = 0; i < 4; ++i) { const int ch = lane + 64 * i; Y[(size_t)m * D + ch] = f2b(ya[i] * rstd * onw[ch]); } }
        }
        LDS_WAIT(); asm volatile("" ::: "memory");
    }
    __syncthreads();
    {
        float* A = (float*)(F.lds + RING_OFF);
        float* hp = (float*)(F.lds + RING_OFF + 40960);
        float* hid = (float*)(F.lds + RING_OFF + 61440);
        const int tid = F.tid;
        for (int u = F.vcu; u < BATCH * 2 * 16; u += F.G) {
            const int g = u & 15, br = (u >> 4) & 1, b = u >> 5; const int n0 = 8 * g, nb = (NCMP - n0) < 8 ? (NCMP - n0) : 8, ntok = 16 * (nb - 1) + 32, tk0 = 16 * n0;
            const float* w1 = F.a->in[I_CW1] + (size_t)(l * 2 + br) * 2048 * 256; const float* w2 = F.a->in[I_CW2] + (size_t)(l * 2 + br) * 256 * 64;
            const float* cb1 = (const float*)(F.ws + WS_CB1) + (size_t)(l * 2 + br) * 16 * 256;
            for (int i = tid; i < 144 * 64; i += NWAVES * 64) { const int tt = i >> 6, d = i & 63; A[i] = tt < ntok ? bf2f(P[(size_t)(b * SEQ + tk0 + tt) * NP + (br ? C_VC : C_KC) + d]) : 0.f; }
            __syncthreads();
            { const int hc = tid & 255, kh = tid >> 8; float acc[8];
#pragma unroll
              for (int i = 0; i < 8; ++i) acc[i] = 0.f;
              for (int jj = 0; jj < 16; ++jj) { const int j = kh * 16 + jj;
                  for (int d = 0; d < 64; ++d) { const float w = w1[(size_t)(j * 64 + d) * 256 + hc];
#pragma unroll
                      for (int i = 0; i < 8; ++i) acc[i] += A[(16 * i + j) * 64 + d] * w; } }
#pragma unroll
              for (int i = 0; i < 8; ++i) hp[(kh * 8 + i) * 256 + hc] = acc[i]; }
            __syncthreads();
            { const int hc = tid & 255; float bsum = 0.f;
              for (int ks = 0; ks < 16; ++ks) bsum += cb1[ks * 256 + hc];
#pragma unroll
              for (int q = 0; q < 4; ++q) { const int i = (tid >> 8) + 2 * q; const float x = hp[i * 256 + hc] + hp[(8 + i) * 256 + hc] + bsum; hid[i * 256 + hc] = x / (1.0f + expf(-x)); } }
            __syncthreads();
            { const int i = F.wave; float o = 0.f;
              for (int hc = 0; hc < 256; ++hc) o += hid[i * 256 + hc] * w2[hc * 64 + lane];
              if (br == 0) { const float rstd = 1.0f / sqrtf(wsum(o * o) * (1.f / 64.f) + EPS); o = o * rstd * F.a->in[I_NKN][l * 192 + lane]; }
              if (i < nb) ((bf16*)(F.ws + WS_KCV))[(size_t)br * 65536 + (size_t)(b * 128 + n0 + i) * 64 + lane] = f2b(o); }
            __syncthreads();
        }
    }
}

template <int DK> __device__ __forceinline__ float dotq(const float* qs, const bf16* kr) {
    float acc = 0.f;
#pragma unroll
    for (int c = 0; c < DK / 8; ++c) { const v4u w = *(const v4u*)(kr + 8 * c); const f32x4 q0 = *(const f32x4*)(qs + 8 * c), q1 = *(const f32x4*)(qs + 8 * c + 4);
        acc += bflo(w.x) * q0.x + bfhi(w.x) * q0.y + bflo(w.y) * q0.z + bfhi(w.y) * q0.w + bflo(w.z) * q1.x + bfhi(w.z) * q1.y + bflo(w.w) * q1.z + bfhi(w.w) * q1.w; }
    return acc;
}
template <int DK, bool BIAS> __device__ __forceinline__ float row_attn(const float* qs, const bf16* Kb, int kstride, const bf16* Vb, int vstride, int t, int slo, unsigned cmask, float scale, const float* tbh, int lane) {
    float m = -INFINITY, l = 0.f, o = 0.f;
    cmask = (unsigned)__builtin_amdgcn_readfirstlane((int)cmask);
    while (cmask) { const int c = __builtin_ctz(cmask); cmask &= cmask - 1u;
        const int s = c * 64 + lane; const bool valid = (s <= t) && (s >= slo);
        float logit = -INFINITY;
        if (valid) { logit = dotq<DK>(qs, Kb + (size_t)s * kstride) * scale; if (BIAS) { const int dd = t - s; logit += tbh[(dd < 127 ? dd : 127) * 4]; } }
        const float mn = fmaxf(m, wmaxf(logit));
        if (mn == -INFINITY) continue;
        const float f = expf(m - mn), p = valid ? expf(logit - mn) : 0.f;
        l = l * f + wsum(p); o *= f;
        const int nv = (t - c * 64 + 1) < 64 ? (t - c * 64 + 1) : 64;
        for (int j = 0; j < nv; ++j) { const float pj = __shfl(p, j); o += pj * bf2f(Vb[(size_t)(c * 64 + j) * vstride + lane]); }
        m = mn; }
    return l > 0.f ? o / l : 0.f;
}
__device__ __forceinline__ void attn_phase_v1(Frame F, int l) {
    OPQ_V(F.lane); OPQ_V(F.tid); OPQ_S(F.ws); OPQ_S(F.a);
    const int lane = F.lane; const int gw = F.vcu * NWAVES + F.wave, NGW = F.G * NWAVES;
    float* scr = (float*)(F.lds + RING_OFF + F.wave * 16384);
    float* qs = scr;
    float* ps = scr + 128;
    float* ob = scr + 256;
    float* ocb = scr + 512;
    float* tb = (float*)(F.lds + TB_OFF);
    for (int i = F.tid; i < 512; i += NWAVES * 64) tb[i] = ((const float*)(F.ws + WS_TB))[i];
    __syncthreads();
    const bf16* P = (const bf16*)(F.ws + WS_P);
    const bf16* QM = (const bf16*)(F.ws + WS_QM); const bf16* KM = (const bf16*)(F.ws + WS_KM); const bf16* VM = (const bf16*)(F.ws + WS_VM);
    const bf16* QN = (const bf16*)(F.ws + WS_QN); const bf16* KSn = (const bf16*)(F.ws + WS_KS); const bf16* KWn = (const bf16*)(F.ws + WS_KW);
    const bf16* KC = (const bf16*)(F.ws + WS_KCV); const bf16* VC = KC + 65536;
    bf16* Y = (bf16*)(F.ws + WS_Y); const float* onw = F.a->in[I_ONW] + l * 1024;
    for (int task = gw; task < 3 * BATCH * SEQ; task += NGW) {
        const int uu = task % SEQ, k = task / SEQ, b = k % BATCH, mixer = k / BATCH, t = (k & 1) ? SEQ - 1 - uu : uu;
        const size_t m = (size_t)b * SEQ + t; const size_t mb = (size_t)b * SEQ;
        if (mixer == 0) {
            const unsigned cm = (t >> 6) == 31 ? 0xffffffffu : ((2u << (t >> 6)) - 1u);
            for (int h = 0; h < 4; ++h) {
                qs[lane] = bf2f(QM[(m * 4 + h) * 96 + lane]); if (lane < 32) qs[64 + lane] = bf2f(QM[(m * 4 + h) * 96 + 64 + lane]);
                LDS_WAIT(); asm volatile("" ::: "memory");
                ob[h * 64 + lane] = row_attn<96, false>(qs, KM + (mb * 4 + h) * 96, 384, VM + mb * 256 + h * 64, 256, t, 0, cm, 0.10206207261596577f, nullptr, lane);
                LDS_WAIT(); asm volatile("" ::: "memory");
            }
        } else if (mixer == 1) {
            for (int h = 0; h < 4; ++h) {
                qs[lane] = bf2f(P[m * NP + C_SQ + h * 64 + lane]);
                LDS_WAIT(); asm volatile("" ::: "memory");
                float carry = 0.f, acc = 0.f;
                for (int c = t >> 6; c >= 0; --c) { const int s = c * 64 + lane; const bool strict = s < t;
                    float z = 0.f, l1m = 0.f;
                    if (strict) { z = dotq<64>(qs, P + (mb + s) * NP + C_SK + h * 64) * 0.125f; l1m = -(fmaxf(z, 0.f) + log1pf(expf(-fabsf(z)))); }
                    float inc = l1m;
#pragma unroll
                    for (int ofs = 1; ofs < 64; ofs <<= 1) { const float y = __shfl_down(inc, ofs); if (lane + ofs < 64) inc += y; }
                    const float rem = carry + inc - l1m;
                    const float a = strict ? expf(z + l1m + rem) : 0.f;
                    carry += __shfl(inc, 0);
                    const int nv = (t - c * 64) < 64 ? (t - c * 64) : 64;
                    for (int j = 0; j < nv; ++j) { const float aj = __shfl(a, j); acc += aj * bf2f(P[(mb + c * 64 + j) * NP + C_SV + h * 64 + lane]); } }
                ob[h * 64 + lane] = acc;
                LDS_WAIT(); asm volatile("" ::: "memory");
            }
        } else {
            float ps0 = 0.f, ps1 = 0.f;
            const int tblk = t >> 6;
            for (int h = 0; h < 4; ++h) {
                qs[lane] = bf2f(QN[m * 256 + h * 64 + lane]);
                LDS_WAIT(); asm volatile("" ::: "memory");
                const int n0 = lane, n1 = lane + 64; const bool v0 = t >= 16 * n0 + 31, v1 = (n1 < NCMP) && (t >= 16 * n1 + 31);
                float l0 = -INFINITY, l1 = -INFINITY;
                if (v0) { const int dd = t - (16 * n0 + 31); l0 = dotq<64>(qs, KC + ((size_t)b * 128 + n0) * 64) * 0.125f + tb[(dd < 127 ? dd : 127) * 4 + h]; }
                if (v1) { const int dd = t - (16 * n1 + 31); l1 = dotq<64>(qs, KC + ((size_t)b * 128 + n1) * 64) * 0.125f + tb[(dd < 127 ? dd : 127) * 4 + h]; }
                const float mx = wmaxf(fmaxf(l0, l1));
                float p0 = 0.f, p1 = 0.f, oc = 0.f;
                if (mx > -INFINITY) { p0 = v0 ? expf(l0 - mx) : 0.f; p1 = v1 ? expf(l1 - mx) : 0.f; const float inv = 1.0f / wsum(p0 + p1); p0 *= inv; p1 *= inv;
                    const int nn = (t - 31) / 16 + 1 < NCMP ? (t - 31) / 16 + 1 : NCMP;
                    for (int j = 0; j < nn; ++j) { const float pj = j < 64 ? __shfl(p0, j) : __shfl(p1, j - 64); oc += pj * bf2f(VC[((size_t)b * 128 + j) * 64 + lane]); } }
                ocb[h * 64 + lane] = oc; ps0 += p0; ps1 += p1;
                LDS_WAIT(); asm volatile("" ::: "memory");
            }
            ps[lane] = ps0; ps[64 + lane] = (lane + 64 < NCMP) ? ps1 : 0.f;
            LDS_WAIT(); asm volatile("" ::: "memory");
            unsigned selmask;
            { const int j = lane & 31;
              float sc = ps[4 * j] + ps[4 * j + 1] + ps[4 * j + 2] + 0.5f * ((j > 0 ? ps[4 * j - 1] : 0.f) + ps[4 * j + 3]);
              const bool forced = (j == 0) || (j == tblk) || (j == tblk - 1); const bool validb = j <= tblk;
              sc = forced ? INFINITY : (validb ? sc : -INFINITY);
              int rank = 0;
              for (int jj = 0; jj < 32; ++jj) { const float so = __shfl(sc, jj); rank += (so > sc || (so == sc && jj < j)) ? 1 : 0; }
              const unsigned long long bal = __ballot(rank < 16 && validb);
              selmask = (unsigned)(bal & 0xffffffffull); }
            LDS_WAIT(); asm volatile("" ::: "memory");
            const int slo_w = t - 511 > 0 ? t - 511 : 0;
            unsigned wmask; { const int c0 = slo_w >> 6; const unsigned upto = tblk == 31 ? 0xffffffffu : ((2u << tblk) - 1u); wmask = upto & ~((1u << c0) - 1u); }
            for (int h = 0; h < 4; ++h) {
                qs[lane] = bf2f(QN[m * 256 + h * 64 + lane]);
                LDS_WAIT(); asm volatile("" ::: "memory");
                const float os = row_attn<64, true>(qs, KSn + mb * 64, 64, P + mb * NP + C_VS, NP, t, 0, selmask, 0.125f, tb + h, lane);
                const float ow = row_attn<64, true>(qs, KWn + mb * 64, 64, P + mb * NP + C_VW, NP, t, slo_w, wmask, 0.125f, tb + h, lane);
                const float g0 = 1.0f / (1.0f + expf(-bf2f(P[m * NP + C_NG + h * 3 + 0]))), g1 = 1.0f / (1.0f + expf(-bf2f(P[m * NP + C_NG + h * 3 + 1]))), g2 = 1.0f / (1.0f + expf(-bf2f(P[m * NP + C_NG + h * 3 + 2])));
                ob[h * 64 + lane] = g0 * ocb[h * 64 + lane] + g1 * os + g2 * ow;
                LDS_WAIT(); asm volatile("" ::: "memory");
            }
        }
        const int gcol = mixer == 0 ? 512 : (mixer == 1 ? 768 : 256);
        LDS_WAIT(); asm volatile("" ::: "memory");
        const float o0 = ob[lane], o1 = ob[64 + lane], o2 = ob[128 + lane], o3 = ob[192 + lane];
        const float rstd = 1.0f / sqrtf(wsum(o0 * o0 + o1 * o1 + o2 * o2 + o3 * o3) * (1.f / 256.f) + EPS);
        Y[m * D + gcol + lane] = f2b(o0 * rstd * onw[gcol + lane]); Y[m * D + gcol + 64 + lane] = f2b(o1 * rstd * onw[gcol + 64 + lane]);
        Y[m * D + gcol + 128 + lane] = f2b(o2 * rstd * onw[gcol + 128 + lane]); Y[m * D + gcol + 192 + lane] = f2b(o3 * rstd * onw[gcol + 192 + lane]);
        LDS_WAIT(); asm volatile("" ::: "memory");
    }
}

constexpr int NPH = 1 + DEPTH * 8;
__global__ void __launch_bounds__(NWAVES * 64, 2) fwd(Args args) {
    extern __shared__ __attribute__((aligned(16))) unsigned char lds[];
    Frame F;
    F.lds = lds; F.tid = threadIdx.x; F.lane = F.tid & 63; F.wave = __builtin_amdgcn_readfirstlane(F.tid >> 6);
    F.G = gridDim.x; { const int bx = blockIdx.x; F.vcu = (F.G % 8 == 0) ? (bx % 8) * (F.G / 8) + bx / 8 : bx; }
    F.a = (ArgsP)__builtin_amdgcn_kernarg_segment_ptr(); F.ws = args.ws;
    for (int u = F.tid; u < (LDS_BYTES - LDSCTL_OFF) / 4; u += NWAVES * 64) ((unsigned*)(lds + LDSCTL_OFF))[u] = 0u;
    __syncthreads();
    XcdBarrier bar; bar.bar = (unsigned*)(args.ws + WS_CTL) + 1024; bar.x = 0; bar.st = nullptr;
    if (MK_ONE_LAUNCH) bar = xcd_barrier_post((unsigned*)(args.ws + WS_CTL) + 1024, (volatile LAS unsigned*)(lds + MISC_OFF) + 8);
    const int lo = args.ph_lo, hi = args.ph_hi;
#define IN(k) (lo <= (k) && (k) < hi)
#define SEAM() do { if (MK_ONE_LAUNCH) { XcdBarrier b2_ = bar; OPQ_S(b2_.bar); xcd_barrier(b2_); } } while (0)
    LAS unsigned char* ldsl = (LAS unsigned char*)lds;
    if (IN(0)) { p0_prologue(F); SEAM(); }
    for (int l = 0; l < DEPTH; ++l) {
        const int pb = 1 + 8 * l;
        if (IN(pb + 0)) {
            unsigned char* ws = args.ws; OPQ_S(ws); bf16* XN = (bf16*)(ws + WS_XN); bf16* Pb = (bf16*)(ws + WS_P);
            pg8::Gemm g{XN, (const bf16*)(ws + WS_WIN) + (size_t)l * NP * D, M, NP, D}; pg8::StaticOrder S; S.init(M, NP, F.G, (int)blockIdx.x);
            pg8::EpiBf16S<0> E{Pb, NP, nullptr};
            pg8::gemm_phase<pg8::EpiBf16S<0>, pg8::StaticOrder, PG8_ALIGN, PG8_SP2>(ldsl + RING_OFF, g, S, E);
            SEAM(); }
        if (IN(pb + 1)) { prep_phase(F, l); SEAM(); }
        if (IN(pb + 2)) { attn_phase_v1(F, l); SEAM(); }
        if (IN(pb + 3)) {
            unsigned char* ws = args.ws; OPQ_S(ws); bf16* Yb = (bf16*)(ws + WS_Y);
            pg8::Gemm g{Yb, (const bf16*)(ws + WS_WO) + (size_t)l * D * D, M, D, D}; pg8::StaticOrder S; S.init(M, D, F.G, (int)blockIdx.x);
            pg8::EpiResF32 E{l == 0 ? args.in[I_X] : args.out, args.out, D};
            pg8::gemm_phase<pg8::EpiResF32, pg8::StaticOrder, PG8_ALIGN, PG8_SP2>(ldsl + RING_OFF, g, S, E);
            SEAM(); }
        if (IN(pb + 4)) { rms_phase(F, args.out, args.in[I_N2W] + l * D, (bf16*)(args.ws + WS_XN)); SEAM(); }
        if (IN(pb + 5)) {
            unsigned char* ws = args.ws; OPQ_S(ws); bf16* XN = (bf16*)(ws + WS_XN); bf16* Hb = (bf16*)(ws + WS_H);
            pg8::Gemm g{XN, (const bf16*)(ws + WS_W1) + (size_t)l * FF * D, M, FF, D}; pg8::StaticOrder S; S.init(M, FF, F.G, (int)blockIdx.x);
            pg8::EpiBf16S<2> E{Hb, FF, nullptr};
            pg8::gemm_phase<pg8::EpiBf16S<2>, pg8::StaticOrder, PG8_ALIGN, PG8_SP2>(ldsl + RING_OFF, g, S, E);
            SEAM(); }
        if (IN(pb + 6)) {
            unsigned char* ws = args.ws; OPQ_S(ws); bf16* Hb = (bf16*)(ws + WS_H);
            pg8::Gemm g{Hb, (const bf16*)(ws + WS_W2) + (size_t)l * D * FF, M, D, FF}; pg8::StaticOrder S; S.init(M, D, F.G, (int)blockIdx.x);
            pg8::EpiResF32 E{args.out, args.out, D};
            pg8::gemm_phase<pg8::EpiResF32, pg8::StaticOrder, PG8_ALIGN, PG8_SP2>(ldsl + RING_OFF, g, S, E);
            if (l + 1 < DEPTH) SEAM(); }
        if (IN(pb + 7)) { if (l + 1 < DEPTH) { rms_phase(F, args.out, args.in[I_N1W] + (l + 1) * D, (bf16*)(args.ws + WS_XN)); SEAM(); } }
    }
#undef IN
#undef SEAM
}

extern "C" void kernel_launch(void* const* d_in, const int* in_sizes, int n_in, void* d_out, int out_size, void* d_ws, size_t ws_size, hipStream_t stream) {
    static int grid = 0;
    if (grid == 0) {
        if (n_in != N_INPUTS || in_sizes[0] != M * D || out_size != M * D || ws_size < WS_END) { fprintf(stderr, "kernel_launch: unexpected shapes (n_in %d, in0 %d, out %d, ws %zu); nothing launched\n", n_in, n_in > 0 ? in_sizes[0] : -1, out_size, ws_size); grid = -1; return; }
        int dev = 0, cus = 0, per_cu = 0;
        if (hipGetDevice(&dev) != hipSuccess || hipDeviceGetAttribute(&cus, hipDeviceAttributeMultiprocessorCount, dev) != hipSuccess) { grid = -1; return; }
        if (hipFuncSetAttribute((const void*)fwd, hipFuncAttributeMaxDynamicSharedMemorySize, LDS_BYTES) != hipSuccess) { fprintf(stderr, "kernel_launch: hipFuncSetAttribute failed\n"); grid = -1; return; }
        if (hipOccupancyMaxActiveBlocksPerMultiprocessor(&per_cu, (const void*)fwd, NWAVES * 64, LDS_BYTES) != hipSuccess || per_cu < 1) { fprintf(stderr, "kernel_launch: occupancy query reports %d\n", per_cu); }
        (void)hipGetLastError();
        grid = cus;
    }
    if (grid < 0) return;
    if (hipMemsetAsync((char*)d_ws + WS_CTL, 0, CTL_ZERO_BYTES, stream) != hipSuccess) return;
    Args a{};
    for (int i = 0; i < N_INPUTS; ++i) a.in[i] = (const float*)d_in[i];
    a.out = (float*)d_out; a.ws = (unsigned char*)d_ws;
#if MK_ONE_LAUNCH
    a.ph_lo = 0; a.ph_hi = NPH;
    hipLaunchKernelGGL(fwd, dim3(grid), dim3(NWAVES * 64), LDS_BYTES, stream, a);
#else
    for (int p = 0; p < NPH; ++p) { a.ph_lo = p; a.ph_hi = p + 1; hipLaunchKernelGGL(fwd, dim3(grid), dim3(NWAVES * 64), LDS_BYTES, stream, a); }
#endif
}
```

```cpp
#include <hip/hip_runtime.h>
#include <cstdio>
#include <cstdint>
#include <cmath>
namespace pg8 {
#ifndef PROBE_TIME_MASK
#define PROBE_TIME_MASK 0u
#endif
#define PG8_PROBE(k) do { if (PROBE_TIME_MASK != 0u) { if (wid == 0 && lane == 0) { volatile PG8_LAS unsigned long long* T_ = (volatile PG8_LAS unsigned long long*)(lds - lds_base_off_ + 131072 + 320 + 128); const unsigned long long now_ = __builtin_amdgcn_s_memrealtime(); if ((PROBE_TIME_MASK >> (k)) & 1u) T_[1] += now_ - T_[0]; T_[0] = now_; } } } while (0)
#define PG8_LAS __attribute__((address_space(3)))
typedef unsigned short bf16_t;
typedef short bf16x8 __attribute__((ext_vector_type(8)));
typedef float f32x4 __attribute__((ext_vector_type(4)));
typedef unsigned u32x4 __attribute__((ext_vector_type(4)));
constexpr int BM = 256, BK = 64, HALF = 128, HTB = HALF * BK * 2  , STAGE_BYTES = 8 * HTB, NXCD = 8, WGM = 8;

__host__ __device__ __forceinline__ int lds_byte(int r, int c) { const int st = (r >> 4) * 2 + (c >> 5), rr = r & 15, cc = c & 31, ob = rr * 64 + cc * 2; return st * 1024 + (ob ^ (((ob >> 9) & 1) << 5)); }
__host__ __device__ __forceinline__ void stage_rc(int b, int& R, int& C) { const int st = b / 1024, sb = b % 1024, swz = sb ^ (((sb >> 9) & 1) << 5); R = (st >> 1) * 16 + swz / 64; C = (st & 1) * 32 + (swz % 64) / 2; }
__host__ __device__ __forceinline__ int perm32(int rho) { const int n = rho >> 4, i = rho & 15; return 8 * (i >> 2) + 4 * n + (i & 3); }

struct Unit { int pm, pn, idx; };
struct Gemm { const bf16_t* A; const bf16_t* Bt; int M, N, K; };

struct StaticOrder {
    int nM, nN, nwg, G, c;
    __host__ __device__ __forceinline__ void init(int M, int N, int G_, int c_) { nM = M / BM; nN = N / BM; nwg = nM * nN; G = G_; c = c_; }
    __host__ __device__ __forceinline__ bool next(int i, Unit& u) const {
        const long L = (long)i * G + c; if (L >= nwg) return false;
        int wgid = (int)L; { const int q = nwg / NXCD, r = nwg % NXCD, xcd = wgid % NXCD, off = wgid / NXCD; wgid = (xcd < r ? xcd * (q + 1) : r * (q + 1) + (xcd - r) * q) + off; }
        const int nig = WGM * nN, gid = wgid / nig, fm = gid * WGM, gsz = (nM - fm) < WGM ? (nM - fm) : WGM;
        u.pm = fm + ((wgid % nig) % gsz); u.pn = (wgid % nig) / gsz; u.idx = i; return true;
    }
    __device__ __forceinline__ void a_ready(const Unit&) const {}
    __device__ __forceinline__ void done(const Unit&) const {}
};

__device__ __forceinline__ unsigned cvt_pk_bf16(float lo, float hi) { unsigned r; asm volatile("v_cvt_pk_bf16_f32 %0, %1, %2" : "=v"(r) : "v"(lo), "v"(hi)); return r; }
typedef float f32x2 __attribute__((ext_vector_type(2)));
__device__ __forceinline__ f32x2 gelu_pk(f32x2 v) {
    const f32x2 av = __builtin_elementwise_abs(v), d = av * 0.2316418882f + 1.0f;
    f32x2 t; t.x = __builtin_amdgcn_rcpf(d.x); t.y = __builtin_amdgcn_rcpf(d.y);
    f32x2 q = t * 0.5307027145f + (-0.7265760135f); q = q * t + 0.7107068705f; q = q * t + (-0.142248368f); q = q * t + 0.127414796f; q = q * t;
    const f32x2 s = (v * v) * (-0.72134752044f);
    f32x2 e; e.x = __builtin_amdgcn_exp2f(s.x); e.y = __builtin_amdgcn_exp2f(s.y);
    const f32x2 m = v * (q * e), r = v - m;
    f32x2 o; o.x = v.x < 0.f ? m.x : r.x; o.y = v.y < 0.f ? m.y : r.y; return o;
}

template <int ACT  > struct EpiBf16 {
    static constexpr bool PERM = true, AFTER_DRAIN = false; static_assert(ACT == 0 || ACT == 1, "EpiBf16: ACT is 0 (none) or 1 (gelu_pk)");
    bf16_t* O; int ldc; const float* bias; int split_cols; size_t split_stride; float scale0;
    __device__ __forceinline__ void operator()(const f32x4 (&acc)[2][2][4][2], const Unit& u, int wr, int wc, int fr, int fq) const {
        const int row0 = u.pm * BM + wr * 64 + fr; int colt = u.pn * BM; bf16_t* base = O;
        float sc = 1.f; if (split_cols) { const int t = colt / split_cols; base += (size_t)t * split_stride; colt -= t * split_cols; if (t == 0) sc = scale0; }
        const int col0 = colt + wc * 32 + 8 * fq, bcol0 = u.pn * BM + wc * 32 + 8 * fq;
        f32x4 bv[2][2];
#pragma unroll
        for (int bj = 0; bj < 2; ++bj)
#pragma unroll
            for (int n = 0; n < 2; ++n) bv[bj][n] = bias ? *(const f32x4*)(bias + bcol0 + bj * HALF + 4 * n) : (f32x4){0.f, 0.f, 0.f, 0.f};
#pragma unroll
        for (int ai = 0; ai < 2; ++ai)
#pragma unroll
            for (int m = 0; m < 4; ++m) { bf16_t* rowp = base + (size_t)(row0 + ai * HALF + m * 16) * ldc + col0;
#pragma unroll
                for (int bj = 0; bj < 2; ++bj) { f32x4 v0 = acc[ai][bj][m][0] + bv[bj][0], v1 = acc[ai][bj][m][1] + bv[bj][1];
                    if (ACT == 1) { f32x2 a = gelu_pk((f32x2){v0[0], v0[1]}), b = gelu_pk((f32x2){v0[2], v0[3]}), c = gelu_pk((f32x2){v1[0], v1[1]}), d = gelu_pk((f32x2){v1[2], v1[3]});
                        v0 = (f32x4){a.x, a.y, b.x, b.y}; v1 = (f32x4){c.x, c.y, d.x, d.y}; }
                    v0 = v0 * sc; v1 = v1 * sc; u32x4 w; w.x = cvt_pk_bf16(v0[0], v0[1]); w.y = cvt_pk_bf16(v0[2], v0[3]); w.z = cvt_pk_bf16(v1[0], v1[1]); w.w = cvt_pk_bf16(v1[2], v1[3]);
                    *(u32x4*)(rowp + bj * HALF) = w; } }
    }
};

template <class Epi, class Sched, bool ALIGN_EPI = false, bool SP2 = false>
__device__ __forceinline__ void gemm_phase(PG8_LAS unsigned char* lds, const Gemm g, const Sched& S, const Epi& E, const int wave_index) {
    int tid_; asm volatile("v_mbcnt_lo_u32_b32 %0, -1, 0\n\tv_mbcnt_hi_u32_b32 %0, -1, %0" : "=v"(tid_)); tid_ += wave_index * 64;
    const int tid = tid_, wid = __builtin_amdgcn_readfirstlane(tid >> 6), lane = tid & 63, wr = wid >> 2, wc = wid & 3, fr = lane & 15, fq = lane >> 4;
    const int K = g.K, nt = K / BK; constexpr int lds_base_off_ = 0;
    unsigned voffA[2], voffB[2];
#pragma unroll
    for (int i = 0; i < 2; ++i) { int R, C; stage_rc(tid * 16 + i * 8192, R, C); const int Rb = Epi::PERM ? ((R & ~31) + perm32(R & 31)) : R;
        voffA[i] = (unsigned)(R * K + C) * 2u; voffB[i] = (unsigned)(Rb * K + C) * 2u; }
    const size_t kstep = (size_t)(BK * 2);
    const size_t hstep = (size_t)HALF * K * 2;
    const size_t tstep = 2 * hstep;
    const unsigned ldsw = (unsigned)wid * 1024u;
    const int aoff = lds_byte(wr * 64 + fr, fq * 8), boff = lds_byte(wc * 32 + fr, fq * 8);
#define PG8_SA(b, h) (((b) * 2 + (h)) * HTB)
#define PG8_SB(b, h) ((4 + (b) * 2 + (h)) * HTB)
#define PG8_STAGE(bufoff, gbase, voff) do { _Pragma("unroll") for (int _i = 0; _i < 2; ++_i) \
        __builtin_amdgcn_global_load_lds((const unsigned*)((const char*)(gbase) + (voff)[_i]), (PG8_LAS unsigned*)(lds + (bufoff) + ldsw + _i * 8192), 16, 0, 0); } while (0)
#define PG8_LDA(dst, b, h) do { _Pragma("unroll") for (int m = 0; m < 4; ++m) _Pragma("unroll") for (int k = 0; k < 2; ++k) dst[m][k] = *(const PG8_LAS bf16x8*)(lds + PG8_SA(b, h) + aoff + m * 2048 + k * 1024); } while (0)
#define PG8_LDB(dst, b, h) do { _Pragma("unroll") for (int n = 0; n < 2; ++n) _Pragma("unroll") for (int k = 0; k < 2; ++k) dst[n][k] = *(const PG8_LAS bf16x8*)(lds + PG8_SB(b, h) + boff + n * 2048 + k * 1024); } while (0)
#define PG8_MMA(ai, bj, At, Bt) do { __builtin_amdgcn_s_setprio(1); _Pragma("unroll") for (int m = 0; m < 4; ++m) _Pragma("unroll") for (int n = 0; n < 2; ++n) _Pragma("unroll") for (int k = 0; k < 2; ++k) \
        acc[ai][bj][m][n] = __builtin_amdgcn_mfma_f32_16x16x32_bf16(Bt[n][k], At[m][k], acc[ai][bj][m][n], 0, 0, 0); __builtin_amdgcn_s_setprio(0); } while (0)
#define PG8_WAIT_V(n) asm volatile("s_waitcnt vmcnt(" #n ")" ::: "memory")
#define PG8_WAIT_L(n) asm volatile("s_waitcnt lgkmcnt(" #n ")" ::: "memory")
#define PG8_BAR __builtin_amdgcn_s_barrier()
#define PG8_SCHED __builtin_amdgcn_sched_barrier(0)
    Unit cur, nxt; int ui = 0;
    if (!S.next(0, cur)) return;
    f32x4 acc[2][2][4][2];
#pragma unroll
    for (int a = 0; a < 2; ++a)
#pragma unroll
        for (int b = 0; b < 2; ++b)
#pragma unroll
            for (int m = 0; m < 4; ++m)
#pragma unroll
                for (int n = 0; n < 2; ++n) acc[a][b][m][n] = (f32x4){0.f, 0.f, 0.f, 0.f};
    bf16x8 At[4][2], B0[2][2], B1[2][2];
    const char* cA = (const char*)g.A + (size_t)cur.pm * tstep; const char* cB = (const char*)g.Bt + (size_t)cur.pn * tstep;
    S.a_ready(cur);
    if constexpr (SP2) {
        PG8_STAGE(PG8_SB(0, 0), cB, voffB); PG8_STAGE(PG8_SB(0, 1), cB + hstep, voffB); PG8_STAGE(PG8_SA(0, 0), cA, voffA); PG8_STAGE(PG8_SA(0, 1), cA + hstep, voffA);
        if (wr == 1) PG8_BAR;
        PG8_WAIT_V(2); PG8_BAR;
        PG8_STAGE(PG8_SB(1, 0), cB + kstep, voffB); PG8_STAGE(PG8_SA(1, 0), cA + kstep, voffA); PG8_STAGE(PG8_SB(1, 1), cB + hstep + kstep, voffB);
        PG8_WAIT_V(6); PG8_BAR;
    } else {
        PG8_STAGE(PG8_SB(0, 0), cB, voffB); PG8_STAGE(PG8_SA(0, 0), cA, voffA); PG8_STAGE(PG8_SB(0, 1), cB + hstep, voffB); PG8_STAGE(PG8_SA(0, 1), cA + hstep, voffA);
        if (wr == 1) PG8_BAR;
        PG8_WAIT_V(4); PG8_BAR;
        PG8_STAGE(PG8_SB(1, 0), cB + kstep, voffB); PG8_STAGE(PG8_SA(1, 0), cA + kstep, voffA); PG8_STAGE(PG8_SB(1, 1), cB + hstep + kstep, voffB);
        PG8_WAIT_V(6); PG8_BAR;
    }
    for (;;) {
        const bool has_next = S.next(ui + 1, nxt);
        const char* nA = has_next ? (const char*)g.A + (size_t)nxt.pm * tstep : cA; const char* nB = has_next ? (const char*)g.Bt + (size_t)nxt.pn * tstep : cB;
        for (int t = 0; t < nt; t += 2) {
            const bool last = (t == nt - 2);
            const char* a1 = cA + (size_t)(t + 1) * kstep;
            const char* a2 = last ? nA : cA + (size_t)(t + 2) * kstep; const char* b2 = last ? nB : cB + (size_t)(t + 2) * kstep;
            const char* a3 = a2 + kstep; const char* b3 = b2 + kstep;
            if (last && has_next) S.a_ready(nxt);
            if constexpr (SP2) {
            PG8_LDB(B0, 0, 0); PG8_LDB(B1, 0, 1); PG8_SCHED; PG8_LDA(At, 0, 0); PG8_STAGE(PG8_SA(1, 1), a1 + hstep, voffA);
            PG8_WAIT_V(8); PG8_WAIT_L(0); PG8_BAR; PG8_MMA(0, 0, At, B0); PG8_MMA(0, 1, At, B1); PG8_BAR; PG8_SCHED;
            PG8_LDA(At, 0, 1); PG8_STAGE(PG8_SB(0, 0), b2, voffB); PG8_STAGE(PG8_SB(0, 1), b2 + hstep, voffB); PG8_STAGE(PG8_SA(0, 0), a2, voffA);
            PG8_WAIT_V(8); PG8_WAIT_L(0); PG8_BAR; PG8_MMA(1, 0, At, B0); PG8_MMA(1, 1, At, B1); PG8_BAR; PG8_SCHED;
            PG8_LDB(B0, 1, 0); PG8_LDB(B1, 1, 1); PG8_SCHED; PG8_LDA(At, 1, 0); PG8_STAGE(PG8_SA(0, 1), a2 + hstep, voffA);
            PG8_WAIT_V(8); PG8_WAIT_L(0); PG8_BAR; PG8_MMA(0, 0, At, B0); PG8_MMA(0, 1, At, B1); PG8_BAR; PG8_SCHED;
            PG8_LDA(At, 1, 1); PG8_STAGE(PG8_SB(1, 0), b3, voffB); PG8_STAGE(PG8_SB(1, 1), b3 + hstep, voffB); PG8_STAGE(PG8_SA(1, 0), a3, voffA);
            PG8_WAIT_V(8); PG8_WAIT_L(0); PG8_BAR; PG8_MMA(1, 0, At, B0); PG8_MMA(1, 1, At, B1); PG8_BAR; PG8_SCHED;
            if constexpr (Epi::KSCALE) { if (t + 2 == 8 || t + 2 == 12) E.kscale(acc, t + 2 == 8 ? 0 : 1, wr, fr); }
            } else {
            PG8_LDB(B0, 0, 0); PG8_SCHED; PG8_LDA(At, 0, 0); PG8_STAGE(PG8_SA(1, 1), a1 + hstep, voffA);
            PG8_WAIT_L(8); PG8_BAR; PG8_WAIT_L(0); PG8_MMA(0, 0, At, B0); PG8_BAR; PG8_SCHED;
            PG8_LDB(B1, 0, 1); PG8_STAGE(PG8_SB(0, 0), b2, voffB);
            PG8_BAR; PG8_WAIT_L(0); PG8_MMA(0, 1, At, B1); PG8_BAR;
            PG8_LDA(At, 0, 1); PG8_STAGE(PG8_SA(0, 0), a2, voffA);
            PG8_BAR; PG8_WAIT_L(0); PG8_MMA(1, 0, At, B0); PG8_BAR; PG8_SCHED;
            PG8_STAGE(PG8_SB(0, 1), b2 + hstep, voffB);
            PG8_WAIT_V(6); PG8_BAR; PG8_MMA(1, 1, At, B1); PG8_BAR;
            PG8_LDB(B0, 1, 0); PG8_SCHED; PG8_LDA(At, 1, 0); PG8_STAGE(PG8_SA(0, 1), a2 + hstep, voffA);
            PG8_WAIT_L(8); PG8_BAR; PG8_WAIT_L(0); PG8_MMA(0, 0, At, B0); PG8_BAR; PG8_SCHED;
            PG8_LDB(B1, 1, 1); PG8_STAGE(PG8_SB(1, 0), b3, voffB);
            PG8_BAR; PG8_WAIT_L(0); PG8_MMA(0, 1, At, B1); PG8_BAR;
            PG8_LDA(At, 1, 1); PG8_STAGE(PG8_SA(1, 0), a3, voffA);
            PG8_BAR; PG8_WAIT_L(0); PG8_MMA(1, 0, At, B0); PG8_BAR; PG8_SCHED;
            PG8_STAGE(PG8_SB(1, 1), b3 + hstep, voffB);
            PG8_WAIT_V(6); PG8_BAR; PG8_MMA(1, 1, At, B1); PG8_BAR;
            }
        }
        if constexpr (ALIGN_EPI) { if (wr == 0) PG8_BAR; }
        if constexpr (!Epi::AFTER_DRAIN) { PG8_PROBE(30); E(acc, cur, wr, wc, fr, fq); S.done(cur); PG8_PROBE(31); }
        if (!has_next) break;
#pragma unroll
        for (int a = 0; a < 2; ++a)
#pragma unroll
            for (int b = 0; b < 2; ++b)
#pragma unroll
                for (int m = 0; m < 4; ++m)
#pragma unroll
                    for (int n = 0; n < 2; ++n) acc[a][b][m][n] = (f32x4){0.f, 0.f, 0.f, 0.f};
        cur = nxt; cA = nA; cB = nB; ++ui;
        if constexpr (ALIGN_EPI) { if (wr == 1) PG8_BAR; }
    }
    PG8_WAIT_V(0);
    if constexpr (!ALIGN_EPI) { if (wr == 0) PG8_BAR; }
    PG8_BAR;
    if constexpr (Epi::AFTER_DRAIN) { E.fused(acc, cur, wr, wc, fr, fq, lds, wid, lane); S.done(cur); }
#undef PG8_SA
#undef PG8_SB
#undef PG8_STAGE
#undef PG8_LDA
#undef PG8_LDB
#undef PG8_MMA
#undef PG8_WAIT_V
#undef PG8_WAIT_L
#undef PG8_BAR
#undef PG8_SCHED
}
}

#ifndef PG8_SP2
#define PG8_SP2 true
#endif
#ifndef PG8_ALIGN
#define PG8_ALIGN true
#endif
namespace pg8 {
template <int ACT> struct EpiBf16S {
    static constexpr bool PERM = true, AFTER_DRAIN = false, KSCALE = false;
    bf16_t* O; int ldc; const PG8_LAS float* rsT;
    __device__ __forceinline__ void operator()(const f32x4 (&acc)[2][2][4][2], const Unit& u, int wr, int wc, int fr, int fq) const {
        const int row0 = u.pm * BM + wr * 64 + fr, col0 = u.pn * BM + wc * 32 + 8 * fq;
        const PG8_LAS float* rs = rsT + u.idx * 256 + wr * 64 + fr;
#pragma unroll
        for (int ai = 0; ai < 2; ++ai)
#pragma unroll
            for (int m = 0; m < 4; ++m) { const int r = row0 + ai * HALF + m * 16; const float s = rs[ai * HALF + m * 16]; bf16_t* rowp = O + (size_t)r * ldc + col0;
#pragma unroll
                for (int bj = 0; bj < 2; ++bj) { f32x4 v0 = acc[ai][bj][m][0] * s, v1 = acc[ai][bj][m][1] * s;
                    if (ACT == 2) {
#pragma unroll
                        for (int e = 0; e < 4; ++e) { const float a = fmaxf(v0[e], 0.f), b = fmaxf(v1[e], 0.f); v0[e] = a * a; v1[e] = b * b; } }
                    u32x4 w; w.x = cvt_pk_bf16(v0[0], v0[1]); w.y = cvt_pk_bf16(v0[2], v0[3]); w.z = cvt_pk_bf16(v1[0], v1[1]); w.w = cvt_pk_bf16(v1[2], v1[3]);
                    *(u32x4*)(rowp + bj * HALF) = w; } }
    }
};
template <bool F32OUT, bool GN = false> struct EpiResNorm {
    static constexpr bool PERM = false, AFTER_DRAIN = true, KSCALE = GN;
    float* out; bf16_t* xb; float* ssq4; int ldc; const PG8_LAS float* ks;
    __device__ __forceinline__ void kscale(f32x4 (&acc)[2][2][4][2], int which, int wr, int fr) const {
        const PG8_LAS float* kp = ks + which * 256 + wr * 64 + fr;
        float fk[2][4];
#pragma unroll
        for (int ai = 0; ai < 2; ++ai)
#pragma unroll
            for (int m = 0; m < 4; ++m) fk[ai][m] = kp[ai * HALF + m * 16];
#pragma unroll
        for (int ai = 0; ai < 2; ++ai)
#pragma unroll
            for (int m = 0; m < 4; ++m)
#pragma unroll
                for (int bj = 0; bj < 2; ++bj)
#pragma unroll
                    for (int n = 0; n < 2; ++n) acc[ai][bj][m][n] *= fk[ai][m];
    }
    __device__ __forceinline__ void fused(f32x4 (&acc)[2][2][4][2], const Unit& u, int wr, int wc, int fr, int fq, PG8_LAS unsigned char* lds, int wid, int lane) const {
        PG8_LAS float* Pss = (PG8_LAS float*)lds;
        const int col0 = u.pn * BM + wc * 32 + 4 * fq;
        if (GN) kscale(acc, 2, wr, fr);
#pragma unroll
        for (int ai = 0; ai < 2; ++ai) {
            uint2 bs[4][2][2];
#pragma unroll
            for (int m = 0; m < 4; ++m) { const size_t off = (size_t)(u.pm * BM + ai * HALF + wr * 64 + m * 16 + fr) * ldc + col0;
#pragma unroll
                for (int bj = 0; bj < 2; ++bj)
#pragma unroll
                    for (int n = 0; n < 2; ++n) bs[m][bj][n] = *(const uint2*)(xb + off + bj * HALF + n * 16); }
#pragma unroll
            for (int m = 0; m < 4; ++m) { const int r = ai * HALF + wr * 64 + m * 16 + fr; const size_t off = (size_t)(u.pm * BM + r) * ldc + col0; float s = 0.f;
#pragma unroll
                for (int bj = 0; bj < 2; ++bj)
#pragma unroll
                    for (int n = 0; n < 2; ++n) { const uint2 b2 = bs[m][bj][n];
                        const f32x4 bsv = (f32x4){__uint_as_float(b2.x << 16), __uint_as_float(b2.x & 0xffff0000u), __uint_as_float(b2.y << 16), __uint_as_float(b2.y & 0xffff0000u)};
                        const f32x4 o = bsv + acc[ai][bj][m][n];
                        if (F32OUT) *(f32x4*)(out + off + bj * HALF + n * 16) = o;
                        else { uint2 w; w.x = cvt_pk_bf16(o[0], o[1]); w.y = cvt_pk_bf16(o[2], o[3]); *(uint2*)(xb + off + bj * HALF + n * 16) = w; s += (o[0] * o[0] + o[1] * o[1]) + (o[2] * o[2] + o[3] * o[3]); } }
                if (!F32OUT) { s += __shfl_xor(s, 16); s += __shfl_xor(s, 32); if (fq == 0) Pss[r * 4 + wc] = s; } }
            asm volatile("" ::: "memory");
        }
        if (!F32OUT) { asm volatile("s_waitcnt lgkmcnt(0)" ::: "memory"); __builtin_amdgcn_s_barrier(); asm volatile("" ::: "memory");
            const int t = wid * 64 + lane;
            if (t < 256) { const f32x4 p = *(const PG8_LAS f32x4*)(Pss + 4 * t); ssq4[(size_t)(u.pm * BM + t) * 4 + u.pn] = (p[0] + p[1]) + (p[2] + p[3]); } }
    }
};
}
#define GAS __attribute__((address_space(1)))
#define LAS __attribute__((address_space(3)))
typedef unsigned short bf16;
typedef unsigned v4u __attribute__((ext_vector_type(4)));
typedef float f32x4 __attribute__((ext_vector_type(4)));
typedef short bf16x8 __attribute__((ext_vector_type(8)));
typedef GAS unsigned gu32;
typedef GAS unsigned long long gu64;
#define RLX_AGENT __ATOMIC_RELAXED, __HIP_MEMORY_SCOPE_AGENT
#define LDS_WAIT() asm volatile("s_waitcnt lgkmcnt(0)" ::: "memory")
#define VM_WAIT() asm volatile("s_waitcnt vmcnt(0)" ::: "memory")
__device__ __forceinline__ unsigned long long rt() { return __builtin_amdgcn_s_memrealtime(); }
__device__ __forceinline__ unsigned f2bf(float f) { unsigned u = __builtin_bit_cast(unsigned, f); return (u + 0x7fffu + ((u >> 16) & 1u)) >> 16; }
__device__ __forceinline__ unsigned pk2(float lo, float hi) { return f2bf(lo) | (f2bf(hi) << 16); }

#define XB_TMO      128
#define XB_XCNT(j)  (256  + 64 * (j))
#define XB_XSUB(j)  (1280 + 64 * (j))
#define XB_XGEN(j)  (2304 + 64 * (j))
#define XB_TOP      3328
#define XB_TOPGEN   3392
#define XCD_BAR_WORDS 3456
#define XB_SPIN_CAP (1u << 18)

__device__ __forceinline__ unsigned xb_ld(unsigned* p)              { return __hip_atomic_load(p, __ATOMIC_RELAXED, __HIP_MEMORY_SCOPE_AGENT); }
__device__ __forceinline__ unsigned xb_add(unsigned* p, unsigned v) { return __hip_atomic_fetch_add(p, v, __ATOMIC_RELAXED, __HIP_MEMORY_SCOPE_AGENT); }
__device__ __forceinline__ unsigned xb_xcc_id() { return (unsigned)__builtin_amdgcn_s_getreg((3 << 11) | 20) & 0xFu; }
#define XB_SPIN(cond, bar) do { unsigned _sp = 0; while (cond) { __builtin_amdgcn_s_sleep(1); \
    if ((++_sp & 255u) == 0u) { if (xb_ld(&(bar)[XB_TMO])) break; if (_sp > XB_SPIN_CAP) { atomicAdd(&(bar)[XB_TMO], 1u); break; } } } } while (0)

struct XcdBarrier {
    unsigned* bar; unsigned x;
    volatile LAS unsigned* st;
};

__device__ __forceinline__ XcdBarrier xcd_barrier_post(unsigned* bar, volatile LAS unsigned* st) {
    XcdBarrier b; b.bar = bar; b.x = xb_xcc_id(); b.st = st;
    if (threadIdx.x == 0) (void)xb_add(&bar[XB_XCNT(b.x)], 1u);
    return b;
}
__device__ __forceinline__ void xcd_barrier_complete(unsigned* bar, unsigned x, unsigned& nloc, unsigned& nx) {
    const unsigned G = gridDim.x * gridDim.y * gridDim.z;
    unsigned sum, cnt, mine, sp = 0u;
    for (;;) {
        sum = 0u; cnt = 0u; mine = 0u;
#pragma unroll
        for (unsigned j = 0; j < 16; ++j) { const unsigned c = xb_ld(&bar[XB_XCNT(j)]); sum += c; cnt += (c > 0u) ? 1u : 0u; mine = (j == x) ? c : mine; }
        if (sum == G) break;
        __builtin_amdgcn_s_sleep(1);
        if ((++sp & 255u) == 0u) { if (xb_ld(&bar[XB_TMO])) break; if (sp > XB_SPIN_CAP) { atomicAdd(&bar[XB_TMO], 1u); break; } }
    }
    nloc = mine > 0u ? mine : 1u; nx = cnt > 0u ? cnt : 1u;
}

__device__ __forceinline__ void xcd_barrier(const XcdBarrier& b, const bool leader  ) {
    asm volatile("s_waitcnt vmcnt(0)" ::: "memory");
    __syncthreads();
    if (leader) {
        unsigned* bar = b.bar;
        __builtin_amdgcn_s_waitcnt(0);
        unsigned nloc = b.st[0], nx = b.st[1];
        if (nloc == 0u) { xcd_barrier_complete(bar, b.x, nloc, nx); b.st[0] = nloc; b.st[1] = nx; }
        const unsigned old = xb_add(&bar[XB_XSUB(b.x)], 1u);
        const unsigned gen = old / nloc;
        if (old + 1u == (gen + 1u) * nloc) {
            __builtin_amdgcn_fence(__ATOMIC_RELEASE, "agent");
            asm volatile("s_waitcnt vmcnt(0)" ::: "memory");
            const unsigned og = xb_add(&bar[XB_TOP], 1u);
            const unsigned tg = og / nx;
            if (og + 1u == (tg + 1u) * nx) xb_add(&bar[XB_TOPGEN], 1u);
            else XB_SPIN(xb_ld(&bar[XB_TOPGEN]) == tg, bar);
            __builtin_amdgcn_fence(__ATOMIC_ACQUIRE, "agent");
            xb_add(&bar[XB_XGEN(b.x)], 1u);
            asm volatile("s_waitcnt vmcnt(0)" ::: "memory");
        } else {
            XB_SPIN(xb_ld(&bar[XB_XGEN(b.x)]) == gen, bar);
            __builtin_amdgcn_fence(__ATOMIC_ACQUIRE, "agent");
            asm volatile("s_waitcnt vmcnt(0)" ::: "memory");
        }
    }
    __syncthreads();
}
constexpr int NWAVES = 8;
#ifndef MK_ONE_LAUNCH
#define MK_ONE_LAUNCH 1
#endif
constexpr int BATCH = 8, SEQ = 2048, D = 1024, M = BATCH * SEQ, DEPTH = 2, FF = 4096, NIN = 2540, NP = 2560;
constexpr int NCMP = 127;
constexpr float EPS = 1e-6f;
constexpr float LOG2E = 1.4426950408889634f;
constexpr int CW_FILL = 8192 + 512;
constexpr int CW_QUEUE = 8192;
constexpr int C_AB = 0, C_AC = 256, C_AU = 512, C_NQ = 768, C_KC = 1024, C_VC = 1088, C_KS = 1152, C_VS = 1216, C_KW = 1280, C_VW = 1344,
              C_CQ = 1408, C_CKV = 1600, C_KR = 1728, C_SQ = 1760, C_SK = 2016, C_SV = 2272, C_NG = 2528;
constexpr int NQKV = 896;
enum { I_X = 0, I_RELB, I_N1W, I_WIN, I_CONVW, I_CONVB, I_NQN, I_NKN, I_CPOS, I_CW1, I_CW2, I_QAN, I_KVN, I_WQB, I_WKVB, I_MQN, I_MKN, I_ONW, I_WOUT, I_N2W, I_FW1, I_FW2, N_INPUTS };
constexpr size_t MiB = 1u << 20;
constexpr size_t WS_CTL = 0, CTL_ZERO_BYTES = 64 * 1024;
constexpr size_t WS_ROPE = 1 * MiB;
constexpr size_t WS_TB = WS_ROPE + 262144;
constexpr size_t WS_CB1 = WS_TB + 4096;
constexpr size_t WS_KCV = WS_CB1 + 65536;
constexpr size_t WS_SSQ = 240 * MiB;
constexpr size_t WS_WIN = 2 * MiB, WS_WO = 16 * MiB, WS_W1 = 20 * MiB, WS_W2 = 36 * MiB;
constexpr size_t OUT_QM = 0, OUT_KM = 12 * MiB, OUT_VM = 24 * MiB;
constexpr size_t WS_WQF = 88 * MiB  , WS_WKVF = WS_WQF + 512 * 1024  , WS_QKV = 208 * MiB  ;
constexpr size_t WS_W1C = 84 * MiB, WS_KS = 92 * MiB, WS_KW = 94 * MiB;
constexpr size_t WS_XB = 52 * MiB  , WS_SSQX = WS_KCV + 262144  , WS_P = 128 * MiB, WS_Y = 96 * MiB, WS_H = 128 * MiB, WS_END = 256 * MiB;
static_assert(WS_KCV + 262144 <= WS_WIN && WS_SSQ + (size_t)M * 8 * 4 <= WS_END && WS_P + (size_t)M * NP * 2 <= WS_SSQ && WS_KW + (size_t)M * 64 * 2 <= WS_Y && WS_XB + (size_t)M * D * 2 <= WS_W1C && WS_Y + (size_t)M * D * 2 <= WS_P && WS_SSQX + (size_t)M * 16 <= WS_WIN, "d_ws map");
constexpr int RING_OFF = 0, RING_BYTES = 131072;
constexpr int LDSCTL_OFF = RING_BYTES, MISC_OFF = LDSCTL_OFF + 320, TB_OFF = RING_BYTES + 1024;
constexpr int RST_OFF = TB_OFF + 2048;
constexpr int LDS_BYTES = 147456;
static_assert(RST_OFF + 4096 <= LDS_BYTES, "LDS map");

typedef unsigned short bf16;
struct Args { const float* in[N_INPUTS]; float* out; unsigned char* ws; int ph_lo, ph_hi; };
struct ArgsG { const GAS float* in[N_INPUTS]; GAS float* out; GAS unsigned char* ws; int ph_lo, ph_hi; };
static_assert(sizeof(ArgsG) == sizeof(Args), "same layout");
typedef const __attribute__((address_space(4))) ArgsG* ArgsP;
#define OPQ_V(x) asm volatile("" : "+v"(x))
template <class T> __device__ __forceinline__ T opq_ptr(T p) { const unsigned long long u = (unsigned long long)p; unsigned lo = (unsigned)__builtin_amdgcn_readfirstlane((int)(unsigned)u), hi = (unsigned)__builtin_amdgcn_readfirstlane((int)(unsigned)(u >> 32));
    asm volatile("" : "+s"(lo), "+s"(hi)); return (T)(((unsigned long long)hi << 32) | lo); }
#define OPQ_S(x) ((x) = opq_ptr(x))

__device__ __forceinline__ float wsum(float v) {
#pragma unroll
    for (int o = 1; o < 64; o <<= 1) v += __shfl_xor(v, o);
    return v;
}
__device__ __forceinline__ float wmaxf(float v) {
#pragma unroll
    for (int o = 1; o < 64; o <<= 1) v = fmaxf(v, __shfl_xor(v, o));
    return v;
}
__device__ __forceinline__ float bf2f(bf16 b) { return __uint_as_float((unsigned)b << 16); }
__device__ __forceinline__ float bflo(unsigned w) { return __uint_as_float(w << 16); }
__device__ __forceinline__ float bfhi(unsigned w) { return __uint_as_float(w & 0xffff0000u); }
__device__ __forceinline__ bf16 f2b(float f) { return (bf16)f2bf(f); }

__device__ __forceinline__ int opq_lane() { int l; asm volatile("v_mbcnt_lo_u32_b32 %0, -1, 0\n\tv_mbcnt_hi_u32_b32 %0, -1, %0" : "=v"(l)); return l; }
struct Frame {
    unsigned char* lds; int wave, vcu, G;
    ArgsP a; GAS unsigned char* ws;
};

namespace att {
typedef float f32x16 __attribute__((ext_vector_type(16)));
typedef short s16x4 __attribute__((ext_vector_type(4)));
typedef short v4i16_t __attribute__((ext_vector_type(4)));
typedef float f32x2_t __attribute__((ext_vector_type(2)));
typedef __bf16 bf16x2_t __attribute__((ext_vector_type(2)));
#define MFMA32(a, b, c) __builtin_amdgcn_mfma_f32_32x32x16_bf16((a), (b), (c), 0, 0, 0)
constexpr int PVB = 144;
constexpr int TBUF = 24576;
constexpr int KOFF = 0, VOFF = 12288;
constexpr float L2E = 1.4426950408889634f;
constexpr float NEG_INF = -INFINITY;
__device__ __forceinline__ int crow(int r, int h) { return (r & 3) + 8 * (r >> 2) + 4 * h; }
__device__ __forceinline__ unsigned cvtpk(float lo, float hi) { f32x2_t v = {lo, hi}; bf16x2_t b = __builtin_convertvector(v, bf16x2_t); return __builtin_bit_cast(unsigned, b); }
__device__ __forceinline__ float ex2(float x) { return __builtin_amdgcn_exp2f(x); }
__device__ __forceinline__ float lg2(float x) { return __builtin_amdgcn_logf(x); }
__device__ __forceinline__ float sigm(float x) { const float e = __builtin_amdgcn_exp2f(-x * 1.4426950408889634f); float d; asm volatile("s_nop 1\n\tv_add_f32_e32 %0, 1.0, %1" : "=v"(d) : "v"(e));     return __builtin_amdgcn_rcpf(d); }
__device__ __forceinline__ float xhalf(float x, int h) { const auto r = __builtin_amdgcn_permlane32_swap(__float_as_uint(x), __float_as_uint(x), false, false); return __uint_as_float(h ? r[0] : r[1]); }
__device__ __forceinline__ float xh_sum(float x) { const auto r = __builtin_amdgcn_permlane32_swap(__float_as_uint(x), __float_as_uint(x), false, false); return __uint_as_float(r[0]) + __uint_as_float(r[1]); }
__device__ __forceinline__ float xh_max(float x) { const auto r = __builtin_amdgcn_permlane32_swap(__float_as_uint(x), __float_as_uint(x), false, false); return fmaxf(__uint_as_float(r[0]), __uint_as_float(r[1])); }
__device__ __forceinline__ bf16x8 packfrag(const f32x16& p, int s) {
    v4u w; w.x = cvtpk(p[8 * s], p[8 * s + 1]); w.y = cvtpk(p[8 * s + 2], p[8 * s + 3]); w.z = cvtpk(p[8 * s + 4], p[8 * s + 5]); w.w = cvtpk(p[8 * s + 6], p[8 * s + 7]);
    return __builtin_bit_cast(bf16x8, w);
}
struct TileRegs { v4u k0, k1, v; };
template <int DK> __device__ __forceinline__ void tile_issue(TileRegs& R, const bf16* Kg, int kpitch, const bf16* Vg, int vpitch, int tid) {
    R.k0 = *(const v4u*)(Kg + (size_t)(tid & 63) * kpitch + (tid >> 6) * 8);
    if (DK == 96) { if (tid < 256) R.k1 = *(const v4u*)(Kg + (size_t)(tid & 63) * kpitch + (8 + (tid >> 6)) * 8); }
    R.v = *(const v4u*)(Vg + (size_t)(tid >> 3) * vpitch + (tid & 7) * 8);
}
template <int DK> __device__ __forceinline__ void tile_commit(const TileRegs& R, LAS unsigned char* buf, int tid) {
    *(LAS v4u*)(buf + KOFF + (tid >> 6) * 1024 + (tid & 63) * 16) = R.k0;
    if (DK == 96) { if (tid < 256) *(LAS v4u*)(buf + KOFF + (8 + (tid >> 6)) * 1024 + (tid & 63) * 16) = R.k1; }
    *(LAS v4u*)(buf + VOFF + (tid >> 3) * PVB + (tid & 7) * 16) = R.v;
}
template <int DK> __device__ __forceinline__ void qk(f32x16& p0, f32x16& p1, const LAS unsigned char* buf, const bf16x8* qf, int r32, int h) {
    const LAS unsigned char* kb = buf + KOFF + h * 1024 + r32 * 16;
    bf16x8 a0[DK / 16], a1[DK / 16];
#pragma unroll
    for (int s = 0; s < DK / 16; ++s) { a0[s] = *(const LAS bf16x8*)(kb + s * 2048); a1[s] = *(const LAS bf16x8*)(kb + s * 2048 + 512); }
#pragma unroll
    for (int s = 0; s < DK / 16; ++s) { p0 = MFMA32(a0[s], qf[s], p0); p1 = MFMA32(a1[s], qf[s], p1); }
}
__device__ __forceinline__ void pv(f32x16& o0, f32x16& o1, const LAS unsigned char* buf, const bf16x8 (&pf)[4], int lane) {
    const int h = lane >> 5, blk = (lane >> 4) & 1, q4 = (lane & 15) >> 2, p = lane & 3;
    const LAS unsigned char* vb = buf + VOFF + (4 * h + q4) * PVB + (16 * blk + 4 * p) * 2;
    s16x4 lo[4][2], hi[4][2];
#pragma unroll
    for (int s = 0; s < 4; ++s)
#pragma unroll
        for (int c = 0; c < 2; ++c) {
            lo[s][c] = __builtin_bit_cast(s16x4, __builtin_amdgcn_ds_read_tr16_b64_v4i16((LAS v4i16_t*)(vb + (16 * s) * PVB + c * 64)));
            hi[s][c] = __builtin_bit_cast(s16x4, __builtin_amdgcn_ds_read_tr16_b64_v4i16((LAS v4i16_t*)(vb + (16 * s + 8) * PVB + c * 64))); }
#pragma unroll
    for (int s = 0; s < 4; ++s) {
        const bf16x8 v0 = (bf16x8){lo[s][0][0], lo[s][0][1], lo[s][0][2], lo[s][0][3], hi[s][0][0], hi[s][0][1], hi[s][0][2], hi[s][0][3]};
        const bf16x8 v1 = (bf16x8){lo[s][1][0], lo[s][1][1], lo[s][1][2], lo[s][1][3], hi[s][1][0], hi[s][1][1], hi[s][1][2], hi[s][1][3]};
        o0 = MFMA32(v0, pf[s], o0); o1 = MFMA32(v1, pf[s], o1);
    }
}
__device__ __forceinline__ float max16(const f32x16& p) {
    float r;
    asm volatile("s_nop 15\n\ts_nop 7\n\tv_max3_f32 %0, %1, %2, %3\n\tv_max3_f32 %0, %0, %4, %5\n\tv_max3_f32 %0, %0, %6, %7\n\tv_max3_f32 %0, %0, %8, %9\n\t"
                 "v_max3_f32 %0, %0, %10, %11\n\tv_max3_f32 %0, %0, %12, %13\n\tv_max3_f32 %0, %0, %14, %15\n\tv_max_f32_e32 %0, %0, %16"
                 : "=&v"(r) : "v"(p[0]), "v"(p[1]), "v"(p[2]), "v"(p[3]), "v"(p[4]), "v"(p[5]), "v"(p[6]), "v"(p[7]), "v"(p[8]), "v"(p[9]), "v"(p[10]), "v"(p[11]), "v"(p[12]), "v"(p[13]), "v"(p[14]), "v"(p[15]));
    return r;
}
__device__ __forceinline__ float max32(const f32x16& p0, const f32x16& p1) { const float a = max16(p0), b = max16(p1); return fmaxf(a, b); }
typedef float f32x2p __attribute__((ext_vector_type(2)));
__device__ __forceinline__ void softmax_step(f32x16& p0, f32x16& p1, float& m, float& l, f32x16& o0, f32x16& o1) {
    float mx = max32(p0, p1); mx = xh_max(mx);
    const float mn = fmaxf(m, mx), mu = (mn == NEG_INF) ? 0.f : mn, f = ex2(m - mu);
    const f32x2p nmu = {-mu, -mu}; f32x2p s2 = {0.f, 0.f};
#pragma unroll
    for (int r = 0; r < 16; r += 2) { f32x2p a = (f32x2p){p0[r], p0[r + 1]} + nmu, b = (f32x2p){p1[r], p1[r + 1]} + nmu;
        a.x = ex2(a.x); a.y = ex2(a.y); b.x = ex2(b.x); b.y = ex2(b.y); s2 += a; s2 += b; p0[r] = a.x; p0[r + 1] = a.y; p1[r] = b.x; p1[r + 1] = b.y; }
    l = l * f + (s2.x + s2.y); m = mn;
    if (__any(f != 1.0f)) { const f32x2p f2 = {f, f};
#pragma unroll
        for (int r = 0; r < 16; r += 2) { const f32x2p a = (f32x2p){o0[r], o0[r + 1]} * f2, b = (f32x2p){o1[r], o1[r + 1]} * f2; o0[r] = a.x; o0[r + 1] = a.y; o1[r] = b.x; o1[r + 1] = b.y; } }
}
__device__ __forceinline__ void pack_pv(f32x16& o0, f32x16& o1, const f32x16& p0, const f32x16& p1, const LAS unsigned char* buf, int lane) {
    bf16x8 pf[4]; pf[0] = packfrag(p0, 0); pf[1] = packfrag(p0, 1); pf[2] = packfrag(p1, 0); pf[3] = packfrag(p1, 1);
    pv(o0, o1, buf, pf, lane);
}
__device__ __forceinline__ void store_o(bf16* yrow, const f32x16& o0, const f32x16& o1, int h) {
#pragma unroll
    for (int g = 0; g < 4; ++g) {
        uint2 w0; w0.x = cvtpk(o0[4 * g], o0[4 * g + 1]); w0.y = cvtpk(o0[4 * g + 2], o0[4 * g + 3]); *(uint2*)(yrow + 8 * g + 4 * h) = w0;
        uint2 w1; w1.x = cvtpk(o1[4 * g], o1[4 * g + 1]); w1.y = cvtpk(o1[4 * g + 2], o1[4 * g + 3]); *(uint2*)(yrow + 32 + 8 * g + 4 * h) = w1;
    }
}
__device__ __forceinline__ float sumsq(const f32x16& o0, const f32x16& o1) {
    float s = 0.f;
#pragma unroll
    for (int r = 0; r < 16; ++r) s += o0[r] * o0[r] + o1[r] * o1[r];
    return s;
}

struct SmState { float m, l; f32x16 o0, o1; };
#define RBAR() asm volatile("s_waitcnt lgkmcnt(0)\n\ts_barrier" ::: "memory")
__device__ __forceinline__ void mla_step(int kt, int NT, int ktd, int R0, const bf16* Kg, const bf16* Vg, const bf16x8 (&qf)[6], SmState& st, const TileRegs& Rc, TileRegs& Ri, LAS unsigned char* lds, int tid, int lane, int r32, int h) {
    const LAS unsigned char* cur = lds + (kt & 1) * TBUF;
    if (kt + 2 < NT) tile_issue<96>(Ri, Kg + (size_t)(kt + 2) * 64 * 384, 384, Vg + (size_t)(kt + 2) * 64 * 256, 256, tid);
    if (kt <= ktd) {
        f32x16 p0 = {}, p1 = {};
        qk<96>(p0, p1, cur, qf, r32, h);
        if (kt == ktd) { const int trel = R0 + r32 - 64 * kt;
#pragma unroll
            for (int r = 0; r < 16; ++r) { const int kk = crow(r, h); if (kk > trel) p0[r] = NEG_INF; if (kk + 32 > trel) p1[r] = NEG_INF; } }
        softmax_step(p0, p1, st.m, st.l, st.o0, st.o1);
        pack_pv(st.o0, st.o1, p0, p1, cur, lane);
    }
    if (kt + 1 < NT) tile_commit<96>(Rc, lds + ((kt + 1) & 1) * TBUF, tid);
    RBAR();
}
__device__ __forceinline__ void mla_unit(int b, int hd, int qb, const bf16* QM, const bf16* KM, const bf16* VM, bf16* Y, float* SSQ, LAS unsigned char* lds, int tid) {
    OPQ_V(tid);
    const int lane = tid & 63, w = __builtin_amdgcn_readfirstlane(tid >> 6), r32 = lane & 31, h = lane >> 5;
    const int R0 = 256 * qb + 32 * w; const size_t tok0 = (size_t)b * SEQ;
    bf16x8 qf[6];
    { const bf16* qp = QM + ((tok0 + R0 + r32) * 4 + hd) * 96 + 8 * h;
#pragma unroll
      for (int s = 0; s < 6; ++s) qf[s] = *(const bf16x8*)(qp + 16 * s); }
    const bf16* Kg = KM + (tok0 * 4 + hd) * 96; const bf16* Vg = VM + tok0 * 256 + hd * 64;
    const int NT = 4 * qb + 4, ktd = 4 * qb + (w >> 1);
    TileRegs Ra, Rb; tile_issue<96>(Ra, Kg, 384, Vg, 256, tid); tile_issue<96>(Rb, Kg + (size_t)64 * 384, 384, Vg + (size_t)64 * 256, 256, tid); tile_commit<96>(Ra, lds, tid);
    __syncthreads();
    SmState st; st.m = NEG_INF; st.l = 0.f; st.o0 = f32x16{}; st.o1 = f32x16{};
    for (int kt = 0; kt < NT; kt += 2) {
        mla_step(kt, NT, ktd, R0, Kg, Vg, qf, st, Rb, Ra, lds, tid, lane, r32, h);
        mla_step(kt + 1, NT, ktd, R0, Kg, Vg, qf, st, Ra, Rb, lds, tid, lane, r32, h);
    }
    float l = st.l; f32x16 o0 = st.o0, o1 = st.o1;
    l = xh_sum(l); const float inv = 1.0f / l;
#pragma unroll
    for (int r = 0; r < 16; ++r) { o0[r] *= inv; o1[r] *= inv; }
    float ss = sumsq(o0, o1); ss = xh_sum(ss);
    const size_t tok = tok0 + R0 + r32;
    if (h == 0) SSQ[tok * 8 + hd] = ss;
    store_o(Y + tok * D + 512 + hd * 64, o0, o1, h);
}

#ifndef SB_EARLY
#define SB_EARLY 1
#endif
constexpr float SB_THR = -160.0f;
struct SbState { float carry; f32x16 o0, o1; bool wdone; };
__device__ __forceinline__ bool sb_step(int i, int NT, int ktd, int R0, const bf16* Kg, const bf16* Vg, const bf16x8 (&qf)[4], SbState& st, const TileRegs& Rc, TileRegs& Ri, LAS unsigned char* lds, LAS unsigned* flags, int tid, int lane, int w, int r32, int h) {
    const int kt = NT - 1 - i;
    const LAS unsigned char* cur = lds + (i & 1) * TBUF;
    if (kt >= 2) tile_issue<64>(Ri, Kg + (size_t)(kt - 2) * 64 * NP, NP, Vg + (size_t)(kt - 2) * 64 * NP, NP, tid);
    float carry = st.carry; f32x16 o0 = st.o0, o1 = st.o1;
        if (kt <= ktd && !(SB_EARLY && st.wdone)) {
            f32x16 p0 = {}, p1 = {};
            qk<64>(p0, p1, cur, qf, r32, h);
            const int trel = (kt == ktd) ? (R0 + r32 - 64 * kt) : 1000;
            f32x16 l0, l1;
#pragma unroll
            for (int r = 0; r < 16; ++r) { const int kk = crow(r, h);
                const float z0 = p0[r], z1 = p1[r];
                const float a0 = -(fmaxf(z0, 0.f) + lg2(1.0f + ex2(-fabsf(z0)))), a1 = -(fmaxf(z1, 0.f) + lg2(1.0f + ex2(-fabsf(z1))));
                l0[r] = (kk < trel) ? a0 : 0.f; l1[r] = (kk + 32 < trel) ? a1 : 0.f; }
            float tg[8], tp[8];
#pragma unroll
            for (int g = 0; g < 4; ++g) { tg[g] = (l0[4 * g] + l0[4 * g + 1]) + (l0[4 * g + 2] + l0[4 * g + 3]); tg[4 + g] = (l1[4 * g] + l1[4 * g + 1]) + (l1[4 * g + 2] + l1[4 * g + 3]); }
#pragma unroll
            for (int g = 0; g < 8; ++g) tp[g] = xhalf(tg[g], h);
            float suf = carry;
#pragma unroll
            for (int g = 7; g >= 0; --g) {
                const float base = suf + (h == 0 ? tp[g] : 0.f);
                if (g >= 4) { const int q = 4 * (g - 4);
                    const float r3 = base, r2 = r3 + l1[q + 3], r1 = r2 + l1[q + 2], r0 = r1 + l1[q + 1];
                    const float e0 = ex2(p1[q] + l1[q] + r0), e1 = ex2(p1[q + 1] + l1[q + 1] + r1), e2 = ex2(p1[q + 2] + l1[q + 2] + r2), e3 = ex2(p1[q + 3] + l1[q + 3] + r3);
                    const int kk = crow(q, h) + 32;
                    p1[q] = (kk < trel) ? e0 : 0.f; p1[q + 1] = (kk + 1 < trel) ? e1 : 0.f; p1[q + 2] = (kk + 2 < trel) ? e2 : 0.f; p1[q + 3] = (kk + 3 < trel) ? e3 : 0.f;
                } else { const int q = 4 * g;
                    const float r3 = base, r2 = r3 + l0[q + 3], r1 = r2 + l0[q + 2], r0 = r1 + l0[q + 1];
                    const float e0 = ex2(p0[q] + l0[q] + r0), e1 = ex2(p0[q + 1] + l0[q + 1] + r1), e2 = ex2(p0[q + 2] + l0[q + 2] + r2), e3 = ex2(p0[q + 3] + l0[q + 3] + r3);
                    const int kk = crow(q, h);
                    p0[q] = (kk < trel) ? e0 : 0.f; p0[q + 1] = (kk + 1 < trel) ? e1 : 0.f; p0[q + 2] = (kk + 2 < trel) ? e2 : 0.f; p0[q + 3] = (kk + 3 < trel) ? e3 : 0.f;
                }
                suf += tg[g] + tp[g];
            }
            carry = suf;
            pack_pv(o0, o1, p0, p1, cur, lane);
        }
    st.carry = carry; st.o0 = o0; st.o1 = o1;
#if SB_EARLY
    { const bool done = (kt <= ktd) && (carry < SB_THR);
      const unsigned long long bal = __ballot(done);
      st.wdone = (bal == ~0ull);
      if (lane == 0) flags[(i & 1) * 8 + w] = st.wdone ? 1u : 0u; }
#endif
    if (kt >= 1) tile_commit<64>(Rc, lds + ((i + 1) & 1) * TBUF, tid);
    RBAR();
#if SB_EARLY
    { unsigned all = 1u;
#pragma unroll
      for (int ww = 0; ww < 8; ++ww) all &= flags[(i & 1) * 8 + ww];
      if (__builtin_amdgcn_readfirstlane((int)all)) return true; }
#endif
    return kt == 0;
}
__device__ __forceinline__ void sb_unit(int b, int hd, int qb, const bf16* P, bf16* Y, float* SSQ, LAS unsigned char* lds, LAS unsigned* flags, int tid) {
    OPQ_V(tid);
    const int lane = tid & 63, w = __builtin_amdgcn_readfirstlane(tid >> 6), r32 = lane & 31, h = lane >> 5;
    const int R0 = 256 * qb + 32 * w; const size_t tok0 = (size_t)b * SEQ;
    bf16x8 qf[4];
    { const bf16* qp = P + (tok0 + R0 + r32) * NP + C_SQ + hd * 64 + 8 * h;
#pragma unroll
      for (int s = 0; s < 4; ++s) qf[s] = *(const bf16x8*)(qp + 16 * s); }
    const bf16* Kg = P + tok0 * NP + C_SK + hd * 64; const bf16* Vg = P + tok0 * NP + C_SV + hd * 64;
    const int NT = 4 * qb + 4, ktd = 4 * qb + (w >> 1);
    TileRegs Ra, Rb; tile_issue<64>(Ra, Kg + (size_t)(NT - 1) * 64 * NP, NP, Vg + (size_t)(NT - 1) * 64 * NP, NP, tid); tile_issue<64>(Rb, Kg + (size_t)(NT - 2) * 64 * NP, NP, Vg + (size_t)(NT - 2) * 64 * NP, NP, tid);
    tile_commit<64>(Ra, lds, tid);
    __syncthreads();
    SbState st; st.carry = 0.f; st.o0 = f32x16{}; st.o1 = f32x16{}; st.wdone = false;
    for (int i = 0; i < NT; i += 2) {
        if (sb_step(i, NT, ktd, R0, Kg, Vg, qf, st, Rb, Ra, lds, flags, tid, lane, w, r32, h)) break;
        if (sb_step(i + 1, NT, ktd, R0, Kg, Vg, qf, st, Ra, Rb, lds, flags, tid, lane, w, r32, h)) break;
    }
    f32x16 o0 = st.o0, o1 = st.o1;
    float ss = sumsq(o0, o1); ss = xh_sum(ss);
    const size_t tok = tok0 + R0 + r32;
    if (h == 0) SSQ[tok * 8 + 4 + hd] = ss;
    store_o(Y + tok * D + 768 + hd * 64, o0, o1, h);
}

constexpr int NSA_SC = 2 * TBUF, NSA_SEL = NSA_SC + 32768, NSA_UNI = NSA_SEL + 256, NSA_SS = NSA_UNI + 16, NSA_ACC2 = NSA_SS + 1024, NSA_END = NSA_ACC2 + 32768;
template <bool WIN> __device__ __forceinline__ void nsa_step(int kt, int k1, int k2, int par, unsigned selmask, unsigned wsel, int tblk, int trow, int hd, const bf16* Kg, int kpitch, const bf16* Vg, int vpitch,
                                                             const bf16x8* qf, const LAS float* tb2, float cb, SmState& st, const TileRegs& Rc, TileRegs& Ri, LAS unsigned char* lds, int tid, int lane, int r32, int h) {
    const LAS unsigned char* cur = lds + par * TBUF;
    if (k2 >= 0) tile_issue<64>(Ri, Kg + (size_t)k2 * 64 * kpitch, kpitch, Vg + (size_t)k2 * 64 * vpitch, vpitch, tid);
    if (WIN || ((wsel >> kt) & 1u)) {
        float& m = st.m; float& l = st.l; f32x16& o0 = st.o0; f32x16& o1 = st.o1;
        const bool nearb = (kt + 2 >= tblk);
        f32x16 p0, p1;
        { const float c0 = (!WIN && !((selmask >> kt) & 1u)) ? NEG_INF : (nearb ? 0.f : cb);
#pragma unroll
          for (int r = 0; r < 16; ++r) { p0[r] = c0; p1[r] = c0; } }
        qk<64>(p0, p1, cur, qf, r32, h);
        if (nearb) { const int dbase = 64 * (tblk - kt) + trow;
            float b0[16], b1[16];
#pragma unroll
            for (int r = 0; r < 16; ++r) { const int d0 = dbase - crow(r, h), d1 = d0 - 32;
                b0[r] = tb2[(d0 < 0 ? 0 : (d0 > 127 ? 127 : d0)) * 4 + hd]; b1[r] = tb2[(d1 < 0 ? 0 : (d1 > 127 ? 127 : d1)) * 4 + hd]; }
#pragma unroll
            for (int r = 0; r < 16; ++r) { const int d0 = dbase - crow(r, h), d1 = d0 - 32;
                p0[r] = d0 < 0 ? NEG_INF : p0[r] + b0[r]; p1[r] = d1 < 0 ? NEG_INF : p1[r] + b1[r]; } }
        if (WIN) { if (kt + 8 == tblk) {
#pragma unroll
            for (int r = 0; r < 16; ++r) { const int kk = crow(r, h); if (kk <= trow) p0[r] = NEG_INF; if (kk + 32 <= trow) p1[r] = NEG_INF; } } }
        softmax_step(p0, p1, m, l, o0, o1);
        pack_pv(o0, o1, p0, p1, cur, lane);
    }
    if (k1 >= 0) tile_commit<64>(Rc, lds + (par ^ 1) * TBUF, tid);
    RBAR();
}
template <bool WIN> __device__ __forceinline__ void nsa_pass(unsigned mask, unsigned selmask, unsigned wsel, int tblk, int trow, int hd, const bf16* Kg, int kpitch, const bf16* Vg, int vpitch,
                                                             const bf16x8* qf, const LAS float* tb2, f32x16& o0, f32x16& o1, float& lsum, LAS unsigned char* lds, int tid) {
    const int lane = tid & 63, r32 = lane & 31, h = lane >> 5;
    SmState st; st.m = NEG_INF; st.l = 0.f; st.o0 = o0; st.o1 = o1;
    const float cb = tb2[127 * 4 + hd];
    TileRegs Ra, Rb;
    { const int k0 = __builtin_ctz(mask); tile_issue<64>(Ra, Kg + (size_t)k0 * 64 * kpitch, kpitch, Vg + (size_t)k0 * 64 * vpitch, vpitch, tid);
      const unsigned m1 = mask & (mask - 1u); if (m1) { const int k1 = __builtin_ctz(m1); tile_issue<64>(Rb, Kg + (size_t)k1 * 64 * kpitch, kpitch, Vg + (size_t)k1 * 64 * vpitch, vpitch, tid); }
      tile_commit<64>(Ra, lds, tid); }
    __syncthreads();
    while (mask) {
        { const int kt = __builtin_ctz(mask); mask &= mask - 1u; const int k1 = mask ? __builtin_ctz(mask) : -1; const unsigned m2 = mask & (mask - 1u); const int k2 = m2 ? __builtin_ctz(m2) : -1;
          nsa_step<WIN>(kt, k1, k2, 0, selmask, wsel, tblk, trow, hd, Kg, kpitch, Vg, vpitch, qf, tb2, cb, st, Rb, Ra, lds, tid, lane, r32, h); }
        if (!mask) break;
        { const int kt = __builtin_ctz(mask); mask &= mask - 1u; const int k1 = mask ? __builtin_ctz(mask) : -1; const unsigned m2 = mask & (mask - 1u); const int k2 = m2 ? __builtin_ctz(m2) : -1;
          nsa_step<WIN>(kt, k1, k2, 1, selmask, wsel, tblk, trow, hd, Kg, kpitch, Vg, vpitch, qf, tb2, cb, st, Ra, Rb, lds, tid, lane, r32, h); }
    }
    o0 = st.o0; o1 = st.o1;
    lsum = xh_sum(st.l);
}
__device__ __forceinline__ void nsa_unit(int b, int qblk, const bf16* P, const float* nqn, const bf16* KSn, const bf16* KWn, const bf16* KC, const bf16* VC, const float* onw, bf16* Y,
                                         LAS unsigned char* lds, const LAS float* tb2, int tid) {
    OPQ_V(tid);
    const int lane = tid & 63, w = __builtin_amdgcn_readfirstlane(tid >> 6), r32 = lane & 31, h = lane >> 5;
    const int hd = w >> 1, trow = 32 * (w & 1) + r32, t = 64 * qblk + trow, tblk = qblk; const size_t tok0 = (size_t)b * SEQ, tok = tok0 + t;
    LAS float* SC = (LAS float*)(lds + NSA_SC); LAS unsigned* SEL = (LAS unsigned*)(lds + NSA_SEL); LAS unsigned* UNI = (LAS unsigned*)(lds + NSA_UNI); LAS float* SS4 = (LAS float*)(lds + NSA_SS);
    bf16x8 qf[4];
    { const bf16* qp = P + tok * NP + C_NQ + hd * 64 + 8 * h; v4u raw[4]; float ss = 0.f;
#pragma unroll
      for (int s = 0; s < 4; ++s) { raw[s] = *(const v4u*)(qp + 16 * s);
          const float a0 = bflo(raw[s].x), a1 = bfhi(raw[s].x), a2 = bflo(raw[s].y), a3 = bfhi(raw[s].y), a4 = bflo(raw[s].z), a5 = bfhi(raw[s].z), a6 = bflo(raw[s].w), a7 = bfhi(raw[s].w);
          ss += ((a0 * a0 + a1 * a1) + (a2 * a2 + a3 * a3)) + ((a4 * a4 + a5 * a5) + (a6 * a6 + a7 * a7)); }
      ss = xh_sum(ss);
      const float rstd = (1.0f / sqrtf(ss * (1.f / 64.f) + EPS)) * (0.125f * L2E);
#pragma unroll
      for (int s = 0; s < 4; ++s) { const f32x4 g0 = *(const f32x4*)(nqn + 16 * s + 8 * h), g1 = *(const f32x4*)(nqn + 16 * s + 8 * h + 4); v4u wq;
          wq.x = cvtpk(bflo(raw[s].x) * rstd * g0.x, bfhi(raw[s].x) * rstd * g0.y); wq.y = cvtpk(bflo(raw[s].y) * rstd * g0.z, bfhi(raw[s].y) * rstd * g0.w);
          wq.z = cvtpk(bflo(raw[s].z) * rstd * g1.x, bfhi(raw[s].z) * rstd * g1.y); wq.w = cvtpk(bflo(raw[s].w) * rstd * g1.z, bfhi(raw[s].w) * rstd * g1.w);
          qf[s] = __builtin_bit_cast(bf16x8, wq); } }
    if (tid == 0) UNI[0] = 0u;
    { TileRegs R0_, R1_; const bf16* kc = KC + (size_t)b * 128 * 64; const bf16* vc = VC + (size_t)b * 128 * 64;
      tile_issue<64>(R0_, kc, 64, vc, 64, tid); tile_issue<64>(R1_, kc + 64 * 64, 64, vc + 64 * 64, 64, tid);
      tile_commit<64>(R0_, lds, tid); tile_commit<64>(R1_, lds + TBUF, tid); }
    __syncthreads();
    LAS float* AC0 = (LAS float*)(lds + NSA_SC) + w * 64 + lane; LAS float* AC1 = (LAS float*)(lds + NSA_ACC2) + w * 64 + lane;
    f32x16 pc[4] = {{}, {}, {}, {}};
    {
        qk<64>(pc[0], pc[1], lds, qf, r32, h); qk<64>(pc[2], pc[3], lds + TBUF, qf, r32, h);
        float mx = NEG_INF;
#pragma unroll
        for (int i = 0; i < 4; ++i) { float bv[16];
#pragma unroll
            for (int r = 0; r < 16; ++r) { const int n = 32 * i + crow(r, h), dist = t - (16 * n + 31); bv[r] = tb2[(dist < 0 ? 0 : (dist > 127 ? 127 : dist)) * 4 + hd]; }
#pragma unroll
            for (int r = 0; r < 16; ++r) { const int n = 32 * i + crow(r, h), dist = t - (16 * n + 31); const bool valid = (dist >= 0) && (n < NCMP);
                pc[i][r] = valid ? pc[i][r] + bv[r] : NEG_INF; mx = fmaxf(mx, pc[i][r]); } }
        mx = xh_max(mx);
        const float mu = (mx == NEG_INF) ? 0.f : mx; float s = 0.f;
#pragma unroll
        for (int i = 0; i < 4; ++i)
#pragma unroll
            for (int r = 0; r < 16; ++r) { pc[i][r] = ex2(pc[i][r] - mu); s += pc[i][r]; }
        s = xh_sum(s);
        const float inv = s > 0.f ? 1.0f / s : 0.f;
#pragma unroll
        for (int i = 0; i < 4; ++i)
#pragma unroll
            for (int r = 0; r < 16; ++r) pc[i][r] *= inv;
        float own[16], cry[16];
#pragma unroll
        for (int i = 0; i < 4; ++i)
#pragma unroll
            for (int g = 0; g < 4; ++g) { const float hv = 0.5f * pc[i][4 * g + 3]; own[4 * i + g] = (pc[i][4 * g] + pc[i][4 * g + 1]) + (pc[i][4 * g + 2] + hv); cry[4 * i + g] = hv; }
#pragma unroll
        for (int jj = 0; jj < 16; ++jj) cry[jj] = xhalf(cry[jj], h);
#pragma unroll
        for (int jj = 0; jj < 16; ++jj) { const float fromh0 = cry[jj], fromh1 = jj > 0 ? cry[jj - 1] : 0.f; own[jj] += h ? fromh0 : fromh1; }
#pragma unroll
        for (int jj = 0; jj < 16; ++jj) SC[(hd * 64 + trow) * 32 + 2 * jj + h] = own[jj];
    }
    __syncthreads();
    { const int hw = tid >> 5, j = tid & 31; unsigned uacc = 0u;
      for (int rr = 0; rr < 4; ++rr) { const int row = hw * 4 + rr;
          float sc = (SC[(0 * 64 + row) * 32 + j] + SC[(1 * 64 + row) * 32 + j]) + (SC[(2 * 64 + row) * 32 + j] + SC[(3 * 64 + row) * 32 + j]);
          const bool forced = (j == 0) || (j == tblk) || (j == tblk - 1), validb = j <= tblk;
          sc = forced ? INFINITY : (validb ? sc : NEG_INF);
          int rank = 0;
          for (int jj = 0; jj < 32; ++jj) { const float so = __shfl(sc, jj, 32); rank += (so > sc || (so == sc && jj < j)) ? 1 : 0; }
          const unsigned long long bal = __ballot(rank < 16 && validb);
          const unsigned msk = (lane < 32) ? (unsigned)bal : (unsigned)(bal >> 32);
          if (j == 0) SEL[row] = msk; uacc |= msk; }
      if (j == 0) __hip_atomic_fetch_or(UNI, uacc, __ATOMIC_RELAXED, __HIP_MEMORY_SCOPE_WORKGROUP); }
    __syncthreads();
    const unsigned selmask = SEL[trow]; const unsigned uni = (unsigned)__builtin_amdgcn_readfirstlane((int)UNI[0]);
    unsigned wsel = selmask;
#pragma unroll
    for (int ofs = 1; ofs < 32; ofs <<= 1) wsel |= (unsigned)__shfl_xor((int)wsel, ofs);
    wsel = (unsigned)__builtin_amdgcn_readfirstlane((int)wsel);
    { f32x16 oc0 = {}, oc1 = {};
      pack_pv(oc0, oc1, pc[0], pc[1], lds, lane); pack_pv(oc0, oc1, pc[2], pc[3], lds + TBUF, lane);
      const float gl = bf2f(P[tok * NP + C_NG + hd * 3 + 0]); const float g0 = sigm(gl);
#pragma unroll
      for (int r = 0; r < 16; ++r) { AC0[r * 512] = g0 * oc0[r]; AC1[r * 512] = g0 * oc1[r]; } }
    __syncthreads();
    { f32x16 o0 = {}, o1 = {}; float ls;
      nsa_pass<false>(uni, selmask, wsel, tblk, trow, hd, KSn + tok0 * 64, 64, P + tok0 * NP + C_VS, NP, qf, tb2, o0, o1, ls, lds, tid);
      const float gl = bf2f(P[tok * NP + C_NG + hd * 3 + 1]); const float g1 = sigm(gl) / ls;
#pragma unroll
      for (int r = 0; r < 16; ++r) { AC0[r * 512] += g1 * o0[r]; AC1[r * 512] += g1 * o1[r]; } }
    f32x16 acc0, acc1;
    { f32x16 o0 = {}, o1 = {}; float ls;
      const int c0 = tblk >= 8 ? tblk - 8 : 0; const unsigned upto = tblk == 31 ? 0xffffffffu : ((2u << tblk) - 1u); const unsigned wmask = upto & ~((1u << c0) - 1u);
      nsa_pass<true>(wmask, 0u, 0u, tblk, trow, hd, KWn + tok0 * 64, 64, P + tok0 * NP + C_VW, NP, qf, tb2, o0, o1, ls, lds, tid);
      const float gl = bf2f(P[tok * NP + C_NG + hd * 3 + 2]); const float g2 = sigm(gl) / ls;
#pragma unroll
      for (int r = 0; r < 16; ++r) { o0[r] = AC0[r * 512] + g2 * o0[r]; o1[r] = AC1[r * 512] + g2 * o1[r]; }
      acc0 = o0; acc1 = o1; }
    { float ss = sumsq(acc0, acc1); ss = xh_sum(ss); if (h == 0) SS4[hd * 64 + trow] = ss; }
    __syncthreads();
    { const float tot = (SS4[trow] + SS4[64 + trow]) + (SS4[128 + trow] + SS4[192 + trow]); const float rstd = 1.0f / sqrtf(tot * (1.f / 256.f) + EPS);
      const float* gw = onw + 256 + hd * 64;
#pragma unroll
      for (int g = 0; g < 4; ++g)
#pragma unroll
          for (int e = 0; e < 4; ++e) { acc0[4 * g + e] *= rstd * gw[8 * g + 4 * h + e]; acc1[4 * g + e] *= rstd * gw[32 + 8 * g + 4 * h + e]; }
      store_o(Y + tok * D + 256 + hd * 64, acc0, acc1, h); }
    __syncthreads();
}
}
#ifndef PROBE_TIME_MASK
#define PROBE_TIME_MASK 0u
#endif
#define PHASE_MAXG(k, wsptr) do { if (PROBE_TIME_MASK != 0u) { if (F.wave == 0 && opq_lane() == 0) { volatile LAS unsigned long long* T_ = (volatile LAS unsigned long long*)((LAS unsigned char*)F.lds + MISC_OFF + 128); const unsigned long long now_ = __builtin_amdgcn_s_memrealtime(); if ((PROBE_TIME_MASK >> (k)) & 1u) atomicMax((unsigned*)((wsptr) + WS_CTL) + 9000, (unsigned)(now_ - T_[0])); T_[0] = now_; } } } while (0)
#ifndef PROBE_CLK_BIT
#define PROBE_CLK_BIT -1
#endif
#define PHASE_CLK(k) do { if (PROBE_CLK_BIT >= 0) { if (F.wave == 0 && opq_lane() == 0) { volatile LAS unsigned long long* T_ = (volatile LAS unsigned long long*)((LAS unsigned char*)F.lds + MISC_OFF + 128); const unsigned long long c_ = __builtin_amdgcn_s_memtime(); if ((k) == PROBE_CLK_BIT) T_[3] += c_ - T_[2]; T_[2] = c_; } } } while (0)
#define PHASE_END(k) do { PHASE_CLK(k); if (PROBE_TIME_MASK != 0u) { if (F.wave == 0 && opq_lane() == 0) { volatile LAS unsigned long long* T_ = (volatile LAS unsigned long long*)((LAS unsigned char*)F.lds + MISC_OFF + 128); const unsigned long long now_ = __builtin_amdgcn_s_memrealtime(); if ((PROBE_TIME_MASK >> (k)) & 1u) T_[1] += now_ - T_[0]; T_[0] = now_; } } } while (0)
#ifndef PROBE_DUP
#define PROBE_DUP -1
#endif
__device__ __forceinline__ int win_dst(int n) { return n < 1408 ? n : (n < 1420 ? 2528 + (n - 1408) : n - 12); }
template <bool WINMAP, bool FRAG = false> __device__ __forceinline__ void transpose_item(const float* W, int K, int N, bf16* WT, float* scr, int item, int lane, const float* gk = nullptr  , int gk0 = 0  ) {
    const int nblk = (N + 31) / 32, kb = item / nblk, nb = item % nblk, k0 = 64 * kb, n0 = 32 * nb;
    { const int n = n0 + (lane & 31); const float cs = (WINMAP && n >= 1772 && n < 2028) ? 0.125f * LOG2E : 1.0f;
      float v[32];
#pragma unroll
      for (int i = 0; i < 32; ++i) { const int kk = 2 * i + (lane >> 5); v[i] = n < N ? W[(size_t)(k0 + kk) * N + n] : 0.f; }
#pragma unroll
      for (int i = 0; i < 32; ++i) { const int kk = 2 * i + (lane >> 5); scr[kk * 33 + (lane & 31)] = v[i] * ((gk && k0 + kk >= gk0) ? cs * gk[k0 + kk] : cs); } }
    LDS_WAIT(); asm volatile("" ::: "memory");
    const int c = lane & 7;
#pragma unroll
    for (int j = 0; j < 4; ++j) { const int nl = (lane >> 3) + 8 * j, n = n0 + nl; const float* s = scr + (8 * c) * 33 + nl;
        v4u o; o.x = pk2(s[0 * 33], s[1 * 33]); o.y = pk2(s[2 * 33], s[3 * 33]); o.z = pk2(s[4 * 33], s[5 * 33]); o.w = pk2(s[6 * 33], s[7 * 33]);
        if (n < N) { const int dn = WINMAP ? win_dst(n) : n; const int kp = k0 + 8 * c;
            if (FRAG) *(v4u*)(WT + ((size_t)((dn >> 5) * (K >> 4) + (kp >> 4)) * 64 + ((kp >> 3) & 1) * 32 + (dn & 31)) * 8) = o;
            else *(v4u*)(WT + (size_t)dn * K + kp) = o; } }
    LDS_WAIT(); asm volatile("" ::: "memory");
}
__device__ __forceinline__ void sincos_d(float angf, float& c, float& s) {
    const double a = (double)angf; const double kq = __builtin_rint(a * 0.63661977236758134308); const int q = (int)kq;
    double r = __builtin_fma(-kq, 1.5707963267948966192, a); r = __builtin_fma(-kq, 6.123233995736766e-17, r);
    const double r2 = r * r;
    double sp = -1.0 / 39916800.0; sp = sp * r2 + 1.0 / 362880.0; sp = sp * r2 - 1.0 / 5040.0; sp = sp * r2 + 1.0 / 120.0; sp = sp * r2 - 1.0 / 6.0; sp = sp * r2 + 1.0; sp *= r;
    double cp = 1.0 / 479001600.0; cp = cp * r2 - 1.0 / 3628800.0; cp = cp * r2 + 1.0 / 40320.0; cp = cp * r2 - 1.0 / 720.0; cp = cp * r2 + 1.0 / 24.0; cp = cp * r2 - 0.5; cp = cp * r2 + 1.0;
    const int qq = q & 3;
    const double sv = (qq == 0) ? sp : (qq == 1) ? cp : (qq == 2) ? -sp : -cp;
    const double cv = (qq == 0) ? cp : (qq == 1) ? -sp : (qq == 2) ? -cp : sp;
    c = (float)cv; s = (float)sv;
}
__device__ __forceinline__ int t5_bucket(int d) {
    if (d < 16) return d;
    int b = 16 + (int)(logf((float)d / 16.0f) / logf(8.0f) * 16.0f);
    return b < 31 ? b : 31;
}

constexpr int CV_IN = (D / 64) * ((NIN + 31) / 32), CV_O = (D / 64) * (D / 32), CV_1 = (D / 64) * (FF / 32), CV_2 = (FF / 64) * (D / 32);
__device__ __forceinline__ void conv_transpose(const Frame F, float* scr, int lane_, int kind, int l, int r) {
    if (kind == 0) transpose_item<true>(((const float*)F.a->in[I_WIN]) + (size_t)l * D * NIN, D, NIN, (bf16*)(F.ws + WS_WIN) + (size_t)l * NP * D, scr, r, lane_, ((const float*)F.a->in[I_N1W]) + l * D);
    else if (kind == 1) transpose_item<false>(((const float*)F.a->in[I_WOUT]) + (size_t)l * D * D, D, D, (bf16*)(F.ws + WS_WO) + (size_t)l * D * D, scr, r, lane_, ((const float*)F.a->in[I_ONW]) + l * D, 512);
    else if (kind == 2) transpose_item<false>(((const float*)F.a->in[I_FW1]) + (size_t)l * D * FF, D, FF, (bf16*)(F.ws + WS_W1) + (size_t)l * FF * D, scr, r, lane_, ((const float*)F.a->in[I_N2W]) + l * D);
    else if (kind == 3) transpose_item<false>(((const float*)F.a->in[I_FW2]) + (size_t)l * FF * D, FF, D, (bf16*)(F.ws + WS_W2) + (size_t)l * D * FF, scr, r, lane_);
    else transpose_item<false, true>(((const float*)F.a->in[I_CW1]) + (size_t)l * 2048 * 256, 2048, 256, (bf16*)(F.ws + WS_W1C) + (size_t)l * 256 * 2048, scr, r, lane_);
}
constexpr int MLAW_Q = 12 * 12 * 64, MLAW_KV = 16 * 8 * 64, MLAW_L = MLAW_Q + MLAW_KV;
__device__ __forceinline__ void conv_mlaw(const Frame F, int it) {
    const int l = it / MLAW_L; int r = it % MLAW_L; const bool isq = r < MLAW_Q; if (!isq) r -= MLAW_Q;
    const int ln = r & 63, fr = r >> 6, KS = isq ? 12 : 8, jt = fr / KS, sx = fr % KS, j = 32 * jt + (ln & 31), c0 = 16 * sx + 8 * (ln >> 5), ldb = isq ? 384 : 512;
    const float* src = (isq ? ((const float*)F.a->in[I_WQB]) + (size_t)l * 192 * 384 : ((const float*)F.a->in[I_WKVB]) + (size_t)l * 128 * 512) + j;
    const float* g = (isq ? ((const float*)F.a->in[I_QAN]) + l * 192 : ((const float*)F.a->in[I_KVN]) + l * 128) + c0;
    float v[8];
#pragma unroll
    for (int i = 0; i < 8; ++i) v[i] = src[(size_t)(c0 + i) * ldb];
    const f32x4 g0 = *(const f32x4*)g, g1 = *(const f32x4*)(g + 4);
    v4u o; o.x = pk2(v[0] * g0[0], v[1] * g0[1]); o.y = pk2(v[2] * g0[2], v[3] * g0[3]); o.z = pk2(v[4] * g1[0], v[5] * g1[1]); o.w = pk2(v[6] * g1[2], v[7] * g1[3]);
    bf16* dst = (bf16*)(F.ws + (isq ? WS_WQF : WS_WKVF)) + (size_t)l * (isq ? 12 * 12 : 16 * 8) * 512;
    *(v4u*)(dst + ((size_t)fr * 64 + ln) * 8) = o;
}

constexpr int CV_TB = 2 * CV_O + 2 * CV_1 + 2 * CV_2 + CV_IN + 2 * 256, CV_TU = (CV_TB + 31) / 32, CV_UNITS = CV_TU;
__device__ __forceinline__ void conv_unit(const Frame F, int cu, int lane_) {
    float* scr = (float*)(F.lds + RING_OFF + F.wave * 16384);
    if (cu < CV_TU) {
        for (int i = 0; i < 4; ++i) { int idx = cu * 32 + F.wave * 4 + i; if (idx >= CV_TB) break;
            if (idx < 2 * CV_O) { conv_transpose(F, scr, lane_, 1, idx / CV_O, idx % CV_O); continue; } idx -= 2 * CV_O;
            if (idx < 2 * CV_1) { conv_transpose(F, scr, lane_, 2, idx / CV_1, idx % CV_1); continue; } idx -= 2 * CV_1;
            if (idx < 2 * CV_2) { conv_transpose(F, scr, lane_, 3, idx / CV_2, idx % CV_2); continue; } idx -= 2 * CV_2;
            if (idx < CV_IN) { conv_transpose(F, scr, lane_, 0, 1, idx); continue; } idx -= CV_IN;
            conv_transpose(F, scr, lane_, 4, 2 + (idx >> 8), idx & 255); }
    }
}
__device__ __forceinline__ void p0_deferred(Frame F, int k, int lane_) {
    OPQ_S(F.ws); OPQ_S(F.a); OPQ_V(lane_);
    float* scr = (float*)(F.lds + RING_OFF + F.wave * 16384);
    const int gw = k * NWAVES + F.wave, NGW = 128 * NWAVES, gt = gw * 64 + lane_, NT = NGW * 64;
    for (int it = gw; it < 2 * 256; it += NGW) conv_transpose(F, scr, lane_, 4, it >> 8, it & 255);
    for (int it = gt; it < DEPTH * MLAW_L; it += NT) conv_mlaw(F, it);
    if (F.wave < 2) { const int it = F.wave * 128 + k; const int hb = it & 3, ks = (it >> 2) & 15, lb = it >> 6;
        const float* pos = ((const float*)F.a->in[I_CPOS]) + (size_t)lb * 2048; const float* w1 = ((const float*)F.a->in[I_CW1]) + (size_t)lb * 2048 * 256 + hb * 64 + lane_; float a = 0.f;
        for (int k0 = ks * 128; k0 < ks * 128 + 128; k0 += 16) { float wv[16];
#pragma unroll
            for (int q = 0; q < 16; ++q) wv[q] = w1[(size_t)(k0 + q) * 256];
#pragma unroll
            for (int q = 0; q < 16; ++q) a += pos[k0 + q] * wv[q]; }
        ((float*)(F.ws + WS_CB1))[(lb * 16 + ks) * 256 + hb * 64 + lane_] = a; }
}
__device__ __forceinline__ void p0_prologue(Frame F) {
    OPQ_S(F.ws); OPQ_S(F.a); const int lane_ = opq_lane(), tid_ = F.wave * 64 + lane_;
    float* scr = (float*)(F.lds + RING_OFF + F.wave * 16384);
    const int gw = F.vcu * NWAVES + F.wave, NGW = F.G * NWAVES;
    const int gt = F.vcu * (NWAVES * 64) + tid_, NT = F.G * NWAVES * 64;
    for (int it = gw; it < CV_IN; it += NGW) conv_transpose(F, scr, lane_, 0, 0, it);
    for (int i = gt; i < DEPTH * 20 * D / 8; i += NT) { const int l = i / (20 * D / 8), r = i % (20 * D / 8);
        *(v4u*)((bf16*)(F.ws + WS_WIN) + (size_t)l * NP * D + (size_t)NIN * D + (size_t)r * 8) = (v4u){0u, 0u, 0u, 0u}; }
    for (int i = gt; i < SEQ * 16; i += NT) { const int t = i >> 4, j = i & 15;
        const double pb = (j & 3) == 0 ? 1.0 : (j & 3) == 1 ? 0.56234132519034908 : (j & 3) == 2 ? 0.31622776601683794 : 0.17782794100389228;
        const int e = j >> 2; const double ps = e == 0 ? 1.0 : e == 1 ? 0.1 : e == 2 ? 0.01 : 0.001;
        const float inv = (float)(pb * ps); const float ang = (float)t * inv; float c, s; sincos_d(ang, c, s);
        ((float*)(F.ws + WS_ROPE))[i] = c; ((float*)(F.ws + WS_ROPE))[SEQ * 16 + i] = s; }
    for (int i = gt; i < 128 * 4; i += NT) { const int d = i >> 2, h = i & 3; ((float*)(F.ws + WS_TB))[i] = ((const float*)F.a->in[I_RELB])[t5_bucket(d) * 4 + h] * LOG2E; }
    for (int m0 = gw; m0 < M; m0 += 2 * NGW) {
        f32x4 v[2][4]; float sq[2] = {0.f, 0.f};
#pragma unroll
        for (int q = 0; q < 2; ++q) { const f32x4* xr = (const f32x4*)(((const float*)F.a->in[I_X]) + (size_t)(m0 + q * NGW) * D) + lane_;
#pragma unroll
            for (int j = 0; j < 4; ++j) v[q][j] = xr[64 * j]; }
#pragma unroll
        for (int q = 0; q < 2; ++q) { const int m = m0 + q * NGW; unsigned long long* o8 = (unsigned long long*)((bf16*)(F.ws + WS_XB) + (size_t)m * D) + lane_;
#pragma unroll
            for (int j = 0; j < 4; ++j) { sq[q] += (v[q][j].x * v[q][j].x + v[q][j].y * v[q][j].y) + (v[q][j].z * v[q][j].z + v[q][j].w * v[q][j].w);
                o8[64 * j] = (unsigned long long)pk2(v[q][j].x, v[q][j].y) | ((unsigned long long)pk2(v[q][j].z, v[q][j].w) << 32); }
            const float t = wsum(sq[q]); if (lane_ == 0) *(f32x4*)((float*)(F.ws + WS_SSQX) + (size_t)m * 4) = (f32x4){t, 0.f, 0.f, 0.f}; }
    }
}
__device__ __forceinline__ float red8(float v) { v += __shfl_xor(v, 1); v += __shfl_xor(v, 2); v += __shfl_xor(v, 4); return v; }
__device__ __forceinline__ void un8(const v4u w, float (&f)[8]) { f[0] = bflo(w.x); f[1] = bfhi(w.x); f[2] = bflo(w.y); f[3] = bfhi(w.y); f[4] = bflo(w.z); f[5] = bfhi(w.z); f[6] = bflo(w.w); f[7] = bfhi(w.w); }
__device__ __forceinline__ void ldf8(const float* p, float (&f)[8]) { const f32x4 a = *(const f32x4*)p, b = *(const f32x4*)(p + 4); f[0] = a.x; f[1] = a.y; f[2] = a.z; f[3] = a.w; f[4] = b.x; f[5] = b.y; f[6] = b.z; f[7] = b.w; }
__device__ __forceinline__ void st8(bf16* p, const float (&f)[8]) { v4u w; w.x = att::cvtpk(f[0], f[1]); w.y = att::cvtpk(f[2], f[3]); w.z = att::cvtpk(f[4], f[5]); w.w = att::cvtpk(f[6], f[7]); *(v4u*)p = w; }
__device__ __forceinline__ float ss8(const float (&f)[8]) { return ((f[0] * f[0] + f[1] * f[1]) + (f[2] * f[2] + f[3] * f[3])) + ((f[4] * f[4] + f[5] * f[5]) + (f[6] * f[6] + f[7] * f[7])); }
__device__ __forceinline__ void rope8(float (&x)[8], const float (&c)[8], const float (&s)[8], bool first) {
#pragma unroll
    for (int j = 0; j < 8; ++j) { const float o = __shfl_xor(x[j], 2); x[j] = first ? x[j] * c[j] - o * s[j] : o * s[j] + x[j] * c[j]; }
}
__device__ __forceinline__ void compress_unit(const Frame F, int l, int u) {
    const int lane = opq_lane(), tid = F.wave * 64 + lane, w = F.wave, r32 = lane & 31, h = lane >> 5;
    const int g4 = u & 3, br = (u >> 2) & 1, b = u >> 3, n0 = 32 * g4, lb = l * 2 + br;
    LAS unsigned char* lds = (LAS unsigned char*)F.lds;
    LAS float* biasL = (LAS float*)lds; LAS float* part = (LAS float*)(lds + 1024); LAS float* ssl = (LAS float*)(lds + 1024 + 65536);
    const bf16* P = (const bf16*)(F.ws + WS_P);
    if (tid < 256) { const float* cb1 = (const float*)(F.ws + WS_CB1) + (size_t)lb * 16 * 256 + tid; float bs = 0.f;
        float t16[16];
#pragma unroll
        for (int ks = 0; ks < 16; ++ks) t16[ks] = cb1[ks * 256];
#pragma unroll
        for (int ks = 0; ks < 16; ++ks) bs += t16[ks];
        biasL[tid] = bs; }
    att::f32x16 acc = {};
    {
        const bf16* w1f = (const bf16*)(F.ws + WS_W1C) + (size_t)lb * 256 * 2048 + ((size_t)w * 128 * 64 + lane) * 8;
        const bf16* tkb = P + ((size_t)b * SEQ + 16 * n0) * NP + (br ? C_VC : C_KC);
        LAS unsigned char* tb = lds + 1024;
        v4u rg[4];
#define CMP_ISSUE(c) do { _Pragma("unroll") for (int i = 0; i < 4; ++i) { const int idx = tid + 512 * i, p8 = idx & 7, rid = idx >> 3, rr = rid & 31, tq = rid >> 5; \
            rg[i] = *(const v4u*)(tkb + (size_t)(16 * rr + 8 * (c) + tq) * NP + 8 * p8); } } while (0)
#define CMP_COMMIT(c) do { _Pragma("unroll") for (int i = 0; i < 4; ++i) { const int idx = tid + 512 * i, p8 = idx & 7, rid = idx >> 3, rr = rid & 31, tq = rid >> 5; \
            *(LAS v4u*)(tb + ((c) & 1) * 32768 + ((tq * 8 + p8) * 32 + rr) * 16) = rg[i]; } } while (0)
        CMP_ISSUE(0); CMP_COMMIT(0);
        __syncthreads();
        PHASE_END(21);
        for (int c = 0; c < 4; ++c) {
            if (c < 3) CMP_ISSUE(c + 1);
            const LAS unsigned char* cb = tb + (c & 1) * 32768 + r32 * 16;
#pragma unroll
            for (int s8 = 0; s8 < 4; ++s8) { bf16x8 af[8], bfr[8];
#pragma unroll
                for (int q = 0; q < 8; ++q) { const int sl = 8 * s8 + q; af[q] = *(const bf16x8*)(w1f + (size_t)(32 * c + sl) * 512); }
#pragma unroll
                for (int q = 0; q < 8; ++q) { const int sl = 8 * s8 + q; bfr[q] = *(const LAS bf16x8*)(cb + (((sl >> 2) * 8 + (sl & 3) * 2 + h) * 32) * 16); }
#pragma unroll
                for (int q = 0; q < 8; ++q) acc = MFMA32(af[q], bfr[q], acc); }
            if (c < 3) CMP_COMMIT(c + 1);
            __syncthreads();
        }
#undef CMP_ISSUE
#undef CMP_COMMIT
    }
    PHASE_END(22);
#pragma unroll
    for (int i = 0; i < 16; ++i) { const float x = acc[i] + biasL[32 * w + att::crow(i, h)]; acc[i] = x / (1.0f + __expf(-x)); }
    { att::f32x16 o0 = {}, o1 = {}; const float* w2 = ((const float*)F.a->in[I_CW2]) + (size_t)lb * 256 * 64;
#pragma unroll
      for (int s = 0; s < 2; ++s) { const bf16x8 bfr = att::packfrag(acc, s);
#pragma unroll
          for (int eb = 0; eb < 2; ++eb) { float a8[8];
#pragma unroll
              for (int j = 0; j < 8; ++j) a8[j] = w2[(size_t)(32 * w + 16 * s + 8 * (j >> 2) + 4 * h + (j & 3)) * 64 + 32 * eb + r32];
              v4u pw; pw.x = att::cvtpk(a8[0], a8[1]); pw.y = att::cvtpk(a8[2], a8[3]); pw.z = att::cvtpk(a8[4], a8[5]); pw.w = att::cvtpk(a8[6], a8[7]);
              const bf16x8 af = __builtin_bit_cast(bf16x8, pw);
              if (eb == 0) o0 = MFMA32(af, bfr, o0); else o1 = MFMA32(af, bfr, o1); } }
#pragma unroll
      for (int i = 0; i < 16; ++i) { part[(w * 64 + att::crow(i, h)) * 32 + r32] = o0[i]; part[(w * 64 + 32 + att::crow(i, h)) * 32 + r32] = o1[i]; } }
    __syncthreads();
    PHASE_END(23);
    { const int r = tid & 31, eg = tid >> 5; float o[4];
#pragma unroll
      for (int q = 0; q < 4; ++q) { float a = 0.f;
#pragma unroll
          for (int ww = 0; ww < 8; ++ww) a += part[(ww * 64 + 4 * eg + q) * 32 + r];
          o[q] = a; }
      if (br == 0) { ssl[eg * 32 + r] = (o[0] * o[0] + o[1] * o[1]) + (o[2] * o[2] + o[3] * o[3]);
          __syncthreads();
          float tot = 0.f;
#pragma unroll
          for (int e2 = 0; e2 < 16; ++e2) tot += ssl[e2 * 32 + r];
          const float rstd = 1.0f / sqrtf(tot * (1.f / 64.f) + EPS); const float* kn = ((const float*)F.a->in[I_NKN]) + l * 192 + 4 * eg;
#pragma unroll
          for (int q = 0; q < 4; ++q) o[q] *= rstd * kn[q]; }
      const int n = n0 + r; uint2 wv; wv.x = att::cvtpk(o[0], o[1]); wv.y = att::cvtpk(o[2], o[3]); if (n >= NCMP) { wv.x = 0u; wv.y = 0u; }
      *(uint2*)((bf16*)(F.ws + WS_KCV) + (size_t)br * 65536 + ((size_t)b * 128 + n) * 64 + 4 * eg) = wv; }
    __syncthreads();
}
__device__ __forceinline__ void convmix_unit(const Frame F, int l, int unit, int lane) {
    const bf16* P = (const bf16*)(F.ws + WS_P); bf16* Y = (bf16*)(F.ws + WS_Y);
    const float* cw = ((const float*)F.a->in[I_CONVW]) + l * 768; const float* cb = ((const float*)F.a->in[I_CONVB]) + l * 256; const float* onw = ((const float*)F.a->in[I_ONW]) + l * 1024;
    const int ts = lane >> 3, ch = lane & 7;
    {
        const int m = unit * 64 + F.wave * 8 + ts, t = m % SEQ; const bf16* pr = P + (size_t)m * NP;
        const float m1 = t >= 1 ? 1.f : 0.f, m2 = t >= 2 ? 1.f : 0.f; const bf16* p1 = pr - (t >= 1 ? NP : 0); const bf16* p2 = pr - (t >= 2 ? 2 * NP : 0);
        float y[4][8]; float ssy = 0.f;
#pragma unroll
        for (int sg = 0; sg < 4; ++sg) { const int col = 64 * sg + 8 * ch; v4u rv[7]; float w0[8], w1[8], w2[8], cbv[8];
            rv[0] = *(const v4u*)(pr + C_AC + col); rv[1] = *(const v4u*)(pr + C_AU + col); rv[2] = *(const v4u*)(p1 + C_AC + col); rv[3] = *(const v4u*)(p1 + C_AU + col);
            rv[4] = *(const v4u*)(p2 + C_AC + col); rv[5] = *(const v4u*)(p2 + C_AU + col); rv[6] = *(const v4u*)(pr + C_AB + col);
            ldf8(cw + col, w0); ldf8(cw + 256 + col, w1); ldf8(cw + 512 + col, w2); ldf8(cb + col, cbv);
            float u[8], v0[8], v1[8], v2[8];
            un8(rv[0], v0); un8(rv[1], u);
#pragma unroll
            for (int j = 0; j < 8; ++j) v0[j] *= u[j];
            un8(rv[2], v1); un8(rv[3], u);
#pragma unroll
            for (int j = 0; j < 8; ++j) v1[j] *= u[j] * m1;
            un8(rv[4], v2); un8(rv[5], u);
#pragma unroll
            for (int j = 0; j < 8; ++j) v2[j] *= u[j] * m2;
            un8(rv[6], u);
#pragma unroll
            for (int j = 0; j < 8; ++j) y[sg][j] = u[j] * (w0[j] * v2[j] + w1[j] * v1[j] + w2[j] * v0[j] + cbv[j]);
            ssy += ss8(y[sg]); }
        { const float rstd = 1.0f / sqrtf(red8(ssy) * (1.f / 256.f) + EPS); float go[4][8];
#pragma unroll
          for (int sg = 0; sg < 4; ++sg) ldf8(onw + 64 * sg + 8 * ch, go[sg]);
#pragma unroll
          for (int sg = 0; sg < 4; ++sg) {
#pragma unroll
              for (int j = 0; j < 8; ++j) y[sg][j] *= rstd * go[sg][j];
              st8(Y + (size_t)m * D + 64 * sg + 8 * ch, y[sg]); } }
    }
}
__device__ __forceinline__ void prep_phase(Frame F, int l) {
    OPQ_S(F.ws); OPQ_S(F.a); const int lane_ = opq_lane(), tid_ = F.wave * 64 + lane_;
    const int lane = lane_; const int gw = F.vcu * NWAVES + F.wave, NGW = F.G * NWAVES;
    const bf16* P = (const bf16*)(F.ws + WS_P);
    const float* mqn = ((const float*)F.a->in[I_MQN]) + l * 96; const float* mkn = ((const float*)F.a->in[I_MKN]) + l * 96;
    const float* nkn = ((const float*)F.a->in[I_NKN]) + l * 192;
    const float* cw = ((const float*)F.a->in[I_CONVW]) + l * 768; const float* cb = ((const float*)F.a->in[I_CONVB]) + l * 256; const float* onw = ((const float*)F.a->in[I_ONW]) + l * 1024;
    const float* cosT = (const float*)(F.ws + WS_ROPE); const float* sinT = cosT + SEQ * 16;
    GAS unsigned char* ob_ = (GAS unsigned char*)F.a->out; bf16* QM = (bf16*)(ob_ + OUT_QM); bf16* KM = (bf16*)(ob_ + OUT_KM); bf16* VM = (bf16*)(ob_ + OUT_VM);
    bf16* KSn = (bf16*)(F.ws + WS_KS); bf16* KWn = (bf16*)(F.ws + WS_KW); bf16* Y = (bf16*)(F.ws + WS_Y);
    const int ts = lane >> 3, ch = lane & 7; const bool ropelane = ch < 4, first = ch < 2;
    constexpr int LATP = 328;
    LAS unsigned char* ldsb = (LAS unsigned char*)F.lds; LAS bf16* latn = (LAS bf16*)ldsb;
    bf16* QKV = (bf16*)(F.ws + WS_QKV);
    for (int unit = F.vcu; unit < M / 64; unit += F.G) {
        const int m = unit * 64 + F.wave * 8 + ts, t = m % SEQ; const bf16* pr = P + (size_t)m * NP;
        float a[8];
        { v4u rl[5];
#pragma unroll
          for (int sg = 0; sg < 3; ++sg) rl[sg] = *(const v4u*)(pr + C_CQ + 64 * sg + 8 * ch);
#pragma unroll
          for (int sg = 0; sg < 2; ++sg) rl[3 + sg] = *(const v4u*)(pr + C_CKV + 64 * sg + 8 * ch);
          float ss = 0.f;
#pragma unroll
          for (int sg = 0; sg < 3; ++sg) { un8(rl[sg], a); ss += ss8(a); }
          const float rq = 1.0f / sqrtf(red8(ss) * (1.f / 192.f) + EPS); ss = 0.f;
#pragma unroll
          for (int sg = 0; sg < 2; ++sg) { un8(rl[3 + sg], a); ss += ss8(a); }
          const float rkv = 1.0f / sqrtf(red8(ss) * (1.f / 128.f) + EPS);
          LAS bf16* lrow = latn + (F.wave * 8 + ts) * LATP + 8 * ch;
#pragma unroll
          for (int sg = 0; sg < 5; ++sg) { un8(rl[sg], a); const float r_ = sg < 3 ? rq : rkv; v4u w;
              w.x = att::cvtpk(a[0] * r_, a[1] * r_); w.y = att::cvtpk(a[2] * r_, a[3] * r_); w.z = att::cvtpk(a[4] * r_, a[5] * r_); w.w = att::cvtpk(a[6] * r_, a[7] * r_);
              *(LAS v4u*)(lrow + 64 * sg) = w; } }
        __syncthreads();
        { const int r32 = lane & 31, h = lane >> 5;
          for (int jt = F.wave; jt < 28; jt += 8) {
              const bool isq = jt < 12;
              const bf16* wf = (isq ? (const bf16*)(F.ws + WS_WQF) + ((size_t)l * 144 + jt * 12) * 512 : (const bf16*)(F.ws + WS_WKVF) + ((size_t)l * 128 + (jt - 12) * 8) * 512) + lane * 8;
              const LAS bf16* lb = latn + r32 * LATP + (isq ? 0 : 192) + 8 * h;
              att::f32x16 c0 = {}, c1 = {};
              bf16x8 af[12];
#pragma unroll
              for (int sx = 0; sx < 12; ++sx) af[sx] = (sx < 8 || isq) ? *(const bf16x8*)(wf + (size_t)sx * 512) : af[0];
#pragma unroll
              for (int sx = 0; sx < 12; ++sx) { if (sx < 8 || isq) { const bf16x8 b0 = *(const LAS bf16x8*)(lb + 16 * sx), b1 = *(const LAS bf16x8*)(lb + 32 * LATP + 16 * sx);
                      c0 = MFMA32(af[sx], b0, c0); c1 = MFMA32(af[sx], b1, c1); } }
              bf16* q0 = QKV + (size_t)(unit * 64 + r32) * NQKV + 32 * jt + 4 * h; bf16* q1 = q0 + (size_t)32 * NQKV;
#pragma unroll
              for (int g4 = 0; g4 < 4; ++g4) { uint2 w0; w0.x = att::cvtpk(c0[4 * g4], c0[4 * g4 + 1]); w0.y = att::cvtpk(c0[4 * g4 + 2], c0[4 * g4 + 3]); *(uint2*)(q0 + 8 * g4) = w0;
                  uint2 w1; w1.x = att::cvtpk(c1[4 * g4], c1[4 * g4 + 1]); w1.y = att::cvtpk(c1[4 * g4 + 2], c1[4 * g4 + 3]); *(uint2*)(q1 + 8 * g4) = w1; } } }
        __syncthreads();
        const bf16* qk = QKV + (size_t)m * NQKV;
        v4u rkr, rh[2][4];
        rkr = *(const v4u*)(pr + C_KR + 8 * (ch & 3));
        float rc[8], rs[8]; ldf8(cosT + t * 16 + 8 * (ch & 1), rc); ldf8(sinT + t * 16 + 8 * (ch & 1), rs);
#define TOK_LOAD_HEADS(h0) do { _Pragma("unroll") for (int q_ = 0; q_ < 2; ++q_) { const int hh_ = (h0) + q_; rh[q_][0] = *(const v4u*)(qk + 96 * hh_ + 8 * ch); rh[q_][1] = *(const v4u*)(qk + 96 * hh_ + 64 + 8 * (ch & 3)); \
            rh[q_][2] = *(const v4u*)(qk + 384 + 128 * hh_ + 8 * ch); rh[q_][3] = *(const v4u*)(qk + 384 + 128 * hh_ + 64 + 8 * ch); } } while (0)
        TOK_LOAD_HEADS(0);
        float gqn[8], gqr[8], gkn[8], gkr[8]; ldf8(mqn + 8 * ch, gqn); ldf8(mqn + 64 + 8 * (ch & 3), gqr); ldf8(mkn + 8 * ch, gkn); ldf8(mkn + 64 + 8 * (ch & 3), gkr);
        float kr[8];
        un8(rkr, kr);
#pragma unroll
        for (int j = 0; j < 8; ++j) kr[j] = ropelane ? kr[j] : 0.f;
        rope8(kr, rc, rs, first);
        const float sskr = ss8(kr);
#pragma unroll
        for (int hh = 0; hh < 4; ++hh) {
            if (hh == 2) TOK_LOAD_HEADS(2);
            float qr[8];
            un8(rh[hh & 1][0], a); un8(rh[hh & 1][1], qr);
#pragma unroll
            for (int j = 0; j < 8; ++j) qr[j] = ropelane ? qr[j] : 0.f;
            rope8(qr, rc, rs, first);
            float rstd = 1.0f / sqrtf(red8(ss8(a) + ss8(qr)) * (1.f / 96.f) + EPS) * (0.10206207261596577f * LOG2E);
            bf16* qo = QM + ((size_t)m * 4 + hh) * 96;
#pragma unroll
            for (int j = 0; j < 8; ++j) { a[j] *= rstd * gqn[j]; qr[j] *= rstd * gqr[j]; }
            st8(qo + 8 * ch, a);
            if (ropelane) st8(qo + 64 + 8 * ch, qr);
            un8(rh[hh & 1][2], a);
            rstd = 1.0f / sqrtf(red8(ss8(a) + sskr) * (1.f / 96.f) + EPS);
            bf16* ko = KM + ((size_t)m * 4 + hh) * 96;
#pragma unroll
            for (int j = 0; j < 8; ++j) a[j] *= rstd * gkn[j];
            st8(ko + 8 * ch, a);
#pragma unroll
            for (int j = 0; j < 8; ++j) a[j] = kr[j] * rstd * gkr[j];
            if (ropelane) st8(ko + 64 + 8 * ch, a);
            *(v4u*)(VM + (size_t)m * 256 + 64 * hh + 8 * ch) = rh[hh & 1][3];
        }
        __syncthreads();
    }
    for (int task = gw; task < M / 8; task += NGW) {
        const int m = task * 8 + ts; const bf16* pr = P + (size_t)m * NP;
        float a[8];
        { v4u rks = *(const v4u*)(pr + C_KS + 8 * ch), rkw = *(const v4u*)(pr + C_KW + 8 * ch); float gks[8], gkw[8]; ldf8(nkn + 64 + 8 * ch, gks); ldf8(nkn + 128 + 8 * ch, gkw);
          un8(rks, a); float rstd = 1.0f / sqrtf(red8(ss8(a)) * (1.f / 64.f) + EPS);
#pragma unroll
          for (int j = 0; j < 8; ++j) a[j] *= rstd * gks[j];
          st8(KSn + (size_t)m * 64 + 8 * ch, a);
          un8(rkw, a); rstd = 1.0f / sqrtf(red8(ss8(a)) * (1.f / 64.f) + EPS);
#pragma unroll
          for (int j = 0; j < 8; ++j) a[j] *= rstd * gkw[j];
          st8(KWn + (size_t)m * 64 + 8 * ch, a); }
    }
#undef TOK_LOAD_HEADS
    __syncthreads();
    PHASE_END(20);
    for (int rep_ = 0; rep_ < (PROBE_DUP == 3 ? 2 : 1); ++rep_)
    for (int u = F.vcu; u < BATCH * 2 * 4; u += F.G) compress_unit(F, l, u);
}

constexpr int ATT_UNITS = 768, ATT_FILL_POS = 400;
__device__ const unsigned short ATT_ORDER[768] = {4127,4159,4191,4223,4255,4287,4319,4351,4126,4158,4190,4222,4254,4286,4318,4350,4125,4157,4189,4221,4253,4285,4317,4349,4124,4156,4188,4220,4252,4284,4316,4348,4123,4155,4187,4219,4251,4283,4315,4347,4122,4154,4186,4218,4250,4282,4314,4346,4121,4153,4185,4217,4249,4281,4313,4345,4120,4152,4184,4216,4248,4280,4312,4344,4119,4151,4183,4215,4247,4279,4311,4343,4118,4150,4182,4214,4246,4278,4310,4342,4117,4149,4181,4213,4245,4277,4309,4341,4116,4148,4180,4212,4244,4276,4308,4340,4115,4147,4179,4211,4243,4275,4307,4339,4114,4146,4178,4210,4242,4274,4306,4338,4113,4145,4177,4209,4241,4273,4305,4337,4112,4144,4176,4208,4240,4272,4304,4336,4111,4143,4175,4207,4239,4271,4303,4335,4110,4142,4174,4206,4238,4270,4302,4334,4109,4141,4173,4205,4237,4269,4301,4333,4108,4140,4172,4204,4236,4268,4300,4332,7,15,23,31,39,47,55,63,71,79,87,95,103,111,119,127,135,143,151,159,167,175,183,191,199,207,215,223,231,239,247,255,4107,4139,4171,4203,4235,4267,4299,4331,4106,4138,4170,4202,4234,4266,4298,4330,4105,4137,4169,4201,4233,4265,4297,4329,6,14,22,30,38,46,54,62,70,78,86,94,102,110,118,126,134,142,150,158,166,174,182,190,198,206,214,222,230,238,246,254,4104,4136,4168,4200,4232,4264,4296,4328,4103,4135,4167,4199,4231,4263,4295,4327,5,13,21,29,37,45,53,61,69,77,85,93,101,109,117,125,133,141,149,157,165,173,181,189,197,205,213,221,229,237,245,253,4102,4134,4166,4198,4230,4262,4294,4326,4101,4133,4165,4197,4229,4261,4293,4325,4,12,20,28,36,44,52,60,68,76,84,92,100,108,116,124,132,140,148,156,164,172,180,188,196,204,212,220,228,236,244,252,4100,4132,4164,4196,4228,4260,4292,4324,3,11,19,27,35,43,51,59,67,75,83,91,99,107,115,123,131,139,147,155,163,171,179,187,195,203,211,219,227,235,243,251,4099,4131,4163,4195,4227,4259,4291,4323,4098,4130,4162,4194,4226,4258,4290,4322,2,10,18,26,34,42,50,58,66,74,82,90,98,106,114,122,130,138,146,154,162,170,178,186,194,202,210,218,226,234,242,250,4097,4129,4161,4193,4225,4257,4289,4321,8199,8207,8215,8223,8231,8239,8247,8255,8263,8271,8279,8287,8295,8303,8311,8319,8327,8335,8343,8351,8359,8367,8375,8383,8391,8399,8407,8415,8423,8431,8439,8447,8198,8206,8214,8222,8230,8238,8246,8254,8262,8270,8278,8286,8294,8302,8310,8318,8326,8334,8342,8350,8358,8366,8374,8382,8390,8398,8406,8414,8422,8430,8438,8446,8197,8205,8213,8221,8229,8237,8245,8253,8261,8269,8277,8285,8293,8301,8309,8317,8325,8333,8341,8349,8357,8365,8373,8381,8389,8397,8405,8413,8421,8429,8437,8445,8196,8204,8212,8220,8228,8236,8244,8252,8260,8268,8276,8284,8292,8300,8308,8316,8324,8332,8340,8348,8356,8364,8372,8380,8388,8396,8404,8412,8420,8428,8436,8444,8195,8203,8211,8219,8227,8235,8243,8251,8259,8267,8275,8283,8291,8299,8307,8315,8323,8331,8339,8347,8355,8363,8371,8379,8387,8395,8403,8411,8419,8427,8435,8443,8194,8202,8210,8218,8226,8234,8242,8250,8258,8266,8274,8282,8290,8298,8306,8314,8322,8330,8338,8346,8354,8362,8370,8378,8386,8394,8402,8410,8418,8426,8434,8442,8193,8201,8209,8217,8225,8233,8241,8249,8257,8265,8273,8281,8289,8297,8305,8313,8321,8329,8337,8345,8353,8361,8369,8377,8385,8393,8401,8409,8417,8425,8433,8441,1,9,17,25,33,41,49,57,65,73,81,89,97,105,113,121,129,137,145,153,161,169,177,185,193,201,209,217,225,233,241,249,4096,4128,4160,4192,4224,4256,4288,4320,8192,8200,8208,8216,8224,8232,8240,8248,8256,8264,8272,8280,8288,8296,8304,8312,8320,8328,8336,8344,8352,8360,8368,8376,8384,8392,8400,8408,8416,8424,8432,8440,0,8,16,24,32,40,48,56,64,72,80,88,96,104,112,120,128,136,144,152,160,168,176,184,192,200,208,216,224,232,240,248};

__device__ __forceinline__ void attn_phase(Frame F, int l, int qslot_i = 0) {
    OPQ_S(F.ws); OPQ_S(F.a); const int lane_ = opq_lane(), tid_ = F.wave * 64 + lane_;
    const int tid = tid_;
    LAS unsigned char* lds = (LAS unsigned char*)F.lds;
    LAS float* tb2 = (LAS float*)(lds + TB_OFF);
    LAS unsigned* qslot = (LAS unsigned*)(lds + MISC_OFF) + 16;
    LAS unsigned* sbflags = (LAS unsigned*)(lds + att::NSA_END);
    for (int i = tid; i < 512; i += NWAVES * 64) tb2[i] = ((const float*)(F.ws + WS_TB))[i];
    const bf16* P = (const bf16*)(F.ws + WS_P);
    const GAS unsigned char* ob_ = (const GAS unsigned char*)F.a->out; const bf16* QM = (const bf16*)(ob_ + OUT_QM); const bf16* KM = (const bf16*)(ob_ + OUT_KM); const bf16* VM = (const bf16*)(ob_ + OUT_VM);
    const float* nqn = ((const float*)F.a->in[I_NQN]) + l * 64; const bf16* KSn = (const bf16*)(F.ws + WS_KS); const bf16* KWn = (const bf16*)(F.ws + WS_KW);
    const bf16* KC = (const bf16*)(F.ws + WS_KCV); const bf16* VC = KC + 65536;
    bf16* Y = (bf16*)(F.ws + WS_Y); float* SSQ = (float*)(F.ws + WS_SSQ); const float* onw = ((const float*)F.a->in[I_ONW]) + l * 1024;
    unsigned* qhead = (unsigned*)(F.ws + WS_CTL) + CW_QUEUE + 64 * (l + 2 * qslot_i);
    PHASE_END(27);
    const int nfill = (l == 0) ? CV_UNITS : 0;
    if (F.wave >= 4) __builtin_amdgcn_s_setprio(1);
    for (;;) {
        __syncthreads();
        if (tid == 0) qslot[0] = __hip_atomic_fetch_add(qhead, 1u, __ATOMIC_RELAXED, __HIP_MEMORY_SCOPE_AGENT);
        __syncthreads();
        int u = __builtin_amdgcn_readfirstlane((int)qslot[0]);
        if (u >= ATT_UNITS + nfill + M / 64) break;
        if (u >= ATT_UNITS + nfill) { convmix_unit(F, l, u - ATT_UNITS - nfill, opq_lane()); PHASE_END(28); continue; }
        if (u >= ATT_FILL_POS && u < ATT_FILL_POS + nfill) {
            __syncthreads(); if (tid == 0) qslot[2] = __hip_atomic_fetch_add((unsigned*)(F.ws + WS_CTL) + CW_FILL, 1u, __ATOMIC_RELAXED, __HIP_MEMORY_SCOPE_AGENT); __syncthreads();
            const int fu = __builtin_amdgcn_readfirstlane((int)qslot[2]); if (fu < CV_UNITS) { conv_unit(F, fu, opq_lane()); PHASE_END(28); }
            continue; }
        if (u >= ATT_FILL_POS) u -= nfill;
        const int code = __builtin_amdgcn_readfirstlane((int)ATT_ORDER[u]), ty = code >> 12, bb = (code >> 5) & 7;
        if (ty == 0) { att::mla_unit(bb, (code >> 3) & 3, code & 7, QM, KM, VM, Y, SSQ, lds, tid); PHASE_END(24); }
        else if (ty == 1) { att::nsa_unit(bb, code & 31, P, nqn, KSn, KWn, KC, VC, onw, Y, lds, tb2, tid); if (u < 8 && l == 1) PHASE_MAXG(29, F.ws); else PHASE_END(25); }
        else { att::sb_unit(bb, (code >> 3) & 3, code & 7, P, Y, SSQ, lds, sbflags, tid); PHASE_END(26); }
    }
    __builtin_amdgcn_s_setprio(0);
}
#ifndef PROBE_DUP
#define PROBE_DUP -1
#endif
#define IN(k) (lo <= (k) && (k) < hi)
#define SEAM() do { if (MK_ONE_LAUNCH) { XcdBarrier b2_ = bar; OPQ_S(b2_.bar); xcd_barrier(b2_, F.wave == 0 && opq_lane() == 0); } } while (0)
__device__ __forceinline__ void layer_body(const Args& args, const Frame F, const XcdBarrier& bar, LAS unsigned char* ldsl, const int lo, const int hi, const int l) {
        const int pb = 1 + 6 * l;
        if (IN(pb + 0)) {
            GAS unsigned char* ws = (GAS unsigned char*)args.ws; OPQ_S(ws);
            pg8::Gemm g{(const bf16*)(ws + WS_XB), (const bf16*)(ws + WS_WIN) + (size_t)l * NP * D, M, NP, D}; pg8::StaticOrder S; S.init(M, NP, F.G, (int)blockIdx.x);
            { LAS float* rsT_ = (LAS float*)(ldsl + RST_OFF); const int t_ = F.wave * 64 + opq_lane(); const float* sq_ = (const float*)(ws + WS_SSQX);
              if (t_ < 256) {
#pragma unroll 1
                  for (int i_ = 0; i_ < 4; ++i_) { pg8::Unit uu_; if (!S.next(i_, uu_)) break; const f32x4 q_ = *(const f32x4*)(sq_ + ((size_t)uu_.pm * 256 + t_) * 4);
                      rsT_[i_ * 256 + t_] = 1.0f / sqrtf(((q_[0] + q_[1]) + (q_[2] + q_[3])) * (1.f / 1024.f) + EPS); } }
              __syncthreads(); }
            pg8::EpiBf16S<0> E{(bf16*)(ws + WS_P), NP, (const LAS float*)(ldsl + RST_OFF)};
            pg8::gemm_phase<pg8::EpiBf16S<0>, pg8::StaticOrder, PG8_ALIGN, PG8_SP2>(ldsl + RING_OFF, g, S, E, F.wave);
            if (l == 0) { pg8::Unit tmp_; if (!S.next(2, tmp_)) { p0_deferred(F, (int)blockIdx.x - 128, opq_lane());
                LAS unsigned* qs_ = (LAS unsigned*)(ldsl + MISC_OFF) + 16;
                if (F.wave == 0 && opq_lane() == 0) qs_[0] = __hip_atomic_fetch_add((unsigned*)(ws + WS_CTL) + CW_FILL, 1u, __ATOMIC_RELAXED, __HIP_MEMORY_SCOPE_AGENT);
                __syncthreads();
                const int fu = __builtin_amdgcn_readfirstlane((int)qs_[0]);
                if (fu < CV_UNITS) conv_unit(F, fu, opq_lane()); } }
            SEAM(); PHASE_END(pb + 0); }
        if (IN(pb + 1)) { prep_phase(F, l); SEAM(); if (PROBE_DUP == 1) { prep_phase(F, l); SEAM(); } PHASE_END(pb + 1); }
        if (IN(pb + 2)) { attn_phase(F, l); SEAM(); if (PROBE_DUP == 2) { attn_phase(F, l, 1); SEAM(); } PHASE_END(pb + 2); }
        if (IN(pb + 3)) {
            GAS unsigned char* ws = (GAS unsigned char*)args.ws; OPQ_S(ws);
            pg8::Gemm g{(const bf16*)(ws + WS_Y), (const bf16*)(ws + WS_WO) + (size_t)l * D * D, M, D, D}; pg8::StaticOrder S; S.init(M, D, F.G, (int)blockIdx.x);
            { LAS float* ks_ = (LAS float*)(ldsl + RST_OFF); const int t_ = F.wave * 64 + opq_lane(); pg8::Unit uu_;
              if (t_ < 256 && S.next(0, uu_)) { const float* sq_ = (const float*)(ws + WS_SSQ) + ((size_t)uu_.pm * 256 + t_) * 8; const f32x4 a_ = *(const f32x4*)sq_, b_ = *(const f32x4*)(sq_ + 4);
                  const float v2_ = ((a_[0] + a_[1]) + (a_[2] + a_[3])) * (1.f / 256.f) + EPS, v3_ = ((b_[0] + b_[1]) + (b_[2] + b_[3])) * (1.f / 256.f) + EPS;
                  const float r2_ = 1.0f / sqrtf(v2_), r3_ = 1.0f / sqrtf(v3_);
                  ks_[t_] = sqrtf(v2_); ks_[256 + t_] = r2_ * sqrtf(v3_); ks_[512 + t_] = r3_; }
              __syncthreads(); }
            pg8::EpiResNorm<false, true> E{nullptr, (bf16*)(ws + WS_XB), (float*)(ws + WS_SSQX), D, (const LAS float*)(ldsl + RST_OFF)};
            pg8::gemm_phase<pg8::EpiResNorm<false, true>, pg8::StaticOrder, false, PG8_SP2>(ldsl + RING_OFF, g, S, E, F.wave);
            SEAM(); PHASE_END(pb + 3); }
        if (IN(pb + 4)) {
            GAS unsigned char* ws = (GAS unsigned char*)args.ws; OPQ_S(ws);
            pg8::Gemm g{(const bf16*)(ws + WS_XB), (const bf16*)(ws + WS_W1) + (size_t)l * FF * D, M, FF, D}; pg8::StaticOrder S; S.init(M, FF, F.G, (int)blockIdx.x);
            { LAS float* rsT_ = (LAS float*)(ldsl + RST_OFF); const int t_ = F.wave * 64 + opq_lane(); const float* sq_ = (const float*)(ws + WS_SSQX);
              if (t_ < 256) {
#pragma unroll 1
                  for (int i_ = 0; i_ < 4; ++i_) { pg8::Unit uu_; if (!S.next(i_, uu_)) break; const f32x4 q_ = *(const f32x4*)(sq_ + ((size_t)uu_.pm * 256 + t_) * 4);
                      rsT_[i_ * 256 + t_] = 1.0f / sqrtf(((q_[0] + q_[1]) + (q_[2] + q_[3])) * (1.f / 1024.f) + EPS); } }
              __syncthreads(); }
            pg8::EpiBf16S<2> E{(bf16*)(ws + WS_H), FF, (const LAS float*)(ldsl + RST_OFF)};
            pg8::gemm_phase<pg8::EpiBf16S<2>, pg8::StaticOrder, PG8_ALIGN, PG8_SP2>(ldsl + RING_OFF, g, S, E, F.wave);
            SEAM(); PHASE_END(pb + 4); }
        if (IN(pb + 5)) {
            GAS unsigned char* ws = (GAS unsigned char*)args.ws; OPQ_S(ws);
            pg8::Gemm g{(const bf16*)(ws + WS_H), (const bf16*)(ws + WS_W2) + (size_t)l * D * FF, M, D, FF}; pg8::StaticOrder S; S.init(M, D, F.G, (int)blockIdx.x);
            if (l + 1 < DEPTH) { pg8::EpiResNorm<false> E{nullptr, (bf16*)(ws + WS_XB), (float*)(ws + WS_SSQX), D, nullptr};
                pg8::gemm_phase<pg8::EpiResNorm<false>, pg8::StaticOrder, false, PG8_SP2>(ldsl + RING_OFF, g, S, E, F.wave); SEAM(); PHASE_END(pb + 5); }
            else { pg8::EpiResNorm<true> E{args.out, (bf16*)(ws + WS_XB), nullptr, D, nullptr};
                pg8::gemm_phase<pg8::EpiResNorm<true>, pg8::StaticOrder, false, PG8_SP2>(ldsl + RING_OFF, g, S, E, F.wave); __syncthreads(); PHASE_END(pb + 5); } }
    }
constexpr int NPH = 1 + DEPTH * 6;
__global__ void __launch_bounds__(NWAVES * 64, 2) __attribute__((amdgpu_waves_per_eu(2, 2))) fwd(Args args) {
    extern __shared__ __attribute__((aligned(16))) unsigned char lds[];
    Frame F;
    F.lds = lds; F.wave = __builtin_amdgcn_readfirstlane((int)(threadIdx.x >> 6));
    F.G = gridDim.x; { const int bx = blockIdx.x; F.vcu = (F.G % 8 == 0) ? (bx % 8) * (F.G / 8) + bx / 8 : bx; }
    F.a = (ArgsP)__builtin_amdgcn_kernarg_segment_ptr(); F.ws = (GAS unsigned char*)args.ws;
    for (int u = threadIdx.x; u < (LDS_BYTES - LDSCTL_OFF) / 4; u += NWAVES * 64) ((unsigned*)(lds + LDSCTL_OFF))[u] = 0u;
    __syncthreads();
    XcdBarrier bar; bar.bar = (unsigned*)(args.ws + WS_CTL) + 1024; bar.x = 0; bar.st = nullptr;
    if (MK_ONE_LAUNCH) bar = xcd_barrier_post((unsigned*)(args.ws + WS_CTL) + 1024, (volatile LAS unsigned*)(lds + MISC_OFF) + 8);
    const int lo = args.ph_lo, hi = args.ph_hi;
    LAS unsigned char* ldsl = (LAS unsigned char*)lds;
#ifndef PROBE_DUP
#define PROBE_DUP -1
#endif
    if (PROBE_TIME_MASK != 0u) { if (threadIdx.x == 0) { volatile LAS unsigned long long* T_ = (volatile LAS unsigned long long*)((LAS unsigned char*)lds + MISC_OFF + 128); T_[0] = __builtin_amdgcn_s_memrealtime(); T_[1] = 0ull; T_[2] = __builtin_amdgcn_s_memtime(); T_[3] = 0ull; } }
    if (PROBE_CLK_BIT >= 0 && PROBE_TIME_MASK == 0u) { if (threadIdx.x == 0) { volatile LAS unsigned long long* T_ = (volatile LAS unsigned long long*)((LAS unsigned char*)lds + MISC_OFF + 128); T_[0] = 0ull; T_[1] = 0ull; T_[2] = __builtin_amdgcn_s_memtime(); T_[3] = 0ull; } }
    if (IN(0)) { p0_prologue(F); SEAM(); if (PROBE_DUP == 0) { p0_prologue(F); SEAM(); } PHASE_END(0); }
    for (int l = 0; l < DEPTH; ++l) layer_body(args, F, bar, ldsl, lo, hi, l);
    if (PROBE_TIME_MASK != 0u || PROBE_CLK_BIT >= 0) { if (blockIdx.x == 0 && F.wave == 0 && opq_lane() == 0) { volatile LAS unsigned long long* T_ = (volatile LAS unsigned long long*)((LAS unsigned char*)lds + MISC_OFF + 128); const unsigned long long w_ = 8ull * (T_[1] + (unsigned long long)__hip_atomic_load((unsigned*)(args.ws + WS_CTL) + 9000, __ATOMIC_RELAXED, __HIP_MEMORY_SCOPE_AGENT)) + (PROBE_CLK_BIT >= 0 ? T_[3] / 16ull : 0ull); const unsigned long long t0_ = __builtin_amdgcn_s_memrealtime(); while (__builtin_amdgcn_s_memrealtime() - t0_ < w_) __builtin_amdgcn_s_sleep(8); } }
#undef IN
#undef SEAM
}

extern "C" void kernel_launch(void* const* d_in, const int* in_sizes, int n_in, void* d_out, int out_size, void* d_ws, size_t ws_size, hipStream_t stream) {
    static int grid = 0;
    if (grid == 0) {
        if (n_in != N_INPUTS || in_sizes[0] != M * D || out_size != M * D || ws_size < WS_END) { fprintf(stderr, "kernel_launch: unexpected shapes (n_in %d, in0 %d, out %d, ws %zu); nothing launched\n", n_in, n_in > 0 ? in_sizes[0] : -1, out_size, ws_size); grid = -1; return; }
        int dev = 0, cus = 0, per_cu = 0;
        if (hipGetDevice(&dev) != hipSuccess || hipDeviceGetAttribute(&cus, hipDeviceAttributeMultiprocessorCount, dev) != hipSuccess) { grid = -1; return; }
        if (hipFuncSetAttribute((const void*)fwd, hipFuncAttributeMaxDynamicSharedMemorySize, LDS_BYTES) != hipSuccess) { fprintf(stderr, "kernel_launch: hipFuncSetAttribute failed\n"); grid = -1; return; }
        if (hipOccupancyMaxActiveBlocksPerMultiprocessor(&per_cu, (const void*)fwd, NWAVES * 64, LDS_BYTES) != hipSuccess || per_cu < 1) { fprintf(stderr, "kernel_launch: occupancy query reports %d\n", per_cu); }
        (void)hipGetLastError();
        grid = cus;
        if (grid != 256) { fprintf(stderr, "kernel_launch: built for 256 CUs (one 256x256 unit per workgroup in the N = 1024 GEMM phases), found %d; nothing launched\n", cus); grid = -1; return; }
    }
    if (grid < 0) return;
    if (hipMemsetAsync((char*)d_ws + WS_CTL, 0, CTL_ZERO_BYTES, stream) != hipSuccess) return;
    Args a{};
    for (int i = 0; i < N_INPUTS; ++i) a.in[i] = (const float*)d_in[i];
    a.out = (float*)d_out; a.ws = (unsigned char*)d_ws;
#if MK_ONE_LAUNCH
    a.ph_lo = 0; a.ph_hi = NPH;
    hipLaunchKernelGGL(fwd, dim3(grid), dim3(NWAVES * 64), LDS_BYTES, stream, a);
#else
    for (int p = 0; p < NPH; ++p) { a.ph_lo = p; a.ph_hi = p + 1; hipLaunchKernelGGL(fwd, dim3(grid), dim3(NWAVES * 64), LDS_BYTES, stream, a); }
#endif
}
```

```cpp
#include <hip/hip_runtime.h>
#include <cstdio>
#include <cstdint>
#include <cmath>
namespace pg8 {
#ifndef PROBE_TIME_MASK
#define PROBE_TIME_MASK 0u
#endif
#define PG8_PROBE(k) do { if (PROBE_TIME_MASK != 0u) { if (wid == 0 && lane == 0) { volatile PG8_LAS unsigned long long* T_ = (volatile PG8_LAS unsigned long long*)(lds - lds_base_off_ + 131072 + 320 + 128); const unsigned long long now_ = __builtin_amdgcn_s_memrealtime(); if ((PROBE_TIME_MASK >> (k)) & 1u) T_[1] += now_ - T_[0]; T_[0] = now_; } } } while (0)
#define PG8_LAS __attribute__((address_space(3)))
typedef unsigned short bf16_t;
typedef short bf16x8 __attribute__((ext_vector_type(8)));
typedef float f32x4 __attribute__((ext_vector_type(4)));
typedef unsigned u32x4 __attribute__((ext_vector_type(4)));
constexpr int BM = 256, BK = 64, HALF = 128, HTB = HALF * BK * 2  , STAGE_BYTES = 8 * HTB, NXCD = 8, WGM = 8;

__host__ __device__ __forceinline__ int lds_byte(int r, int c) { const int st = (r >> 4) * 2 + (c >> 5), rr = r & 15, cc = c & 31, ob = rr * 64 + cc * 2; return st * 1024 + (ob ^ (((ob >> 9) & 1) << 5)); }
__host__ __device__ __forceinline__ void stage_rc(int b, int& R, int& C) { const int st = b / 1024, sb = b % 1024, swz = sb ^ (((sb >> 9) & 1) << 5); R = (st >> 1) * 16 + swz / 64; C = (st & 1) * 32 + (swz % 64) / 2; }
__host__ __device__ __forceinline__ int perm32(int rho) { const int n = rho >> 4, i = rho & 15; return 8 * (i >> 2) + 4 * n + (i & 3); }

struct Unit { int pm, pn, idx; };
struct Gemm { const bf16_t* A; const bf16_t* Bt; int M, N, K; };

struct StaticOrder {
    int nM, nN, nwg, G, c;
    __host__ __device__ __forceinline__ void init(int M, int N, int G_, int c_) { nM = M / BM; nN = N / BM; nwg = nM * nN; G = G_; c = c_; }
    __host__ __device__ __forceinline__ bool next(int i, Unit& u) const {
        const long L = (long)i * G + c; if (L >= nwg) return false;
        int wgid = (int)L; { const int q = nwg / NXCD, r = nwg % NXCD, xcd = wgid % NXCD, off = wgid / NXCD; wgid = (xcd < r ? xcd * (q + 1) : r * (q + 1) + (xcd - r) * q) + off; }
        const int nig = WGM * nN, gid = wgid / nig, fm = gid * WGM, gsz = (nM - fm) < WGM ? (nM - fm) : WGM;
        u.pm = fm + ((wgid % nig) % gsz); u.pn = (wgid % nig) / gsz; u.idx = i; return true;
    }
    __device__ __forceinline__ void a_ready(const Unit&) const {}
    __device__ __forceinline__ void done(const Unit&) const {}
};

__device__ __forceinline__ unsigned cvt_pk_bf16(float lo, float hi) { unsigned r; asm volatile("v_cvt_pk_bf16_f32 %0, %1, %2" : "=v"(r) : "v"(lo), "v"(hi)); return r; }
typedef float f32x2 __attribute__((ext_vector_type(2)));
__device__ __forceinline__ f32x2 gelu_pk(f32x2 v) {
    const f32x2 av = __builtin_elementwise_abs(v), d = av * 0.2316418882f + 1.0f;
    f32x2 t; t.x = __builtin_amdgcn_rcpf(d.x); t.y = __builtin_amdgcn_rcpf(d.y);
    f32x2 q = t * 0.5307027145f + (-0.7265760135f); q = q * t + 0.7107068705f; q = q * t + (-0.142248368f); q = q * t + 0.127414796f; q = q * t;
    const f32x2 s = (v * v) * (-0.72134752044f);
    f32x2 e; e.x = __builtin_amdgcn_exp2f(s.x); e.y = __builtin_amdgcn_exp2f(s.y);
    const f32x2 m = v * (q * e), r = v - m;
    f32x2 o; o.x = v.x < 0.f ? m.x : r.x; o.y = v.y < 0.f ? m.y : r.y; return o;
}

template <int ACT  > struct EpiBf16 {
    static constexpr bool PERM = true, AFTER_DRAIN = false; static_assert(ACT == 0 || ACT == 1, "EpiBf16: ACT is 0 (none) or 1 (gelu_pk)");
    bf16_t* O; int ldc; const float* bias; int split_cols; size_t split_stride; float scale0;
    __device__ __forceinline__ void operator()(const f32x4 (&acc)[2][2][4][2], const Unit& u, int wr, int wc, int fr, int fq) const {
        const int row0 = u.pm * BM + wr * 64 + fr; int colt = u.pn * BM; bf16_t* base = O;
        float sc = 1.f; if (split_cols) { const int t = colt / split_cols; base += (size_t)t * split_stride; colt -= t * split_cols; if (t == 0) sc = scale0; }
        const int col0 = colt + wc * 32 + 8 * fq, bcol0 = u.pn * BM + wc * 32 + 8 * fq;
        f32x4 bv[2][2];
#pragma unroll
        for (int bj = 0; bj < 2; ++bj)
#pragma unroll
            for (int n = 0; n < 2; ++n) bv[bj][n] = bias ? *(const f32x4*)(bias + bcol0 + bj * HALF + 4 * n) : (f32x4){0.f, 0.f, 0.f, 0.f};
#pragma unroll
        for (int ai = 0; ai < 2; ++ai)
#pragma unroll
            for (int m = 0; m < 4; ++m) { bf16_t* rowp = base + (size_t)(row0 + ai * HALF + m * 16) * ldc + col0;
#pragma unroll
                for (int bj = 0; bj < 2; ++bj) { f32x4 v0 = acc[ai][bj][m][0] + bv[bj][0], v1 = acc[ai][bj][m][1] + bv[bj][1];
                    if (ACT == 1) { f32x2 a = gelu_pk((f32x2){v0[0], v0[1]}), b = gelu_pk((f32x2){v0[2], v0[3]}), c = gelu_pk((f32x2){v1[0], v1[1]}), d = gelu_pk((f32x2){v1[2], v1[3]});
                        v0 = (f32x4){a.x, a.y, b.x, b.y}; v1 = (f32x4){c.x, c.y, d.x, d.y}; }
                    v0 = v0 * sc; v1 = v1 * sc; u32x4 w; w.x = cvt_pk_bf16(v0[0], v0[1]); w.y = cvt_pk_bf16(v0[2], v0[3]); w.z = cvt_pk_bf16(v1[0], v1[1]); w.w = cvt_pk_bf16(v1[2], v1[3]);
                    *(u32x4*)(rowp + bj * HALF) = w; } }
    }
};

template <class Epi, class Sched, bool ALIGN_EPI = false, bool SP2 = false>
__device__ __forceinline__ void gemm_phase(PG8_LAS unsigned char* lds, const Gemm g, const Sched& S, const Epi& E, const int wave_index) {
    int tid_; asm volatile("v_mbcnt_lo_u32_b32 %0, -1, 0\n\tv_mbcnt_hi_u32_b32 %0, -1, %0" : "=v"(tid_)); tid_ += wave_index * 64;
    const int tid = tid_, wid = __builtin_amdgcn_readfirstlane(tid >> 6), lane = tid & 63, wr = wid >> 2, wc = wid & 3, fr = lane & 15, fq = lane >> 4;
    const int K = g.K, nt = K / BK; constexpr int lds_base_off_ = 0;
    unsigned voffA[2], voffB[2];
#pragma unroll
    for (int i = 0; i < 2; ++i) { int R, C; stage_rc(tid * 16 + i * 8192, R, C); const int Rb = Epi::PERM ? ((R & ~31) + perm32(R & 31)) : R;
        voffA[i] = (unsigned)(R * K + C) * 2u; voffB[i] = (unsigned)(Rb * K + C) * 2u; }
    const size_t kstep = (size_t)(BK * 2);
    const size_t hstep = (size_t)HALF * K * 2;
    const size_t tstep = 2 * hstep;
    const unsigned ldsw = (unsigned)wid * 1024u;
    const int aoff = lds_byte(wr * 64 + fr, fq * 8), boff = lds_byte(wc * 32 + fr, fq * 8);
#define PG8_SA(b, h) (((b) * 2 + (h)) * HTB)
#define PG8_SB(b, h) ((4 + (b) * 2 + (h)) * HTB)
#define PG8_STAGE(bufoff, gbase, voff) do { _Pragma("unroll") for (int _i = 0; _i < 2; ++_i) \
        __builtin_amdgcn_global_load_lds((const unsigned*)((const char*)(gbase) + (voff)[_i]), (PG8_LAS unsigned*)(lds + (bufoff) + ldsw + _i * 8192), 16, 0, 0); } while (0)
#define PG8_LDA(dst, b, h) do { _Pragma("unroll") for (int m = 0; m < 4; ++m) _Pragma("unroll") for (int k = 0; k < 2; ++k) dst[m][k] = *(const PG8_LAS bf16x8*)(lds + PG8_SA(b, h) + aoff + m * 2048 + k * 1024); } while (0)
#define PG8_LDB(dst, b, h) do { _Pragma("unroll") for (int n = 0; n < 2; ++n) _Pragma("unroll") for (int k = 0; k < 2; ++k) dst[n][k] = *(const PG8_LAS bf16x8*)(lds + PG8_SB(b, h) + boff + n * 2048 + k * 1024); } while (0)
#define PG8_MMA(ai, bj, At, Bt) do { __builtin_amdgcn_s_setprio(1); _Pragma("unroll") for (int m = 0; m < 4; ++m) _Pragma("unroll") for (int n = 0; n < 2; ++n) _Pragma("unroll") for (int k = 0; k < 2; ++k) \
        acc[ai][bj][m][n] = __builtin_amdgcn_mfma_f32_16x16x32_bf16(Bt[n][k], At[m][k], acc[ai][bj][m][n], 0, 0, 0); __builtin_amdgcn_s_setprio(0); } while (0)
#define PG8_WAIT_V(n) asm volatile("s_waitcnt vmcnt(" #n ")" ::: "memory")
#define PG8_WAIT_L(n) asm volatile("s_waitcnt lgkmcnt(" #n ")" ::: "memory")
#define PG8_BAR __builtin_amdgcn_s_barrier()
#define PG8_SCHED __builtin_amdgcn_sched_barrier(0)
    Unit cur, nxt; int ui = 0;
    if (!S.next(0, cur)) return;
    f32x4 acc[2][2][4][2];
#pragma unroll
    for (int a = 0; a < 2; ++a)
#pragma unroll
        for (int b = 0; b < 2; ++b)
#pragma unroll
            for (int m = 0; m < 4; ++m)
#pragma unroll
                for (int n = 0; n < 2; ++n) acc[a][b][m][n] = (f32x4){0.f, 0.f, 0.f, 0.f};
    bf16x8 At[4][2], B0[2][2], B1[2][2];
    const char* cA = (const char*)g.A + (size_t)cur.pm * tstep; const char* cB = (const char*)g.Bt + (size_t)cur.pn * tstep;
    S.a_ready(cur);
    if constexpr (SP2) {
        PG8_STAGE(PG8_SB(0, 0), cB, voffB); PG8_STAGE(PG8_SB(0, 1), cB + hstep, voffB); PG8_STAGE(PG8_SA(0, 0), cA, voffA); PG8_STAGE(PG8_SA(0, 1), cA + hstep, voffA);
        if (wr == 1) PG8_BAR;
        PG8_WAIT_V(2); PG8_BAR;
        PG8_STAGE(PG8_SB(1, 0), cB + kstep, voffB); PG8_STAGE(PG8_SA(1, 0), cA + kstep, voffA); PG8_STAGE(PG8_SB(1, 1), cB + hstep + kstep, voffB);
        PG8_WAIT_V(6); PG8_BAR;
    } else {
        PG8_STAGE(PG8_SB(0, 0), cB, voffB); PG8_STAGE(PG8_SA(0, 0), cA, voffA); PG8_STAGE(PG8_SB(0, 1), cB + hstep, voffB); PG8_STAGE(PG8_SA(0, 1), cA + hstep, voffA);
        if (wr == 1) PG8_BAR;
        PG8_WAIT_V(4); PG8_BAR;
        PG8_STAGE(PG8_SB(1, 0), cB + kstep, voffB); PG8_STAGE(PG8_SA(1, 0), cA + kstep, voffA); PG8_STAGE(PG8_SB(1, 1), cB + hstep + kstep, voffB);
        PG8_WAIT_V(6); PG8_BAR;
    }
    for (;;) {
        const bool has_next = S.next(ui + 1, nxt);
        const char* nA = has_next ? (const char*)g.A + (size_t)nxt.pm * tstep : cA; const char* nB = has_next ? (const char*)g.Bt + (size_t)nxt.pn * tstep : cB;
        for (int t = 0; t < nt; t += 2) {
            const bool last = (t == nt - 2);
            const char* a1 = cA + (size_t)(t + 1) * kstep;
            const char* a2 = last ? nA : cA + (size_t)(t + 2) * kstep; const char* b2 = last ? nB : cB + (size_t)(t + 2) * kstep;
            const char* a3 = a2 + kstep; const char* b3 = b2 + kstep;
            if (last && has_next) S.a_ready(nxt);
            if constexpr (SP2) {
            PG8_LDB(B0, 0, 0); PG8_LDB(B1, 0, 1); PG8_SCHED; PG8_LDA(At, 0, 0); PG8_STAGE(PG8_SA(1, 1), a1 + hstep, voffA);
            PG8_WAIT_V(8); PG8_WAIT_L(0); PG8_BAR; PG8_MMA(0, 0, At, B0); PG8_MMA(0, 1, At, B1); PG8_BAR; PG8_SCHED;
            PG8_LDA(At, 0, 1); PG8_STAGE(PG8_SB(0, 0), b2, voffB); PG8_STAGE(PG8_SB(0, 1), b2 + hstep, voffB); PG8_STAGE(PG8_SA(0, 0), a2, voffA);
            PG8_WAIT_V(8); PG8_WAIT_L(0); PG8_BAR; PG8_MMA(1, 0, At, B0); PG8_MMA(1, 1, At, B1); PG8_BAR; PG8_SCHED;
            PG8_LDB(B0, 1, 0); PG8_LDB(B1, 1, 1); PG8_SCHED; PG8_LDA(At, 1, 0); PG8_STAGE(PG8_SA(0, 1), a2 + hstep, voffA);
            PG8_WAIT_V(8); PG8_WAIT_L(0); PG8_BAR; PG8_MMA(0, 0, At, B0); PG8_MMA(0, 1, At, B1); PG8_BAR; PG8_SCHED;
            PG8_LDA(At, 1, 1); PG8_STAGE(PG8_SB(1, 0), b3, voffB); PG8_STAGE(PG8_SB(1, 1), b3 + hstep, voffB); PG8_STAGE(PG8_SA(1, 0), a3, voffA);
            PG8_WAIT_V(8); PG8_WAIT_L(0); PG8_BAR; PG8_MMA(1, 0, At, B0); PG8_MMA(1, 1, At, B1); PG8_BAR; PG8_SCHED;
            if constexpr (Epi::KSCALE) { if (t + 2 == 8 || t + 2 == 12) E.kscale(acc, t + 2 == 8 ? 0 : 1, wr, fr); }
            } else {
            PG8_LDB(B0, 0, 0); PG8_SCHED; PG8_LDA(At, 0, 0); PG8_STAGE(PG8_SA(1, 1), a1 + hstep, voffA);
            PG8_WAIT_L(8); PG8_BAR; PG8_WAIT_L(0); PG8_MMA(0, 0, At, B0); PG8_BAR; PG8_SCHED;
            PG8_LDB(B1, 0, 1); PG8_STAGE(PG8_SB(0, 0), b2, voffB);
            PG8_BAR; PG8_WAIT_L(0); PG8_MMA(0, 1, At, B1); PG8_BAR;
            PG8_LDA(At, 0, 1); PG8_STAGE(PG8_SA(0, 0), a2, voffA);
            PG8_BAR; PG8_WAIT_L(0); PG8_MMA(1, 0, At, B0); PG8_BAR; PG8_SCHED;
            PG8_STAGE(PG8_SB(0, 1), b2 + hstep, voffB);
            PG8_WAIT_V(6); PG8_BAR; PG8_MMA(1, 1, At, B1); PG8_BAR;
            PG8_LDB(B0, 1, 0); PG8_SCHED; PG8_LDA(At, 1, 0); PG8_STAGE(PG8_SA(0, 1), a2 + hstep, voffA);
            PG8_WAIT_L(8); PG8_BAR; PG8_WAIT_L(0); PG8_MMA(0, 0, At, B0); PG8_BAR; PG8_SCHED;
            PG8_LDB(B1, 1, 1); PG8_STAGE(PG8_SB(1, 0), b3, voffB);
            PG8_BAR; PG8_WAIT_L(0); PG8_MMA(0, 1, At, B1); PG8_BAR;
            PG8_LDA(At, 1, 1); PG8_STAGE(PG8_SA(1, 0), a3, voffA);
            PG8_BAR; PG8_WAIT_L(0); PG8_MMA(1, 0, At, B0); PG8_BAR; PG8_SCHED;
            PG8_STAGE(PG8_SB(1, 1), b3 + hstep, voffB);
            PG8_WAIT_V(6); PG8_BAR; PG8_MMA(1, 1, At, B1); PG8_BAR;
            }
        }
        if constexpr (ALIGN_EPI) { if (wr == 0) PG8_BAR; }
        if constexpr (!Epi::AFTER_DRAIN) { PG8_PROBE(30); E(acc, cur, wr, wc, fr, fq); S.done(cur); PG8_PROBE(31); }
        if (!has_next) break;
#pragma unroll
        for (int a = 0; a < 2; ++a)
#pragma unroll
            for (int b = 0; b < 2; ++b)
#pragma unroll
                for (int m = 0; m < 4; ++m)
#pragma unroll
                    for (int n = 0; n < 2; ++n) acc[a][b][m][n] = (f32x4){0.f, 0.f, 0.f, 0.f};
        cur = nxt; cA = nA; cB = nB; ++ui;
        if constexpr (ALIGN_EPI) { if (wr == 1) PG8_BAR; }
    }
    PG8_WAIT_V(0);
    if constexpr (!ALIGN_EPI) { if (wr == 0) PG8_BAR; }
    PG8_BAR;
    if constexpr (Epi::AFTER_DRAIN) { E.fused(acc, cur, wr, wc, fr, fq, lds, wid, lane); S.done(cur); }
#undef PG8_SA
#undef PG8_SB
#undef PG8_STAGE
#undef PG8_LDA
#undef PG8_LDB
#undef PG8_MMA
#undef PG8_WAIT_V
#undef PG8_WAIT_L
#undef PG8_BAR
#undef PG8_SCHED
}
}

#ifndef PG8_SP2
#define PG8_SP2 true
#endif
#ifndef PG8_ALIGN
#define PG8_ALIGN true
#endif
namespace pg8 {
template <int ACT> struct EpiBf16S {
    static constexpr bool PERM = true, AFTER_DRAIN = false, KSCALE = false;
    bf16_t* O; int ldc; const PG8_LAS float* rsT;
    __device__ __forceinline__ void operator()(const f32x4 (&acc)[2][2][4][2], const Unit& u, int wr, int wc, int fr, int fq) const {
        const int row0 = u.pm * BM + wr * 64 + fr, col0 = u.pn * BM + wc * 32 + 8 * fq;
        const PG8_LAS float* rs = rsT + u.idx * 256 + wr * 64 + fr;
#pragma unroll
        for (int ai = 0; ai < 2; ++ai)
#pragma unroll
            for (int m = 0; m < 4; ++m) { const int r = row0 + ai * HALF + m * 16; const float s = rs[ai * HALF + m * 16]; bf16_t* rowp = O + (size_t)r * ldc + col0;
#pragma unroll
                for (int bj = 0; bj < 2; ++bj) { f32x4 v0 = acc[ai][bj][m][0] * s, v1 = acc[ai][bj][m][1] * s;
                    if (ACT == 2) {
#pragma unroll
                        for (int e = 0; e < 4; ++e) { const float a = fmaxf(v0[e], 0.f), b = fmaxf(v1[e], 0.f); v0[e] = a * a; v1[e] = b * b; } }
                    u32x4 w; w.x = cvt_pk_bf16(v0[0], v0[1]); w.y = cvt_pk_bf16(v0[2], v0[3]); w.z = cvt_pk_bf16(v1[0], v1[1]); w.w = cvt_pk_bf16(v1[2], v1[3]);
                    *(u32x4*)(rowp + bj * HALF) = w; } }
    }
};
template <bool F32OUT, bool GN = false> struct EpiResNorm {
    static constexpr bool PERM = false, AFTER_DRAIN = true, KSCALE = GN;
    float* out; bf16_t* xb; float* ssq4; int ldc; const PG8_LAS float* ks;
    __device__ __forceinline__ void kscale(f32x4 (&acc)[2][2][4][2], int which, int wr, int fr) const {
        const PG8_LAS float* kp = ks + which * 256 + wr * 64 + fr;
        float fk[2][4];
#pragma unroll
        for (int ai = 0; ai < 2; ++ai)
#pragma unroll
            for (int m = 0; m < 4; ++m) fk[ai][m] = kp[ai * HALF + m * 16];
#pragma unroll
        for (int ai = 0; ai < 2; ++ai)
#pragma unroll
            for (int m = 0; m < 4; ++m)
#pragma unroll
                for (int bj = 0; bj < 2; ++bj)
#pragma unroll
                    for (int n = 0; n < 2; ++n) acc[ai][bj][m][n] *= fk[ai][m];
    }
    __device__ __forceinline__ void fused(f32x4 (&acc)[2][2][4][2], const Unit& u, int wr, int wc, int fr, int fq, PG8_LAS unsigned char* lds, int wid, int lane) const {
        PG8_LAS float* Pss = (PG8_LAS float*)lds;
        const int col0 = u.pn * BM + wc * 32 + 4 * fq;
        if (GN) kscale(acc, 2, wr, fr);
#pragma unroll
        for (int ai = 0; ai < 2; ++ai) {
            uint2 bs[4][2][2];
#pragma unroll
            for (int m = 0; m < 4; ++m) { const size_t off = (size_t)(u.pm * BM + ai * HALF + wr * 64 + m * 16 + fr) * ldc + col0;
#pragma unroll
                for (int bj = 0; bj < 2; ++bj)
#pragma unroll
                    for (int n = 0; n < 2; ++n) bs[m][bj][n] = *(const uint2*)(xb + off + bj * HALF + n * 16); }
#pragma unroll
            for (int m = 0; m < 4; ++m) { const int r = ai * HALF + wr * 64 + m * 16 + fr; const size_t off = (size_t)(u.pm * BM + r) * ldc + col0; float s = 0.f;
#pragma unroll
                for (int bj = 0; bj < 2; ++bj)
#pragma unroll
                    for (int n = 0; n < 2; ++n) { const uint2 b2 = bs[m][bj][n];
                        const f32x4 bsv = (f32x4){__uint_as_float(b2.x << 16), __uint_as_float(b2.x & 0xffff0000u), __uint_as_float(b2.y << 16), __uint_as_float(b2.y & 0xffff0000u)};
                        const f32x4 o = bsv + acc[ai][bj][m][n];
                        if (F32OUT) *(f32x4*)(out + off + bj * HALF + n * 16) = o;
                        else { uint2 w; w.x = cvt_pk_bf16(o[0], o[1]); w.y = cvt_pk_bf16(o[2], o[3]); *(uint2*)(xb + off + bj * HALF + n * 16) = w; s += (o[0] * o[0] + o[1] * o[1]) + (o[2] * o[2] + o[3] * o[3]); } }
                if (!F32OUT) { s += __shfl_xor(s, 16); s += __shfl_xor(s, 32); if (fq == 0) Pss[r * 4 + wc] = s; } }
            asm volatile("" ::: "memory");
        }
        if (!F32OUT) { asm volatile("s_waitcnt lgkmcnt(0)" ::: "memory"); __builtin_amdgcn_s_barrier(); asm volatile("" ::: "memory");
            const int t = wid * 64 + lane;
            if (t < 256) { const f32x4 p = *(const PG8_LAS f32x4*)(Pss + 4 * t); ssq4[(size_t)(u.pm * BM + t) * 4 + u.pn] = (p[0] + p[1]) + (p[2] + p[3]); } }
    }
};
}
#define GAS __attribute__((address_space(1)))
#define LAS __attribute__((address_space(3)))
typedef unsigned short bf16;
typedef unsigned v4u __attribute__((ext_vector_type(4)));
typedef float f32x4 __attribute__((ext_vector_type(4)));
typedef short bf16x8 __attribute__((ext_vector_type(8)));
typedef GAS unsigned gu32;
typedef GAS unsigned long long gu64;
#define RLX_AGENT __ATOMIC_RELAXED, __HIP_MEMORY_SCOPE_AGENT
#define LDS_WAIT() asm volatile("s_waitcnt lgkmcnt(0)" ::: "memory")
#define VM_WAIT() asm volatile("s_waitcnt vmcnt(0)" ::: "memory")
__device__ __forceinline__ unsigned long long rt() { return __builtin_amdgcn_s_memrealtime(); }
__device__ __forceinline__ unsigned f2bf(float f) { unsigned u = __builtin_bit_cast(unsigned, f); return (u + 0x7fffu + ((u >> 16) & 1u)) >> 16; }
__device__ __forceinline__ unsigned pk2(float lo, float hi) { return f2bf(lo) | (f2bf(hi) << 16); }

#define XB_TMO      128
#define XB_XCNT(j)  (256  + 64 * (j))
#define XB_XSUB(j)  (1280 + 64 * (j))
#define XB_XGEN(j)  (2304 + 64 * (j))
#define XB_TOP      3328
#define XB_TOPGEN   3392
#define XCD_BAR_WORDS 3456
#define XB_SPIN_CAP (1u << 18)

__device__ __forceinline__ unsigned xb_ld(unsigned* p)              { return __hip_atomic_load(p, __ATOMIC_RELAXED, __HIP_MEMORY_SCOPE_AGENT); }
__device__ __forceinline__ unsigned xb_add(unsigned* p, unsigned v) { return __hip_atomic_fetch_add(p, v, __ATOMIC_RELAXED, __HIP_MEMORY_SCOPE_AGENT); }
__device__ __forceinline__ unsigned xb_xcc_id() { return (unsigned)__builtin_amdgcn_s_getreg((3 << 11) | 20) & 0xFu; }
#define XB_SPIN(cond, bar) do { unsigned _sp = 0; while (cond) { __builtin_amdgcn_s_sleep(1); \
    if ((++_sp & 255u) == 0u) { if (xb_ld(&(bar)[XB_TMO])) break; if (_sp > XB_SPIN_CAP) { atomicAdd(&(bar)[XB_TMO], 1u); break; } } } } while (0)

struct XcdBarrier {
    unsigned* bar; unsigned x;
    volatile LAS unsigned* st;
};

__device__ __forceinline__ XcdBarrier xcd_barrier_post(unsigned* bar, volatile LAS unsigned* st) {
    XcdBarrier b; b.bar = bar; b.x = xb_xcc_id(); b.st = st;
    if (threadIdx.x == 0) (void)xb_add(&bar[XB_XCNT(b.x)], 1u);
    return b;
}
__device__ __forceinline__ void xcd_barrier_complete(unsigned* bar, unsigned x, unsigned& nloc, unsigned& nx) {
    const unsigned G = gridDim.x * gridDim.y * gridDim.z;
    unsigned sum, cnt, mine, sp = 0u;
    for (;;) {
        sum = 0u; cnt = 0u; mine = 0u;
#pragma unroll
        for (unsigned j = 0; j < 16; ++j) { const unsigned c = xb_ld(&bar[XB_XCNT(j)]); sum += c; cnt += (c > 0u) ? 1u : 0u; mine = (j == x) ? c : mine; }
        if (sum == G) break;
        __builtin_amdgcn_s_sleep(1);
        if ((++sp & 255u) == 0u) { if (xb_ld(&bar[XB_TMO])) break; if (sp > XB_SPIN_CAP) { atomicAdd(&bar[XB_TMO], 1u); break; } }
    }
    nloc = mine > 0u ? mine : 1u; nx = cnt > 0u ? cnt : 1u;
}

__device__ __forceinline__ void xcd_barrier(const XcdBarrier& b, const bool leader  ) {
    asm volatile("s_waitcnt vmcnt(0)" ::: "memory");
    __syncthreads();
    if (leader) {
        unsigned* bar = b.bar;
        __builtin_amdgcn_s_waitcnt(0);
        unsigned nloc = b.st[0], nx = b.st[1];
        if (nloc == 0u) { xcd_barrier_complete(bar, b.x, nloc, nx); b.st[0] = nloc; b.st[1] = nx; }
        const unsigned old = xb_add(&bar[XB_XSUB(b.x)], 1u);
        const unsigned gen = old / nloc;
        if (old + 1u == (gen + 1u) * nloc) {
            __builtin_amdgcn_fence(__ATOMIC_RELEASE, "agent");
            asm volatile("s_waitcnt vmcnt(0)" ::: "memory");
            const unsigned og = xb_add(&bar[XB_TOP], 1u);
            const unsigned tg = og / nx;
            if (og + 1u == (tg + 1u) * nx) xb_add(&bar[XB_TOPGEN], 1u);
            else XB_SPIN(xb_ld(&bar[XB_TOPGEN]) == tg, bar);
            __builtin_amdgcn_fence(__ATOMIC_ACQUIRE, "agent");
            xb_add(&bar[XB_XGEN(b.x)], 1u);
            asm volatile("s_waitcnt vmcnt(0)" ::: "memory");
        } else {
            XB_SPIN(xb_ld(&bar[XB_XGEN(b.x)]) == gen, bar);
            __builtin_amdgcn_fence(__ATOMIC_ACQUIRE, "agent");
            asm volatile("s_waitcnt vmcnt(0)" ::: "memory");
        }
    }
    __syncthreads();
}
constexpr int NWAVES = 8;
#ifndef MK_ONE_LAUNCH
#define MK_ONE_LAUNCH 1
#endif
constexpr int BATCH = 8, SEQ = 2048, D = 1024, M = BATCH * SEQ, DEPTH = 2, FF = 4096, NIN = 2540, NP = 2560;
constexpr int NCMP = 127;
constexpr float EPS = 1e-6f;
constexpr float LOG2E = 1.4426950408889634f;
constexpr int CW_FILL = 8192 + 512;
constexpr int CW_QUEUE = 8192;
constexpr int C_AB = 0, C_AC = 256, C_AU = 512, C_NQ = 768, C_KC = 1024, C_VC = 1088, C_KS = 1152, C_VS = 1216, C_KW = 1280, C_VW = 1344,
              C_CQ = 1408, C_CKV = 1600, C_KR = 1728, C_SQ = 1760, C_SK = 2016, C_SV = 2272, C_NG = 2528;
constexpr int NQKV = 896;
enum { I_X = 0, I_RELB, I_N1W, I_WIN, I_CONVW, I_CONVB, I_NQN, I_NKN, I_CPOS, I_CW1, I_CW2, I_QAN, I_KVN, I_WQB, I_WKVB, I_MQN, I_MKN, I_ONW, I_WOUT, I_N2W, I_FW1, I_FW2, N_INPUTS };
constexpr size_t MiB = 1u << 20;
constexpr size_t WS_CTL = 0, CTL_ZERO_BYTES = 64 * 1024;
constexpr size_t WS_ROPE = 1 * MiB;
constexpr size_t WS_TB = WS_ROPE + 262144;
constexpr size_t WS_CB1 = WS_TB + 4096;
constexpr size_t WS_KCV = WS_CB1 + 65536;
constexpr size_t WS_SSQ = 240 * MiB;
constexpr size_t WS_WIN = 2 * MiB, WS_WO = 16 * MiB, WS_W1 = 20 * MiB, WS_W2 = 36 * MiB;
constexpr size_t OUT_QM = 0, OUT_KM = 12 * MiB, OUT_VM = 24 * MiB;
constexpr size_t WS_WQF = 88 * MiB  , WS_WKVF = WS_WQF + 512 * 1024  , WS_QKV = 208 * MiB  ;
constexpr size_t WS_W1C = 84 * MiB, WS_KS = 92 * MiB, WS_KW = 94 * MiB;
constexpr size_t WS_XB = 52 * MiB  , WS_SSQX = WS_KCV + 262144  , WS_P = 128 * MiB, WS_Y = 96 * MiB, WS_H = 128 * MiB, WS_END = 256 * MiB;
static_assert(WS_KCV + 262144 <= WS_WIN && WS_SSQ + (size_t)M * 8 * 4 <= WS_END && WS_P + (size_t)M * NP * 2 <= WS_SSQ && WS_KW + (size_t)M * 64 * 2 <= WS_Y && WS_XB + (size_t)M * D * 2 <= WS_W1C && WS_Y + (size_t)M * D * 2 <= WS_P && WS_SSQX + (size_t)M * 16 <= WS_WIN, "d_ws map");
constexpr int RING_OFF = 0, RING_BYTES = 131072;
constexpr int LDSCTL_OFF = RING_BYTES, MISC_OFF = LDSCTL_OFF + 320, TB_OFF = RING_BYTES + 1024;
constexpr int RST_OFF = TB_OFF + 2048;
constexpr int LDS_BYTES = 147456;
static_assert(RST_OFF + 4096 <= LDS_BYTES, "LDS map");

typedef unsigned short bf16;
struct Args { const float* in[N_INPUTS]; float* out; unsigned char* ws; int ph_lo, ph_hi; };
struct ArgsG { const GAS float* in[N_INPUTS]; GAS float* out; GAS unsigned char* ws; int ph_lo, ph_hi; };
static_assert(sizeof(ArgsG) == sizeof(Args), "same layout");
typedef const __attribute__((address_space(4))) ArgsG* ArgsP;
#define OPQ_V(x) asm volatile("" : "+v"(x))
template <class T> __device__ __forceinline__ T opq_ptr(T p) { const unsigned long long u = (unsigned long long)p; unsigned lo = (unsigned)__builtin_amdgcn_readfirstlane((int)(unsigned)u), hi = (unsigned)__builtin_amdgcn_readfirstlane((int)(unsigned)(u >> 32));
    asm volatile("" : "+s"(lo), "+s"(hi)); return (T)(((unsigned long long)hi << 32) | lo); }
#define OPQ_S(x) ((x) = opq_ptr(x))

__device__ __forceinline__ float wsum(float v) {
#pragma unroll
    for (int o = 1; o < 64; o <<= 1) v += __shfl_xor(v, o);
    return v;
}
__device__ __forceinline__ float wmaxf(float v) {
#pragma unroll
    for (int o = 1; o < 64; o <<= 1) v = fmaxf(v, __shfl_xor(v, o));
    return v;
}
__device__ __forceinline__ float bf2f(bf16 b) { return __uint_as_float((unsigned)b << 16); }
__device__ __forceinline__ float bflo(unsigned w) { return __uint_as_float(w << 16); }
__device__ __forceinline__ float bfhi(unsigned w) { return __uint_as_float(w & 0xffff0000u); }
__device__ __forceinline__ bf16 f2b(float f) { return (bf16)f2bf(f); }

__device__ __forceinline__ int opq_lane() { int l; asm volatile("v_mbcnt_lo_u32_b32 %0, -1, 0\n\tv_mbcnt_hi_u32_b32 %0, -1, %0" : "=v"(l)); return l; }
struct Frame {
    unsigned char* lds; int wave, vcu, G;
    ArgsP a; GAS unsigned char* ws;
};

namespace att {
typedef float f32x16 __attribute__((ext_vector_type(16)));
typedef short s16x4 __attribute__((ext_vector_type(4)));
typedef short v4i16_t __attribute__((ext_vector_type(4)));
typedef float f32x2_t __attribute__((ext_vector_type(2)));
typedef __bf16 bf16x2_t __attribute__((ext_vector_type(2)));
#define MFMA32(a, b, c) __builtin_amdgcn_mfma_f32_32x32x16_bf16((a), (b), (c), 0, 0, 0)
constexpr int PVB = 144;
constexpr int TBUF = 24576;
constexpr int KOFF = 0, VOFF = 12288;
constexpr float L2E = 1.4426950408889634f;
constexpr float NEG_INF = -INFINITY;
__device__ __forceinline__ int crow(int r, int h) { return (r & 3) + 8 * (r >> 2) + 4 * h; }
__device__ __forceinline__ unsigned cvtpk(float lo, float hi) { f32x2_t v = {lo, hi}; bf16x2_t b = __builtin_convertvector(v, bf16x2_t); return __builtin_bit_cast(unsigned, b); }
__device__ __forceinline__ float ex2(float x) { return __builtin_amdgcn_exp2f(x); }
__device__ __forceinline__ float lg2(float x) { return __builtin_amdgcn_logf(x); }
__device__ __forceinline__ float sigm(float x) { const float e = __builtin_amdgcn_exp2f(-x * 1.4426950408889634f); float d; asm volatile("s_nop 1\n\tv_add_f32_e32 %0, 1.0, %1" : "=v"(d) : "v"(e));     return __builtin_amdgcn_rcpf(d); }
__device__ __forceinline__ float xhalf(float x, int h) { const auto r = __builtin_amdgcn_permlane32_swap(__float_as_uint(x), __float_as_uint(x), false, false); return __uint_as_float(h ? r[0] : r[1]); }
__device__ __forceinline__ float xh_sum(float x) { const auto r = __builtin_amdgcn_permlane32_swap(__float_as_uint(x), __float_as_uint(x), false, false); return __uint_as_float(r[0]) + __uint_as_float(r[1]); }
__device__ __forceinline__ float xh_max(float x) { const auto r = __builtin_amdgcn_permlane32_swap(__float_as_uint(x), __float_as_uint(x), false, false); return fmaxf(__uint_as_float(r[0]), __uint_as_float(r[1])); }
__device__ __forceinline__ bf16x8 packfrag(const f32x16& p, int s) {
    v4u w; w.x = cvtpk(p[8 * s], p[8 * s + 1]); w.y = cvtpk(p[8 * s + 2], p[8 * s + 3]); w.z = cvtpk(p[8 * s + 4], p[8 * s + 5]); w.w = cvtpk(p[8 * s + 6], p[8 * s + 7]);
    return __builtin_bit_cast(bf16x8, w);
}
struct TileRegs { v4u k0, k1, v; };
template <int DK> __device__ __forceinline__ void tile_issue(TileRegs& R, const bf16* Kg, int kpitch, const bf16* Vg, int vpitch, int tid) {
    R.k0 = *(const v4u*)(Kg + (size_t)(tid & 63) * kpitch + (tid >> 6) * 8);
    if (DK == 96) { if (tid < 256) R.k1 = *(const v4u*)(Kg + (size_t)(tid & 63) * kpitch + (8 + (tid >> 6)) * 8); }
    R.v = *(const v4u*)(Vg + (size_t)(tid >> 3) * vpitch + (tid & 7) * 8);
}
template <int DK> __device__ __forceinline__ void tile_commit(const TileRegs& R, LAS unsigned char* buf, int tid) {
    *(LAS v4u*)(buf + KOFF + (tid >> 6) * 1024 + (tid & 63) * 16) = R.k0;
    if (DK == 96) { if (tid < 256) *(LAS v4u*)(buf + KOFF + (8 + (tid >> 6)) * 1024 + (tid & 63) * 16) = R.k1; }
    *(LAS v4u*)(buf + VOFF + (tid >> 3) * PVB + (tid & 7) * 16) = R.v;
}
template <int DK> __device__ __forceinline__ void qk(f32x16& p0, f32x16& p1, const LAS unsigned char* buf, const bf16x8* qf, int r32, int h) {
    const LAS unsigned char* kb = buf + KOFF + h * 1024 + r32 * 16;
    bf16x8 a0[DK / 16], a1[DK / 16];
#pragma unroll
    for (int s = 0; s < DK / 16; ++s) { a0[s] = *(const LAS bf16x8*)(kb + s * 2048); a1[s] = *(const LAS bf16x8*)(kb + s * 2048 + 512); }
#pragma unroll
    for (int s = 0; s < DK / 16; ++s) { p0 = MFMA32(a0[s], qf[s], p0); p1 = MFMA32(a1[s], qf[s], p1); }
}
__device__ __forceinline__ void pv(f32x16& o0, f32x16& o1, const LAS unsigned char* buf, const bf16x8 (&pf)[4], int lane) {
    const int h = lane >> 5, blk = (lane >> 4) & 1, q4 = (lane & 15) >> 2, p = lane & 3;
    const LAS unsigned char* vb = buf + VOFF + (4 * h + q4) * PVB + (16 * blk + 4 * p) * 2;
    s16x4 lo[4][2], hi[4][2];
#pragma unroll
    for (int s = 0; s < 4; ++s)
#pragma unroll
        for (int c = 0; c < 2; ++c) {
            lo[s][c] = __builtin_bit_cast(s16x4, __builtin_amdgcn_ds_read_tr16_b64_v4i16((LAS v4i16_t*)(vb + (16 * s) * PVB + c * 64)));
            hi[s][c] = __builtin_bit_cast(s16x4, __builtin_amdgcn_ds_read_tr16_b64_v4i16((LAS v4i16_t*)(vb + (16 * s + 8) * PVB + c * 64))); }
#pragma unroll
    for (int s = 0; s < 4; ++s) {
        const bf16x8 v0 = (bf16x8){lo[s][0][0], lo[s][0][1], lo[s][0][2], lo[s][0][3], hi[s][0][0], hi[s][0][1], hi[s][0][2], hi[s][0][3]};
        const bf16x8 v1 = (bf16x8){lo[s][1][0], lo[s][1][1], lo[s][1][2], lo[s][1][3], hi[s][1][0], hi[s][1][1], hi[s][1][2], hi[s][1][3]};
        o0 = MFMA32(v0, pf[s], o0); o1 = MFMA32(v1, pf[s], o1);
    }
}
__device__ __forceinline__ float max16(const f32x16& p) {
    float r;
    asm volatile("s_nop 15\n\ts_nop 7\n\tv_max3_f32 %0, %1, %2, %3\n\tv_max3_f32 %0, %0, %4, %5\n\tv_max3_f32 %0, %0, %6, %7\n\tv_max3_f32 %0, %0, %8, %9\n\t"
                 "v_max3_f32 %0, %0, %10, %11\n\tv_max3_f32 %0, %0, %12, %13\n\tv_max3_f32 %0, %0, %14, %15\n\tv_max_f32_e32 %0, %0, %16"
                 : "=&v"(r) : "v"(p[0]), "v"(p[1]), "v"(p[2]), "v"(p[3]), "v"(p[4]), "v"(p[5]), "v"(p[6]), "v"(p[7]), "v"(p[8]), "v"(p[9]), "v"(p[10]), "v"(p[11]), "v"(p[12]), "v"(p[13]), "v"(p[14]), "v"(p[15]));
    return r;
}
__device__ __forceinline__ float max32(const f32x16& p0, const f32x16& p1) { const float a = max16(p0), b = max16(p1); return fmaxf(a, b); }
typedef float f32x2p __attribute__((ext_vector_type(2)));
__device__ __forceinline__ void softmax_step(f32x16& p0, f32x16& p1, float& m, float& l, f32x16& o0, f32x16& o1) {
    float mx = max32(p0, p1); mx = xh_max(mx);
    const float mn = fmaxf(m, mx), mu = (mn == NEG_INF) ? 0.f : mn, f = ex2(m - mu);
    const f32x2p nmu = {-mu, -mu}; f32x2p s2 = {0.f, 0.f};
#pragma unroll
    for (int r = 0; r < 16; r += 2) { f32x2p a = (f32x2p){p0[r], p0[r + 1]} + nmu, b = (f32x2p){p1[r], p1[r + 1]} + nmu;
        a.x = ex2(a.x); a.y = ex2(a.y); b.x = ex2(b.x); b.y = ex2(b.y); s2 += a; s2 += b; p0[r] = a.x; p0[r + 1] = a.y; p1[r] = b.x; p1[r + 1] = b.y; }
    l = l * f + (s2.x + s2.y); m = mn;
    if (__any(f != 1.0f)) { const f32x2p f2 = {f, f};
#pragma unroll
        for (int r = 0; r < 16; r += 2) { const f32x2p a = (f32x2p){o0[r], o0[r + 1]} * f2, b = (f32x2p){o1[r], o1[r + 1]} * f2; o0[r] = a.x; o0[r + 1] = a.y; o1[r] = b.x; o1[r + 1] = b.y; } }
}
__device__ __forceinline__ void pack_pv(f32x16& o0, f32x16& o1, const f32x16& p0, const f32x16& p1, const LAS unsigned char* buf, int lane) {
    bf16x8 pf[4]; pf[0] = packfrag(p0, 0); pf[1] = packfrag(p0, 1); pf[2] = packfrag(p1, 0); pf[3] = packfrag(p1, 1);
    pv(o0, o1, buf, pf, lane);
}
__device__ __forceinline__ void store_o(bf16* yrow, const f32x16& o0, const f32x16& o1, int h) {
#pragma unroll
    for (int g = 0; g < 4; ++g) {
        uint2 w0; w0.x = cvtpk(o0[4 * g], o0[4 * g + 1]); w0.y = cvtpk(o0[4 * g + 2], o0[4 * g + 3]); *(uint2*)(yrow + 8 * g + 4 * h) = w0;
        uint2 w1; w1.x = cvtpk(o1[4 * g], o1[4 * g + 1]); w1.y = cvtpk(o1[4 * g + 2], o1[4 * g + 3]); *(uint2*)(yrow + 32 + 8 * g + 4 * h) = w1;
    }
}
__device__ __forceinline__ float sumsq(const f32x16& o0, const f32x16& o1) {
    float s = 0.f;
#pragma unroll
    for (int r = 0; r < 16; ++r) s += o0[r] * o0[r] + o1[r] * o1[r];
    return s;
}

struct SmState { float m, l; f32x16 o0, o1; };
#define RBAR() asm volatile("s_waitcnt lgkmcnt(0)\n\ts_barrier" ::: "memory")
__device__ __forceinline__ void mla_step(int kt, int NT, int ktd, int R0, const bf16* Kg, const bf16* Vg, const bf16x8 (&qf)[6], SmState& st, const TileRegs& Rc, TileRegs& Ri, LAS unsigned char* lds, int tid, int lane, int r32, int h) {
    const LAS unsigned char* cur = lds + (kt & 1) * TBUF;
    if (kt + 2 < NT) tile_issue<96>(Ri, Kg + (size_t)(kt + 2) * 64 * 384, 384, Vg + (size_t)(kt + 2) * 64 * 256, 256, tid);
    if (kt <= ktd) {
        f32x16 p0 = {}, p1 = {};
        qk<96>(p0, p1, cur, qf, r32, h);
        if (kt == ktd) { const int trel = R0 + r32 - 64 * kt;
#pragma unroll
            for (int r = 0; r < 16; ++r) { const int kk = crow(r, h); if (kk > trel) p0[r] = NEG_INF; if (kk + 32 > trel) p1[r] = NEG_INF; } }
        softmax_step(p0, p1, st.m, st.l, st.o0, st.o1);
        pack_pv(st.o0, st.o1, p0, p1, cur, lane);
    }
    if (kt + 1 < NT) tile_commit<96>(Rc, lds + ((kt + 1) & 1) * TBUF, tid);
    RBAR();
}
__device__ __forceinline__ void mla_unit(int b, int hd, int qb, const bf16* QM, const bf16* KM, const bf16* VM, bf16* Y, float* SSQ, LAS unsigned char* lds, int tid) {
    OPQ_V(tid);
    const int lane = tid & 63, w = __builtin_amdgcn_readfirstlane(tid >> 6), r32 = lane & 31, h = lane >> 5;
    const int R0 = 256 * qb + 32 * w; const size_t tok0 = (size_t)b * SEQ;
    bf16x8 qf[6];
    { const bf16* qp = QM + ((tok0 + R0 + r32) * 4 + hd) * 96 + 8 * h;
#pragma unroll
      for (int s = 0; s < 6; ++s) qf[s] = *(const bf16x8*)(qp + 16 * s); }
    const bf16* Kg = KM + (tok0 * 4 + hd) * 96; const bf16* Vg = VM + tok0 * 256 + hd * 64;
    const int NT = 4 * qb + 4, ktd = 4 * qb + (w >> 1);
    TileRegs Ra, Rb; tile_issue<96>(Ra, Kg, 384, Vg, 256, tid); tile_issue<96>(Rb, Kg + (size_t)64 * 384, 384, Vg + (size_t)64 * 256, 256, tid); tile_commit<96>(Ra, lds, tid);
    __syncthreads();
    SmState st; st.m = NEG_INF; st.l = 0.f; st.o0 = f32x16{}; st.o1 = f32x16{};
    for (int kt = 0; kt < NT; kt += 2) {
        mla_step(kt, NT, ktd, R0, Kg, Vg, qf, st, Rb, Ra, lds, tid, lane, r32, h);
        mla_step(kt + 1, NT, ktd, R0, Kg, Vg, qf, st, Ra, Rb, lds, tid, lane, r32, h);
    }
    float l = st.l; f32x16 o0 = st.o0, o1 = st.o1;
    l = xh_sum(l); const float inv = 1.0f / l;
#pragma unroll
    for (int r = 0; r < 16; ++r) { o0[r] *= inv; o1[r] *= inv; }
    float ss = sumsq(o0, o1); ss = xh_sum(ss);
    const size_t tok = tok0 + R0 + r32;
    if (h == 0) SSQ[tok * 8 + hd] = ss;
    store_o(Y + tok * D + 512 + hd * 64, o0, o1, h);
}

#ifndef SB_EARLY
#define SB_EARLY 1
#endif
constexpr float SB_THR = -160.0f;
struct SbState { float carry; f32x16 o0, o1; bool wdone; };
__device__ __forceinline__ bool sb_step(int i, int NT, int ktd, int R0, const bf16* Kg, const bf16* Vg, const bf16x8 (&qf)[4], SbState& st, const TileRegs& Rc, TileRegs& Ri, LAS unsigned char* lds, LAS unsigned* flags, int tid, int lane, int w, int r32, int h) {
    const int kt = NT - 1 - i;
    const LAS unsigned char* cur = lds + (i & 1) * TBUF;
    if (kt >= 2) tile_issue<64>(Ri, Kg + (size_t)(kt - 2) * 64 * NP, NP, Vg + (size_t)(kt - 2) * 64 * NP, NP, tid);
    float carry = st.carry; f32x16 o0 = st.o0, o1 = st.o1;
        if (kt <= ktd && !(SB_EARLY && st.wdone)) {
            f32x16 p0 = {}, p1 = {};
            qk<64>(p0, p1, cur, qf, r32, h);
            const int trel = (kt == ktd) ? (R0 + r32 - 64 * kt) : 1000;
            f32x16 l0, l1;
#pragma unroll
            for (int r = 0; r < 16; ++r) { const int kk = crow(r, h);
                const float z0 = p0[r], z1 = p1[r];
                const float a0 = -(fmaxf(z0, 0.f) + lg2(1.0f + ex2(-fabsf(z0)))), a1 = -(fmaxf(z1, 0.f) + lg2(1.0f + ex2(-fabsf(z1))));
                l0[r] = (kk < trel) ? a0 : 0.f; l1[r] = (kk + 32 < trel) ? a1 : 0.f; }
            float tg[8], tp[8];
#pragma unroll
            for (int g = 0; g < 4; ++g) { tg[g] = (l0[4 * g] + l0[4 * g + 1]) + (l0[4 * g + 2] + l0[4 * g + 3]); tg[4 + g] = (l1[4 * g] + l1[4 * g + 1]) + (l1[4 * g + 2] + l1[4 * g + 3]); }
#pragma unroll
            for (int g = 0; g < 8; ++g) tp[g] = xhalf(tg[g], h);
            float suf = carry;
#pragma unroll
            for (int g = 7; g >= 0; --g) {
                const float base = suf + (h == 0 ? tp[g] : 0.f);
                if (g >= 4) { const int q = 4 * (g - 4);
                    const float r3 = base, r2 = r3 + l1[q + 3], r1 = r2 + l1[q + 2], r0 = r1 + l1[q + 1];
                    const float e0 = ex2(p1[q] + l1[q] + r0), e1 = ex2(p1[q + 1] + l1[q + 1] + r1), e2 = ex2(p1[q + 2] + l1[q + 2] + r2), e3 = ex2(p1[q + 3] + l1[q + 3] + r3);
                    const int kk = crow(q, h) + 32;
                    p1[q] = (kk < trel) ? e0 : 0.f; p1[q + 1] = (kk + 1 < trel) ? e1 : 0.f; p1[q + 2] = (kk + 2 < trel) ? e2 : 0.f; p1[q + 3] = (kk + 3 < trel) ? e3 : 0.f;
                } else { const int q = 4 * g;
                    const float r3 = base, r2 = r3 + l0[q + 3], r1 = r2 + l0[q + 2], r0 = r1 + l0[q + 1];
                    const float e0 = ex2(p0[q] + l0[q] + r0), e1 = ex2(p0[q + 1] + l0[q + 1] + r1), e2 = ex2(p0[q + 2] + l0[q + 2] + r2), e3 = ex2(p0[q + 3] + l0[q + 3] + r3);
                    const int kk = crow(q, h);
                    p0[q] = (kk < trel) ? e0 : 0.f; p0[q + 1] = (kk + 1 < trel) ? e1 : 0.f; p0[q + 2] = (kk + 2 < trel) ? e2 : 0.f; p0[q + 3] = (kk + 3 < trel) ? e3 : 0.f;
                }
                suf += tg[g] + tp[g];
            }
            carry = suf;
            pack_pv(o0, o1, p0, p1, cur, lane);
        }
    st.carry = carry; st.o0 = o0; st.o1 = o1;
#if SB_EARLY
    { const bool done = (kt <= ktd) && (carry < SB_THR);
      const unsigned long long bal = __ballot(done);
      st.wdone = (bal == ~0ull);
      if (lane == 0) flags[(i & 1) * 8 + w] = st.wdone ? 1u : 0u; }
#endif
    if (kt >= 1) tile_commit<64>(Rc, lds + ((i + 1) & 1) * TBUF, tid);
    RBAR();
#if SB_EARLY
    { unsigned all = 1u;
#pragma unroll
      for (int ww = 0; ww < 8; ++ww) all &= flags[(i & 1) * 8 + ww];
      if (__builtin_amdgcn_readfirstlane((int)all)) return true; }
#endif
    return kt == 0;
}
__device__ __forceinline__ void sb_unit(int b, int hd, int qb, const bf16* P, bf16* Y, float* SSQ, LAS unsigned char* lds, LAS unsigned* flags, int tid) {
    OPQ_V(tid);
    const int lane = tid & 63, w = __builtin_amdgcn_readfirstlane(tid >> 6), r32 = lane & 31, h = lane >> 5;
    const int R0 = 256 * qb + 32 * w; const size_t tok0 = (size_t)b * SEQ;
    bf16x8 qf[4];
    { const bf16* qp = P + (tok0 + R0 + r32) * NP + C_SQ + hd * 64 + 8 * h;
#pragma unroll
      for (int s = 0; s < 4; ++s) qf[s] = *(const bf16x8*)(qp + 16 * s); }
    const bf16* Kg = P + tok0 * NP + C_SK + hd * 64; const bf16* Vg = P + tok0 * NP + C_SV + hd * 64;
    const int NT = 4 * qb + 4, ktd = 4 * qb + (w >> 1);
    TileRegs Ra, Rb; tile_issue<64>(Ra, Kg + (size_t)(NT - 1) * 64 * NP, NP, Vg + (size_t)(NT - 1) * 64 * NP, NP, tid); tile_issue<64>(Rb, Kg + (size_t)(NT - 2) * 64 * NP, NP, Vg + (size_t)(NT - 2) * 64 * NP, NP, tid);
    tile_commit<64>(Ra, lds, tid);
    __syncthreads();
    SbState st; st.carry = 0.f; st.o0 = f32x16{}; st.o1 = f32x16{}; st.wdone = false;
    for (int i = 0; i < NT; i += 2) {
        if (sb_step(i, NT, ktd, R0, Kg, Vg, qf, st, Rb, Ra, lds, flags, tid, lane, w, r32, h)) break;
        if (sb_step(i + 1, NT, ktd, R0, Kg, Vg, qf, st, Ra, Rb, lds, flags, tid, lane, w, r32, h)) break;
    }
    f32x16 o0 = st.o0, o1 = st.o1;
    float ss = sumsq(o0, o1); ss = xh_sum(ss);
    const size_t tok = tok0 + R0 + r32;
    if (h == 0) SSQ[tok * 8 + 4 + hd] = ss;
    store_o(Y + tok * D + 768 + hd * 64, o0, o1, h);
}

constexpr int NSA_SC = 2 * TBUF, NSA_SEL = NSA_SC + 32768, NSA_UNI = NSA_SEL + 256, NSA_SS = NSA_UNI + 16, NSA_ACC2 = NSA_SS + 1024, NSA_END = NSA_ACC2 + 32768;
template <bool WIN> __device__ __forceinline__ void nsa_step(int kt, int k1, int k2, int par, unsigned selmask, unsigned wsel, int tblk, int trow, int hd, const bf16* Kg, int kpitch, const bf16* Vg, int vpitch,
                                                             const bf16x8* qf, const LAS float* tb2, float cb, SmState& st, const TileRegs& Rc, TileRegs& Ri, LAS unsigned char* lds, int tid, int lane, int r32, int h) {
    const LAS unsigned char* cur = lds + par * TBUF;
    if (k2 >= 0) tile_issue<64>(Ri, Kg + (size_t)k2 * 64 * kpitch, kpitch, Vg + (size_t)k2 * 64 * vpitch, vpitch, tid);
    if (WIN || ((wsel >> kt) & 1u)) {
        float& m = st.m; float& l = st.l; f32x16& o0 = st.o0; f32x16& o1 = st.o1;
        const bool nearb = (kt + 2 >= tblk);
        f32x16 p0, p1;
        { const float c0 = (!WIN && !((selmask >> kt) & 1u)) ? NEG_INF : (nearb ? 0.f : cb);
#pragma unroll
          for (int r = 0; r < 16; ++r) { p0[r] = c0; p1[r] = c0; } }
        qk<64>(p0, p1, cur, qf, r32, h);
        if (nearb) { const int dbase = 64 * (tblk - kt) + trow;
            float b0[16], b1[16];
#pragma unroll
            for (int r = 0; r < 16; ++r) { const int d0 = dbase - crow(r, h), d1 = d0 - 32;
                b0[r] = tb2[(d0 < 0 ? 0 : (d0 > 127 ? 127 : d0)) * 4 + hd]; b1[r] = tb2[(d1 < 0 ? 0 : (d1 > 127 ? 127 : d1)) * 4 + hd]; }
#pragma unroll
            for (int r = 0; r < 16; ++r) { const int d0 = dbase - crow(r, h), d1 = d0 - 32;
                p0[r] = d0 < 0 ? NEG_INF : p0[r] + b0[r]; p1[r] = d1 < 0 ? NEG_INF : p1[r] + b1[r]; } }
        if (WIN) { if (kt + 8 == tblk) {
#pragma unroll
            for (int r = 0; r < 16; ++r) { const int kk = crow(r, h); if (kk <= trow) p0[r] = NEG_INF; if (kk + 32 <= trow) p1[r] = NEG_INF; } } }
        softmax_step(p0, p1, m, l, o0, o1);
        pack_pv(o0, o1, p0, p1, cur, lane);
    }
    if (k1 >= 0) tile_commit<64>(Rc, lds + (par ^ 1) * TBUF, tid);
    RBAR();
}
template <bool WIN> __device__ __forceinline__ void nsa_pass(unsigned mask, unsigned selmask, unsigned wsel, int tblk, int trow, int hd, const bf16* Kg, int kpitch, const bf16* Vg, int vpitch,
                                                             const bf16x8* qf, const LAS float* tb2, f32x16& o0, f32x16& o1, float& lsum, LAS unsigned char* lds, int tid) {
    const int lane = tid & 63, r32 = lane & 31, h = lane >> 5;
    SmState st; st.m = NEG_INF; st.l = 0.f; st.o0 = o0; st.o1 = o1;
    const float cb = tb2[127 * 4 + hd];
    TileRegs Ra, Rb;
    { const int k0 = __builtin_ctz(mask); tile_issue<64>(Ra, Kg + (size_t)k0 * 64 * kpitch, kpitch, Vg + (size_t)k0 * 64 * vpitch, vpitch, tid);
      const unsigned m1 = mask & (mask - 1u); if (m1) { const int k1 = __builtin_ctz(m1); tile_issue<64>(Rb, Kg + (size_t)k1 * 64 * kpitch, kpitch, Vg + (size_t)k1 * 64 * vpitch, vpitch, tid); }
      tile_commit<64>(Ra, lds, tid); }
    __syncthreads();
    while (mask) {
        { const int kt = __builtin_ctz(mask); mask &= mask - 1u; const int k1 = mask ? __builtin_ctz(mask) : -1; const unsigned m2 = mask & (mask - 1u); const int k2 = m2 ? __builtin_ctz(m2) : -1;
          nsa_step<WIN>(kt, k1, k2, 0, selmask, wsel, tblk, trow, hd, Kg, kpitch, Vg, vpitch, qf, tb2, cb, st, Rb, Ra, lds, tid, lane, r32, h); }
        if (!mask) break;
        { const int kt = __builtin_ctz(mask); mask &= mask - 1u; const int k1 = mask ? __builtin_ctz(mask) : -1; const unsigned m2 = mask & (mask - 1u); const int k2 = m2 ? __builtin_ctz(m2) : -1;
          nsa_step<WIN>(kt, k1, k2, 1, selmask, wsel, tblk, trow, hd, Kg, kpitch, Vg, vpitch, qf, tb2, cb, st, Ra, Rb, lds, tid, lane, r32, h); }
    }
    o0 = st.o0; o1 = st.o1;
    lsum = xh_sum(st.l);
}
constexpr int RSLOT = 8192, RING_K = 0, RING_V = 3 * RSLOT;
constexpr float NSA_THR = 8.0f;
#define NSBAR() __builtin_amdgcn_sched_barrier(0)
#define NPIN(x) asm volatile("" : "+v"(x))
#define NWAIT_BAR(N) asm volatile("s_waitcnt vmcnt(" #N ") lgkmcnt(0)\n\ts_barrier" ::: "memory")
__device__ __forceinline__ void glds16(const void* g, unsigned lds_base) {
    unsigned sv; asm volatile("s_mov_b32 %0, m0\n\ts_mov_b32 m0, %2\n\ts_nop 0\n\tglobal_load_lds_dwordx4 %1, off\n\ts_mov_b32 m0, %0" : "=&s"(sv) : "v"(g), "s"(lds_base) : "memory"); }
__device__ __forceinline__ void kload2(bf16x8* kf, const LAS unsigned char* kp, int d0) { kf[2 * d0] = *(const LAS bf16x8*)(kp + d0 * 2048); kf[2 * d0 + 1] = *(const LAS bf16x8*)(kp + d0 * 2048 + 512); }
__device__ __forceinline__ s16x4 vtr(const LAS unsigned char* p) { return __builtin_bit_cast(s16x4, __builtin_amdgcn_ds_read_tr16_b64_v4i16((LAS v4i16_t*)p)); }
#define NMX3(a, b, c) __builtin_fmaxf(__builtin_fmaxf((a), (b)), (c))
__device__ __forceinline__ float rowmax(const f32x16& p0, const f32x16& p1) {
    float a = NMX3(p0[0], p0[1], p1[0]), b = NMX3(p0[2], p0[3], p1[1]); a = NMX3(a, p1[2], p1[3]);
#pragma unroll
    for (int r = 4; r < 16; r += 4) { a = NMX3(a, p0[r], p0[r + 1]); b = NMX3(b, p0[r + 2], p0[r + 3]); a = NMX3(a, p1[r], p1[r + 1]); b = NMX3(b, p1[r + 2], p1[r + 3]); }
    return xh_max(__builtin_fmaxf(a, b)); }
__device__ __forceinline__ void nsa_near(f32x16& p0, f32x16& p1, int dbase, const LAS float* tb2, int hd, int h) {
    float b0[16], b1[16];
#pragma unroll
    for (int r = 0; r < 16; ++r) { const int d0 = dbase - crow(r, h), d1 = d0 - 32;
        b0[r] = tb2[(d0 < 0 ? 0 : (d0 > 127 ? 127 : d0)) * 4 + hd]; b1[r] = tb2[(d1 < 0 ? 0 : (d1 > 127 ? 127 : d1)) * 4 + hd]; }
#pragma unroll
    for (int r = 0; r < 16; ++r) { const int d0 = dbase - crow(r, h), d1 = d0 - 32;
        p0[r] = d0 < 0 ? NEG_INF : p0[r] + b0[r]; p1[r] = d1 < 0 ? NEG_INF : p1[r] + b1[r]; }
}
__device__ __forceinline__ void nsa_low(f32x16& p0, f32x16& p1, int trow, int h) {
#pragma unroll
    for (int r = 0; r < 16; ++r) { const int kk = crow(r, h); if (kk <= trow) p0[r] = NEG_INF; if (kk + 32 <= trow) p1[r] = NEG_INF; }
}
template <bool WIN> __device__ __forceinline__ void nsa_ring_pass(unsigned mask, unsigned selmask, int tblk, int trow, int hd, const bf16* Kg, const bf16* Vg,
                                                                  const bf16x8* qf, const LAS float* tb2, f32x16& oo0, f32x16& oo1, float& lsum, LAS unsigned char* lds, int tid) {
    const int lane = tid & 63, r32 = lane & 31, hi = lane >> 5, wid = __builtin_amdgcn_readfirstlane(tid >> 6);
    const float cb = tb2[127 * 4 + hd];
    const unsigned lds0 = (unsigned)(size_t)lds;
    const bf16* ksrc = Kg + (size_t)lane * 64 + wid * 8;
    const bf16* vsrc = Vg + (size_t)(16 * (wid & 3) + (lane >> 2)) * NP + (wid >> 2) * 32 + (lane & 3) * 8;
    const unsigned kdst = lds0 + RING_K + wid * 1024, vdst = lds0 + RING_V + wid * 1024;
    const LAS unsigned char* kp0 = lds + RING_K + hi * 1024 + r32 * 16;
    const LAS unsigned char* vp0 = lds + RING_V + ((lane >> 4) & 1) * 32 + (lane & 3) * 8 + (4 * hi + ((lane & 15) >> 2)) * 64;
    unsigned mk = mask, mv = mask, mc = mask; const int kdum = __builtin_ctz(mask);
#define DMA_K(slot) do { const int t_ = mk ? __builtin_ctz(mk) : kdum; mk &= mk - 1u; glds16(ksrc + (size_t)t_ * 64 * 64, (unsigned)__builtin_amdgcn_readfirstlane(kdst + (slot))); } while (0)
#define DMA_V(slot) do { const int t_ = mv ? __builtin_ctz(mv) : kdum; mv &= mv - 1u; glds16(vsrc + (size_t)t_ * 64 * NP, (unsigned)__builtin_amdgcn_readfirstlane(vdst + (slot))); } while (0)
    const int NT = __builtin_popcount(mask);
    DMA_K(0); DMA_V(0); DMA_K(RSLOT); DMA_K(2 * RSLOT);
    float mhat, l_reg = 0.f, f = 1.f; bool resc = false;
    f32x16 o0 = oo0, o1 = oo1;
    const f32x16 zero16 = {};
    f32x16 pA0, pA1, pB0, pB1; bf16x8 kf[8]; s16x4 vlo[8], vhi[8]; v4u pw0, pw1, pw2, pw3;
    int sl_prev = 0, sl_cur = 0, sl_next = RSLOT;
#define ROT() do { sl_prev = sl_cur; sl_cur = sl_next; sl_next = (sl_next == 2 * RSLOT) ? 0 : sl_next + RSLOT; } while (0)
#define EX(v) ex2((v) + nmh)
#define RESC() do { if (resc) { _Pragma("unroll") for (int r = 0; r < 16; ++r) { o0[r] *= f; o1[r] *= f; } } } while (0)
    NWAIT_BAR(3);
    { const int kt = __builtin_ctz(mc); mc &= mc - 1u; const bool nearb = (kt + 2 >= tblk);
      const float badd = (WIN || ((selmask >> kt) & 1u)) ? (nearb ? 0.f : cb) : NEG_INF;
#pragma unroll
      for (int d0 = 0; d0 < 4; ++d0) kload2(kf, kp0, d0);
      pA0 = MFMA32(kf[0], qf[0], zero16); pA1 = MFMA32(kf[1], qf[0], zero16); pA0 = MFMA32(kf[2], qf[1], pA0); pA1 = MFMA32(kf[3], qf[1], pA1);
      pA0 = MFMA32(kf[4], qf[2], pA0); pA1 = MFMA32(kf[5], qf[2], pA1); pA0 = MFMA32(kf[6], qf[3], pA0); pA1 = MFMA32(kf[7], qf[3], pA1);
      if (nearb) nsa_near(pA0, pA1, 64 * (tblk - kt) + trow, tb2, hd, hi);
      if (WIN) { if (kt + 8 == tblk) nsa_low(pA0, pA1, trow, hi); }
      const float rm = rowmax(pA0, pA1) + badd; mhat = (rm == NEG_INF) ? -126.f : rm; const float nmh = badd - mhat;
#pragma unroll
      for (int r = 0; r < 16; ++r) { pA0[r] = EX(pA0[r]); pA1[r] = EX(pA1[r]); } }
    NWAIT_BAR(0);
    DMA_K(0); DMA_V(RSLOT); ROT();
#pragma unroll
    for (int d0 = 0; d0 < 4; ++d0) kload2(kf, kp0 + sl_cur, d0);
    NWAIT_BAR(2);
#define PKW(P, i) cvtpk(P[i], P[i + 1])
#define PAF(k) __builtin_bit_cast(bf16x8, pw##k)
#define VFR(i) (bf16x8){vlo[i][0], vlo[i][1], vlo[i][2], vlo[i][3], vhi[i][0], vhi[i][1], vhi[i][2], vhi[i][3]}
#define VRD(i) do { vlo[i] = vtr(vp_ + (((i) >> 2) * 4096 + ((i) & 3) * 1024)); vhi[i] = vtr(vp_ + (((i) >> 2) * 4096 + ((i) & 3) * 1024 + 512)); } while (0)
#define KRD(d0) do { kload2(kf, kp0 + sl_next, d0); NSBAR(); } while (0)
#define GAPA(MF, a0, a1, a2, a3, W0, W1, PW) do { MF; sacc += a0; sacc += a1; sacc += a2; sacc += a3; W0; W1; NPIN(PW); NPIN(sacc); NSBAR(); } while (0)
#define GAPB(MF, X, i) do { MF; X[i] = EX(X[i]); X[i + 1] = EX(X[i + 1]); X[i + 2] = EX(X[i + 2]); X[i + 3] = EX(X[i + 3]); NPIN(X); NSBAR(); } while (0)
#define NSTEP(C0, C1, P0, P1) do { NSBAR(); \
    const int kt = __builtin_ctz(mc); mc &= mc - 1u; const bool nearb = (kt + 2 >= tblk); \
    const float badd = (WIN || ((selmask >> kt) & 1u)) ? (nearb ? 0.f : cb) : NEG_INF; \
    const LAS unsigned char* vp_ = vp0 + sl_prev; \
    VRD(0); NSBAR(); float sacc = P0[0] + P0[1]; \
                     GAPA(C0 = MFMA32(kf[0], qf[0], zero16), P0[2], P0[3], P0[4], P0[5],     pw0[0] = PKW(P0, 0),  pw0[1] = PKW(P0, 2),  pw0); \
    VRD(4); NSBAR(); GAPA(C1 = MFMA32(kf[1], qf[0], zero16), P0[6], P0[7], P0[8], P0[9],     pw0[2] = PKW(P0, 4),  pw0[3] = PKW(P0, 6),  pw0); \
    VRD(1); NSBAR(); GAPA(C0 = MFMA32(kf[2], qf[1], C0),    P0[10], P0[11], P0[12], P0[13], pw1[0] = PKW(P0, 8),  pw1[1] = PKW(P0, 10), pw1); \
    VRD(5); NSBAR(); GAPA(C1 = MFMA32(kf[3], qf[1], C1),    P0[14], P0[15], P1[0], P1[1],   pw1[2] = PKW(P0, 12), pw1[3] = PKW(P0, 14), pw1); \
    VRD(2); NSBAR(); GAPA(C0 = MFMA32(kf[4], qf[2], C0),    P1[2], P1[3], P1[4], P1[5],     pw2[0] = PKW(P1, 0),  pw2[1] = PKW(P1, 2),  pw2); \
    VRD(6); NSBAR(); GAPA(C1 = MFMA32(kf[5], qf[2], C1),    P1[6], P1[7], P1[8], P1[9],     pw2[2] = PKW(P1, 4),  pw2[3] = PKW(P1, 6),  pw2); \
    VRD(3); NSBAR(); GAPA(C0 = MFMA32(kf[6], qf[3], C0),    P1[10], P1[11], P1[12], P1[13], pw3[0] = PKW(P1, 8),  pw3[1] = PKW(P1, 10), pw3); \
    VRD(7); NSBAR(); GAPA(C1 = MFMA32(kf[7], qf[3], C1),    P1[14], P1[15], 0.f, 0.f,       pw3[2] = PKW(P1, 12), pw3[3] = PKW(P1, 14), pw3); \
    l_reg += sacc; \
    DMA_K(sl_cur); DMA_V(sl_next); \
    if (nearb) nsa_near(C0, C1, 64 * (tblk - kt) + trow, tb2, hd, hi); \
    if (WIN) { if (kt + 8 == tblk) nsa_low(C0, C1, trow, hi); } \
    { const float rm = rowmax(C0, C1) + badd - mhat; resc = false; \
      if (__builtin_expect(__any(rm > NSA_THR), 0)) { const float dl = __builtin_fmaxf(rm, 0.f); mhat += dl; f = ex2(-dl); l_reg *= f; resc = true; } } \
    const float nmh = badd - mhat; NSBAR(); \
    GAPB(o0 = MFMA32(VFR(0), PAF(0), o0), C0, 0);           GAPB(o1 = MFMA32(VFR(4), PAF(0), o1), C0, 4); \
    KRD(0); GAPB(o0 = MFMA32(VFR(1), PAF(1), o0), C0, 8);   KRD(1); GAPB(o1 = MFMA32(VFR(5), PAF(1), o1), C0, 12); \
    KRD(2); GAPB(o0 = MFMA32(VFR(2), PAF(2), o0), C1, 0);   KRD(3); GAPB(o1 = MFMA32(VFR(6), PAF(2), o1), C1, 4); \
    GAPB(o0 = MFMA32(VFR(3), PAF(3), o0), C1, 8);           GAPB(o1 = MFMA32(VFR(7), PAF(3), o1), C1, 12); \
    } while (0)
#define NDRAIN(P0, P1) do { float sacc = P0[0] + P0[1]; \
      _Pragma("unroll") for (int r = 2; r < 16; ++r) sacc += P0[r]; \
      _Pragma("unroll") for (int r = 0; r < 16; ++r) sacc += P1[r]; \
      l_reg += sacc; \
      pw0 = (v4u){PKW(P0, 0), PKW(P0, 2), PKW(P0, 4), PKW(P0, 6)}; pw1 = (v4u){PKW(P0, 8), PKW(P0, 10), PKW(P0, 12), PKW(P0, 14)}; \
      pw2 = (v4u){PKW(P1, 0), PKW(P1, 2), PKW(P1, 4), PKW(P1, 6)}; pw3 = (v4u){PKW(P1, 8), PKW(P1, 10), PKW(P1, 12), PKW(P1, 14)}; \
      const LAS unsigned char* vp_ = vp0 + sl_prev; _Pragma("unroll") for (int i = 0; i < 8; ++i) VRD(i); \
      o0 = MFMA32(VFR(0), PAF(0), o0); o1 = MFMA32(VFR(4), PAF(0), o1); o0 = MFMA32(VFR(1), PAF(1), o0); o1 = MFMA32(VFR(5), PAF(1), o1); \
      o0 = MFMA32(VFR(2), PAF(2), o0); o1 = MFMA32(VFR(6), PAF(2), o1); o0 = MFMA32(VFR(3), PAF(3), o0); o1 = MFMA32(VFR(7), PAF(3), o1); } while (0)
    int t = 1;
    for (; t + 1 < NT; t += 2) {
        NSTEP(pB0, pB1, pA0, pA1); NWAIT_BAR(2); RESC(); ROT();
        NSTEP(pA0, pA1, pB0, pB1); NWAIT_BAR(2); RESC(); ROT();
    }
    if (t < NT) { NSTEP(pB0, pB1, pA0, pA1); NWAIT_BAR(2); RESC(); ROT(); NDRAIN(pB0, pB1); }
    else NDRAIN(pA0, pA1);
    NWAIT_BAR(0);
#undef DMA_K
#undef DMA_V
#undef ROT
#undef EX
#undef RESC
#undef PKW
#undef PAF
#undef VFR
#undef VRD
#undef KRD
#undef GAPA
#undef GAPB
#undef NSTEP
#undef NDRAIN
    oo0 = o0; oo1 = o1;
    lsum = xh_sum(l_reg);
}
__device__ __forceinline__ void nsa_unit(int b, int qblk, const bf16* P, const float* nqn, const bf16* KSn, const bf16* KWn, const bf16* KC, const bf16* VC, const float* onw, bf16* Y,
                                         LAS unsigned char* lds, const LAS float* tb2, int tid) {
    OPQ_V(tid);
    const int lane = tid & 63, w = __builtin_amdgcn_readfirstlane(tid >> 6), r32 = lane & 31, h = lane >> 5;
    const int hd = w >> 1, trow = 32 * (w & 1) + r32, t = 64 * qblk + trow, tblk = qblk; const size_t tok0 = (size_t)b * SEQ, tok = tok0 + t;
    LAS float* SC = (LAS float*)(lds + NSA_SC); LAS unsigned* SEL = (LAS unsigned*)(lds + NSA_SEL); LAS unsigned* UNI = (LAS unsigned*)(lds + NSA_UNI); LAS float* SS4 = (LAS float*)(lds + NSA_SS);
    bf16x8 qf[4];
    { const bf16* qp = P + tok * NP + C_NQ + hd * 64 + 8 * h; v4u raw[4]; float ss = 0.f;
#pragma unroll
      for (int s = 0; s < 4; ++s) { raw[s] = *(const v4u*)(qp + 16 * s);
          const float a0 = bflo(raw[s].x), a1 = bfhi(raw[s].x), a2 = bflo(raw[s].y), a3 = bfhi(raw[s].y), a4 = bflo(raw[s].z), a5 = bfhi(raw[s].z), a6 = bflo(raw[s].w), a7 = bfhi(raw[s].w);
          ss += ((a0 * a0 + a1 * a1) + (a2 * a2 + a3 * a3)) + ((a4 * a4 + a5 * a5) + (a6 * a6 + a7 * a7)); }
      ss = xh_sum(ss);
      const float rstd = (1.0f / sqrtf(ss * (1.f / 64.f) + EPS)) * (0.125f * L2E);
#pragma unroll
      for (int s = 0; s < 4; ++s) { const f32x4 g0 = *(const f32x4*)(nqn + 16 * s + 8 * h), g1 = *(const f32x4*)(nqn + 16 * s + 8 * h + 4); v4u wq;
          wq.x = cvtpk(bflo(raw[s].x) * rstd * g0.x, bfhi(raw[s].x) * rstd * g0.y); wq.y = cvtpk(bflo(raw[s].y) * rstd * g0.z, bfhi(raw[s].y) * rstd * g0.w);
          wq.z = cvtpk(bflo(raw[s].z) * rstd * g1.x, bfhi(raw[s].z) * rstd * g1.y); wq.w = cvtpk(bflo(raw[s].w) * rstd * g1.z, bfhi(raw[s].w) * rstd * g1.w);
          qf[s] = __builtin_bit_cast(bf16x8, wq); } }
    if (tid == 0) UNI[0] = 0u;
    { TileRegs R0_, R1_; const bf16* kc = KC + (size_t)b * 128 * 64; const bf16* vc = VC + (size_t)b * 128 * 64;
      tile_issue<64>(R0_, kc, 64, vc, 64, tid); tile_issue<64>(R1_, kc + 64 * 64, 64, vc + 64 * 64, 64, tid);
      tile_commit<64>(R0_, lds, tid); tile_commit<64>(R1_, lds + TBUF, tid); }
    __syncthreads();
    LAS float* AC0 = (LAS float*)(lds + NSA_SC) + w * 64 + lane; LAS float* AC1 = (LAS float*)(lds + NSA_ACC2) + w * 64 + lane;
    f32x16 pc[4] = {{}, {}, {}, {}};
    {
        qk<64>(pc[0], pc[1], lds, qf, r32, h); qk<64>(pc[2], pc[3], lds + TBUF, qf, r32, h);
        float mx = NEG_INF;
#pragma unroll
        for (int i = 0; i < 4; ++i) { float bv[16];
#pragma unroll
            for (int r = 0; r < 16; ++r) { const int n = 32 * i + crow(r, h), dist = t - (16 * n + 31); bv[r] = tb2[(dist < 0 ? 0 : (dist > 127 ? 127 : dist)) * 4 + hd]; }
#pragma unroll
            for (int r = 0; r < 16; ++r) { const int n = 32 * i + crow(r, h), dist = t - (16 * n + 31); const bool valid = (dist >= 0) && (n < NCMP);
                pc[i][r] = valid ? pc[i][r] + bv[r] : NEG_INF; mx = fmaxf(mx, pc[i][r]); } }
        mx = xh_max(mx);
        const float mu = (mx == NEG_INF) ? 0.f : mx; float s = 0.f;
#pragma unroll
        for (int i = 0; i < 4; ++i)
#pragma unroll
            for (int r = 0; r < 16; ++r) { pc[i][r] = ex2(pc[i][r] - mu); s += pc[i][r]; }
        s = xh_sum(s);
        const float inv = s > 0.f ? 1.0f / s : 0.f;
#pragma unroll
        for (int i = 0; i < 4; ++i)
#pragma unroll
            for (int r = 0; r < 16; ++r) pc[i][r] *= inv;
        float own[16], cry[16];
#pragma unroll
        for (int i = 0; i < 4; ++i)
#pragma unroll
            for (int g = 0; g < 4; ++g) { const float hv = 0.5f * pc[i][4 * g + 3]; own[4 * i + g] = (pc[i][4 * g] + pc[i][4 * g + 1]) + (pc[i][4 * g + 2] + hv); cry[4 * i + g] = hv; }
#pragma unroll
        for (int jj = 0; jj < 16; ++jj) cry[jj] = xhalf(cry[jj], h);
#pragma unroll
        for (int jj = 0; jj < 16; ++jj) { const float fromh0 = cry[jj], fromh1 = jj > 0 ? cry[jj - 1] : 0.f; own[jj] += h ? fromh0 : fromh1; }
#pragma unroll
        for (int jj = 0; jj < 16; ++jj) SC[(hd * 64 + trow) * 32 + 2 * jj + h] = own[jj];
    }
    __syncthreads();
    { const int hw = tid >> 5, j = tid & 31; unsigned uacc = 0u;
      for (int rr = 0; rr < 4; ++rr) { const int row = hw * 4 + rr;
          float sc = (SC[(0 * 64 + row) * 32 + j] + SC[(1 * 64 + row) * 32 + j]) + (SC[(2 * 64 + row) * 32 + j] + SC[(3 * 64 + row) * 32 + j]);
          const bool forced = (j == 0) || (j == tblk) || (j == tblk - 1), validb = j <= tblk;
          sc = forced ? INFINITY : (validb ? sc : NEG_INF);
          int rank = 0;
          for (int jj = 0; jj < 32; ++jj) { const float so = __shfl(sc, jj, 32); rank += (so > sc || (so == sc && jj < j)) ? 1 : 0; }
          const unsigned long long bal = __ballot(rank < 16 && validb);
          const unsigned msk = (lane < 32) ? (unsigned)bal : (unsigned)(bal >> 32);
          if (j == 0) SEL[row] = msk; uacc |= msk; }
      if (j == 0) __hip_atomic_fetch_or(UNI, uacc, __ATOMIC_RELAXED, __HIP_MEMORY_SCOPE_WORKGROUP); }
    __syncthreads();
    const unsigned selmask = SEL[trow]; const unsigned uni = (unsigned)__builtin_amdgcn_readfirstlane((int)UNI[0]);
    unsigned wsel = selmask;
#pragma unroll
    for (int ofs = 1; ofs < 32; ofs <<= 1) wsel |= (unsigned)__shfl_xor((int)wsel, ofs);
    wsel = (unsigned)__builtin_amdgcn_readfirstlane((int)wsel);
    { f32x16 oc0 = {}, oc1 = {};
      pack_pv(oc0, oc1, pc[0], pc[1], lds, lane); pack_pv(oc0, oc1, pc[2], pc[3], lds + TBUF, lane);
      const float gl = bf2f(P[tok * NP + C_NG + hd * 3 + 0]); const float g0 = sigm(gl);
#pragma unroll
      for (int r = 0; r < 16; ++r) { AC0[r * 512] = g0 * oc0[r]; AC1[r * 512] = g0 * oc1[r]; } }
    __syncthreads();
    { f32x16 o0 = {}, o1 = {}; float ls;
      nsa_ring_pass<false>(uni, selmask, tblk, trow, hd, KSn + tok0 * 64, P + tok0 * NP + C_VS, qf, tb2, o0, o1, ls, lds, tid);
      const float gl = bf2f(P[tok * NP + C_NG + hd * 3 + 1]); const float g1 = sigm(gl) / ls;
#pragma unroll
      for (int r = 0; r < 16; ++r) { AC0[r * 512] += g1 * o0[r]; AC1[r * 512] += g1 * o1[r]; } }
    f32x16 acc0, acc1;
    { f32x16 o0 = {}, o1 = {}; float ls;
      const int c0 = tblk >= 8 ? tblk - 8 : 0; const unsigned upto = tblk == 31 ? 0xffffffffu : ((2u << tblk) - 1u); const unsigned wmask = upto & ~((1u << c0) - 1u);
      nsa_ring_pass<true>(wmask, 0u, tblk, trow, hd, KWn + tok0 * 64, P + tok0 * NP + C_VW, qf, tb2, o0, o1, ls, lds, tid);
      const float gl = bf2f(P[tok * NP + C_NG + hd * 3 + 2]); const float g2 = sigm(gl) / ls;
#pragma unroll
      for (int r = 0; r < 16; ++r) { o0[r] = AC0[r * 512] + g2 * o0[r]; o1[r] = AC1[r * 512] + g2 * o1[r]; }
      acc0 = o0; acc1 = o1; }
    { float ss = sumsq(acc0, acc1); ss = xh_sum(ss); if (h == 0) SS4[hd * 64 + trow] = ss; }
    __syncthreads();
    { const float tot = (SS4[trow] + SS4[64 + trow]) + (SS4[128 + trow] + SS4[192 + trow]); const float rstd = 1.0f / sqrtf(tot * (1.f / 256.f) + EPS);
      const float* gw = onw + 256 + hd * 64;
#pragma unroll
      for (int g = 0; g < 4; ++g)
#pragma unroll
          for (int e = 0; e < 4; ++e) { acc0[4 * g + e] *= rstd * gw[8 * g + 4 * h + e]; acc1[4 * g + e] *= rstd * gw[32 + 8 * g + 4 * h + e]; }
      store_o(Y + tok * D + 256 + hd * 64, acc0, acc1, h); }
    __syncthreads();
}
}
#ifndef PROBE_TIME_MASK
#define PROBE_TIME_MASK 0u
#endif
#define PHASE_MAXG(k, wsptr) do { if (PROBE_TIME_MASK != 0u) { if (F.wave == 0 && opq_lane() == 0) { volatile LAS unsigned long long* T_ = (volatile LAS unsigned long long*)((LAS unsigned char*)F.lds + MISC_OFF + 128); const unsigned long long now_ = __builtin_amdgcn_s_memrealtime(); if ((PROBE_TIME_MASK >> (k)) & 1u) atomicMax((unsigned*)((wsptr) + WS_CTL) + 9000, (unsigned)(now_ - T_[0])); T_[0] = now_; } } } while (0)
#ifndef PROBE_CLK_BIT
#define PROBE_CLK_BIT -1
#endif
#define PHASE_CLK(k) do { if (PROBE_CLK_BIT >= 0) { if (F.wave == 0 && opq_lane() == 0) { volatile LAS unsigned long long* T_ = (volatile LAS unsigned long long*)((LAS unsigned char*)F.lds + MISC_OFF + 128); const unsigned long long c_ = __builtin_amdgcn_s_memtime(); if ((k) == PROBE_CLK_BIT) T_[3] += c_ - T_[2]; T_[2] = c_; } } } while (0)
#define PHASE_END(k) do { PHASE_CLK(k); if (PROBE_TIME_MASK != 0u) { if (F.wave == 0 && opq_lane() == 0) { volatile LAS unsigned long long* T_ = (volatile LAS unsigned long long*)((LAS unsigned char*)F.lds + MISC_OFF + 128); const unsigned long long now_ = __builtin_amdgcn_s_memrealtime(); if ((PROBE_TIME_MASK >> (k)) & 1u) T_[1] += now_ - T_[0]; T_[0] = now_; } } } while (0)
#ifndef PROBE_DUP
#define PROBE_DUP -1
#endif
__device__ __forceinline__ int win_dst(int n) { return n < 1408 ? n : (n < 1420 ? 2528 + (n - 1408) : n - 12); }
template <bool WINMAP, bool FRAG = false> __device__ __forceinline__ void transpose_item(const float* W, int K, int N, bf16* WT, float* scr, int item, int lane, const float* gk = nullptr  , int gk0 = 0  ) {
    const int nblk = (N + 31) / 32, kb = item / nblk, nb = item % nblk, k0 = 64 * kb, n0 = 32 * nb;
    { const int n = n0 + (lane & 31); const float cs = (WINMAP && n >= 1772 && n < 2028) ? 0.125f * LOG2E : 1.0f;
      float v[32];
#pragma unroll
      for (int i = 0; i < 32; ++i) { const int kk = 2 * i + (lane >> 5); v[i] = n < N ? W[(size_t)(k0 + kk) * N + n] : 0.f; }
#pragma unroll
      for (int i = 0; i < 32; ++i) { const int kk = 2 * i + (lane >> 5); scr[kk * 33 + (lane & 31)] = v[i] * ((gk && k0 + kk >= gk0) ? cs * gk[k0 + kk] : cs); } }
    LDS_WAIT(); asm volatile("" ::: "memory");
    const int c = lane & 7;
#pragma unroll
    for (int j = 0; j < 4; ++j) { const int nl = (lane >> 3) + 8 * j, n = n0 + nl; const float* s = scr + (8 * c) * 33 + nl;
        v4u o; o.x = pk2(s[0 * 33], s[1 * 33]); o.y = pk2(s[2 * 33], s[3 * 33]); o.z = pk2(s[4 * 33], s[5 * 33]); o.w = pk2(s[6 * 33], s[7 * 33]);
        if (n < N) { const int dn = WINMAP ? win_dst(n) : n; const int kp = k0 + 8 * c;
            if (FRAG) *(v4u*)(WT + ((size_t)((dn >> 5) * (K >> 4) + (kp >> 4)) * 64 + ((kp >> 3) & 1) * 32 + (dn & 31)) * 8) = o;
            else *(v4u*)(WT + (size_t)dn * K + kp) = o; } }
    LDS_WAIT(); asm volatile("" ::: "memory");
}
__device__ __forceinline__ void sincos_d(float angf, float& c, float& s) {
    const double a = (double)angf; const double kq = __builtin_rint(a * 0.63661977236758134308); const int q = (int)kq;
    double r = __builtin_fma(-kq, 1.5707963267948966192, a); r = __builtin_fma(-kq, 6.123233995736766e-17, r);
    const double r2 = r * r;
    double sp = -1.0 / 39916800.0; sp = sp * r2 + 1.0 / 362880.0; sp = sp * r2 - 1.0 / 5040.0; sp = sp * r2 + 1.0 / 120.0; sp = sp * r2 - 1.0 / 6.0; sp = sp * r2 + 1.0; sp *= r;
    double cp = 1.0 / 479001600.0; cp = cp * r2 - 1.0 / 3628800.0; cp = cp * r2 + 1.0 / 40320.0; cp = cp * r2 - 1.0 / 720.0; cp = cp * r2 + 1.0 / 24.0; cp = cp * r2 - 0.5; cp = cp * r2 + 1.0;
    const int qq = q & 3;
    const double sv = (qq == 0) ? sp : (qq == 1) ? cp : (qq == 2) ? -sp : -cp;
    const double cv = (qq == 0) ? cp : (qq == 1) ? -sp : (qq == 2) ? -cp : sp;
    c = (float)cv; s = (float)sv;
}
__device__ __forceinline__ int t5_bucket(int d) {
    if (d < 16) return d;
    int b = 16 + (int)(logf((float)d / 16.0f) / logf(8.0f) * 16.0f);
    return b < 31 ? b : 31;
}

constexpr int CV_IN = (D / 64) * ((NIN + 31) / 32), CV_O = (D / 64) * (D / 32), CV_1 = (D / 64) * (FF / 32), CV_2 = (FF / 64) * (D / 32);
__device__ __forceinline__ void conv_transpose(const Frame F, float* scr, int lane_, int kind, int l, int r) {
    if (kind == 0) transpose_item<true>(((const float*)F.a->in[I_WIN]) + (size_t)l * D * NIN, D, NIN, (bf16*)(F.ws + WS_WIN) + (size_t)l * NP * D, scr, r, lane_, ((const float*)F.a->in[I_N1W]) + l * D);
    else if (kind == 1) transpose_item<false>(((const float*)F.a->in[I_WOUT]) + (size_t)l * D * D, D, D, (bf16*)(F.ws + WS_WO) + (size_t)l * D * D, scr, r, lane_, ((const float*)F.a->in[I_ONW]) + l * D, 512);
    else if (kind == 2) transpose_item<false>(((const float*)F.a->in[I_FW1]) + (size_t)l * D * FF, D, FF, (bf16*)(F.ws + WS_W1) + (size_t)l * FF * D, scr, r, lane_, ((const float*)F.a->in[I_N2W]) + l * D);
    else if (kind == 3) transpose_item<false>(((const float*)F.a->in[I_FW2]) + (size_t)l * FF * D, FF, D, (bf16*)(F.ws + WS_W2) + (size_t)l * D * FF, scr, r, lane_);
    else transpose_item<false, true>(((const float*)F.a->in[I_CW1]) + (size_t)l * 2048 * 256, 2048, 256, (bf16*)(F.ws + WS_W1C) + (size_t)l * 256 * 2048, scr, r, lane_);
}
constexpr int MLAW_Q = 12 * 12 * 64, MLAW_KV = 16 * 8 * 64, MLAW_L = MLAW_Q + MLAW_KV;
__device__ __forceinline__ void conv_mlaw(const Frame F, int it) {
    const int l = it / MLAW_L; int r = it % MLAW_L; const bool isq = r < MLAW_Q; if (!isq) r -= MLAW_Q;
    const int ln = r & 63, fr = r >> 6, KS = isq ? 12 : 8, jt = fr / KS, sx = fr % KS, j = 32 * jt + (ln & 31), c0 = 16 * sx + 8 * (ln >> 5), ldb = isq ? 384 : 512;
    const float* src = (isq ? ((const float*)F.a->in[I_WQB]) + (size_t)l * 192 * 384 : ((const float*)F.a->in[I_WKVB]) + (size_t)l * 128 * 512) + j;
    const float* g = (isq ? ((const float*)F.a->in[I_QAN]) + l * 192 : ((const float*)F.a->in[I_KVN]) + l * 128) + c0;
    float v[8];
#pragma unroll
    for (int i = 0; i < 8; ++i) v[i] = src[(size_t)(c0 + i) * ldb];
    const f32x4 g0 = *(const f32x4*)g, g1 = *(const f32x4*)(g + 4);
    v4u o; o.x = pk2(v[0] * g0[0], v[1] * g0[1]); o.y = pk2(v[2] * g0[2], v[3] * g0[3]); o.z = pk2(v[4] * g1[0], v[5] * g1[1]); o.w = pk2(v[6] * g1[2], v[7] * g1[3]);
    bf16* dst = (bf16*)(F.ws + (isq ? WS_WQF : WS_WKVF)) + (size_t)l * (isq ? 12 * 12 : 16 * 8) * 512;
    *(v4u*)(dst + ((size_t)fr * 64 + ln) * 8) = o;
}

constexpr int CV_TB = 2 * CV_O + 2 * CV_1 + 2 * CV_2 + CV_IN + 2 * 256, CV_TU = (CV_TB + 31) / 32, CV_UNITS = CV_TU;
__device__ __forceinline__ void conv_unit(const Frame F, int cu, int lane_) {
    float* scr = (float*)(F.lds + RING_OFF + F.wave * 16384);
    if (cu < CV_TU) {
        for (int i = 0; i < 4; ++i) { int idx = cu * 32 + F.wave * 4 + i; if (idx >= CV_TB) break;
            if (idx < 2 * CV_O) { conv_transpose(F, scr, lane_, 1, idx / CV_O, idx % CV_O); continue; } idx -= 2 * CV_O;
            if (idx < 2 * CV_1) { conv_transpose(F, scr, lane_, 2, idx / CV_1, idx % CV_1); continue; } idx -= 2 * CV_1;
            if (idx < 2 * CV_2) { conv_transpose(F, scr, lane_, 3, idx / CV_2, idx % CV_2); continue; } idx -= 2 * CV_2;
            if (idx < CV_IN) { conv_transpose(F, scr, lane_, 0, 1, idx); continue; } idx -= CV_IN;
            conv_transpose(F, scr, lane_, 4, 2 + (idx >> 8), idx & 255); }
    }
}
__device__ __forceinline__ void p0_prologue(Frame F) {
    OPQ_S(F.ws); OPQ_S(F.a); const int lane_ = opq_lane(), tid_ = F.wave * 64 + lane_;
    float* scr = (float*)(F.lds + RING_OFF + F.wave * 16384);
    const int gw = F.vcu * NWAVES + F.wave, NGW = F.G * NWAVES;
    const int gt = F.vcu * (NWAVES * 64) + tid_, NT = F.G * NWAVES * 64;
    for (int it = gw; it < CV_IN + 2 * 256; it += NGW) { if (it < CV_IN) conv_transpose(F, scr, lane_, 0, 0, it); else conv_transpose(F, scr, lane_, 4, (it - CV_IN) >> 8, (it - CV_IN) & 255); }
    for (int it = gt; it < DEPTH * MLAW_L; it += NT) conv_mlaw(F, it);
    for (int i = gt; i < DEPTH * 20 * D / 8; i += NT) { const int l = i / (20 * D / 8), r = i % (20 * D / 8);
        *(v4u*)((bf16*)(F.ws + WS_WIN) + (size_t)l * NP * D + (size_t)NIN * D + (size_t)r * 8) = (v4u){0u, 0u, 0u, 0u}; }
    for (int i = gt; i < SEQ * 16; i += NT) { const int t = i >> 4, j = i & 15;
        const double pb = (j & 3) == 0 ? 1.0 : (j & 3) == 1 ? 0.56234132519034908 : (j & 3) == 2 ? 0.31622776601683794 : 0.17782794100389228;
        const int e = j >> 2; const double ps = e == 0 ? 1.0 : e == 1 ? 0.1 : e == 2 ? 0.01 : 0.001;
        const float inv = (float)(pb * ps); const float ang = (float)t * inv; float c, s; sincos_d(ang, c, s);
        ((float*)(F.ws + WS_ROPE))[i] = c; ((float*)(F.ws + WS_ROPE))[SEQ * 16 + i] = s; }
    for (int i = gt; i < 128 * 4; i += NT) { const int d = i >> 2, h = i & 3; ((float*)(F.ws + WS_TB))[i] = ((const float*)F.a->in[I_RELB])[t5_bucket(d) * 4 + h] * LOG2E; }
    for (int it = gw; it < DEPTH * 2 * 16 * 4; it += NGW) { const int hb = it & 3, ks = (it >> 2) & 15, lb = it >> 6;
        const float* pos = ((const float*)F.a->in[I_CPOS]) + (size_t)lb * 2048; const float* w1 = ((const float*)F.a->in[I_CW1]) + (size_t)lb * 2048 * 256 + hb * 64 + lane_; float a = 0.f;
        for (int k0 = ks * 128; k0 < ks * 128 + 128; k0 += 16) { float wv[16];
#pragma unroll
            for (int q = 0; q < 16; ++q) wv[q] = w1[(size_t)(k0 + q) * 256];
#pragma unroll
            for (int q = 0; q < 16; ++q) a += pos[k0 + q] * wv[q]; }
        ((float*)(F.ws + WS_CB1))[(lb * 16 + ks) * 256 + hb * 64 + lane_] = a; }
    for (int m0 = gw; m0 < M; m0 += 2 * NGW) {
        f32x4 v[2][4]; float sq[2] = {0.f, 0.f};
#pragma unroll
        for (int q = 0; q < 2; ++q) { const f32x4* xr = (const f32x4*)(((const float*)F.a->in[I_X]) + (size_t)(m0 + q * NGW) * D) + lane_;
#pragma unroll
            for (int j = 0; j < 4; ++j) v[q][j] = xr[64 * j]; }
#pragma unroll
        for (int q = 0; q < 2; ++q) { const int m = m0 + q * NGW; unsigned long long* o8 = (unsigned long long*)((bf16*)(F.ws + WS_XB) + (size_t)m * D) + lane_;
#pragma unroll
            for (int j = 0; j < 4; ++j) { sq[q] += (v[q][j].x * v[q][j].x + v[q][j].y * v[q][j].y) + (v[q][j].z * v[q][j].z + v[q][j].w * v[q][j].w);
                o8[64 * j] = (unsigned long long)pk2(v[q][j].x, v[q][j].y) | ((unsigned long long)pk2(v[q][j].z, v[q][j].w) << 32); }
            const float t = wsum(sq[q]); if (lane_ == 0) *(f32x4*)((float*)(F.ws + WS_SSQX) + (size_t)m * 4) = (f32x4){t, 0.f, 0.f, 0.f}; }
    }
}
__device__ __forceinline__ float red8(float v) { v += __shfl_xor(v, 1); v += __shfl_xor(v, 2); v += __shfl_xor(v, 4); return v; }
__device__ __forceinline__ void un8(const v4u w, float (&f)[8]) { f[0] = bflo(w.x); f[1] = bfhi(w.x); f[2] = bflo(w.y); f[3] = bfhi(w.y); f[4] = bflo(w.z); f[5] = bfhi(w.z); f[6] = bflo(w.w); f[7] = bfhi(w.w); }
__device__ __forceinline__ void ldf8(const float* p, float (&f)[8]) { const f32x4 a = *(const f32x4*)p, b = *(const f32x4*)(p + 4); f[0] = a.x; f[1] = a.y; f[2] = a.z; f[3] = a.w; f[4] = b.x; f[5] = b.y; f[6] = b.z; f[7] = b.w; }
__device__ __forceinline__ void st8(bf16* p, const float (&f)[8]) { v4u w; w.x = att::cvtpk(f[0], f[1]); w.y = att::cvtpk(f[2], f[3]); w.z = att::cvtpk(f[4], f[5]); w.w = att::cvtpk(f[6], f[7]); *(v4u*)p = w; }
__device__ __forceinline__ float ss8(const float (&f)[8]) { return ((f[0] * f[0] + f[1] * f[1]) + (f[2] * f[2] + f[3] * f[3])) + ((f[4] * f[4] + f[5] * f[5]) + (f[6] * f[6] + f[7] * f[7])); }
__device__ __forceinline__ void rope8(float (&x)[8], const float (&c)[8], const float (&s)[8], bool first) {
#pragma unroll
    for (int j = 0; j < 8; ++j) { const float o = __shfl_xor(x[j], 2); x[j] = first ? x[j] * c[j] - o * s[j] : o * s[j] + x[j] * c[j]; }
}
__device__ __forceinline__ void compress_unit(const Frame F, int l, int u) {
    const int lane = opq_lane(), tid = F.wave * 64 + lane, w = F.wave, r32 = lane & 31, h = lane >> 5;
    const int g4 = u & 3, br = (u >> 2) & 1, b = u >> 3, n0 = 32 * g4, lb = l * 2 + br;
    LAS unsigned char* lds = (LAS unsigned char*)F.lds;
    LAS float* biasL = (LAS float*)lds; LAS float* part = (LAS float*)(lds + 1024); LAS float* ssl = (LAS float*)(lds + 1024 + 65536);
    const bf16* P = (const bf16*)(F.ws + WS_P);
    if (tid < 256) { const float* cb1 = (const float*)(F.ws + WS_CB1) + (size_t)lb * 16 * 256 + tid; float bs = 0.f;
        float t16[16];
#pragma unroll
        for (int ks = 0; ks < 16; ++ks) t16[ks] = cb1[ks * 256];
#pragma unroll
        for (int ks = 0; ks < 16; ++ks) bs += t16[ks];
        biasL[tid] = bs; }
    att::f32x16 acc = {};
    {
        const bf16* w1f = (const bf16*)(F.ws + WS_W1C) + (size_t)lb * 256 * 2048 + ((size_t)w * 128 * 64 + lane) * 8;
        const bf16* tkb = P + ((size_t)b * SEQ + 16 * n0) * NP + (br ? C_VC : C_KC);
        LAS unsigned char* tb = lds + 1024;
        v4u rg[4];
#define CMP_ISSUE(c) do { _Pragma("unroll") for (int i = 0; i < 4; ++i) { const int idx = tid + 512 * i, p8 = idx & 7, rid = idx >> 3, rr = rid & 31, tq = rid >> 5; \
            rg[i] = *(const v4u*)(tkb + (size_t)(16 * rr + 8 * (c) + tq) * NP + 8 * p8); } } while (0)
#define CMP_COMMIT(c) do { _Pragma("unroll") for (int i = 0; i < 4; ++i) { const int idx = tid + 512 * i, p8 = idx & 7, rid = idx >> 3, rr = rid & 31, tq = rid >> 5; \
            *(LAS v4u*)(tb + ((c) & 1) * 32768 + ((tq * 8 + p8) * 32 + rr) * 16) = rg[i]; } } while (0)
        CMP_ISSUE(0); CMP_COMMIT(0);
        __syncthreads();
        PHASE_END(21);
        for (int c = 0; c < 4; ++c) {
            if (c < 3) CMP_ISSUE(c + 1);
            const LAS unsigned char* cb = tb + (c & 1) * 32768 + r32 * 16;
#pragma unroll
            for (int s8 = 0; s8 < 4; ++s8) { bf16x8 af[8], bfr[8];
#pragma unroll
                for (int q = 0; q < 8; ++q) { const int sl = 8 * s8 + q; af[q] = *(const bf16x8*)(w1f + (size_t)(32 * c + sl) * 512); }
#pragma unroll
                for (int q = 0; q < 8; ++q) { const int sl = 8 * s8 + q; bfr[q] = *(const LAS bf16x8*)(cb + (((sl >> 2) * 8 + (sl & 3) * 2 + h) * 32) * 16); }
#pragma unroll
                for (int q = 0; q < 8; ++q) acc = MFMA32(af[q], bfr[q], acc); }
            if (c < 3) CMP_COMMIT(c + 1);
            __syncthreads();
        }
#undef CMP_ISSUE
#undef CMP_COMMIT
    }
    PHASE_END(22);
#pragma unroll
    for (int i = 0; i < 16; ++i) { const float x = acc[i] + biasL[32 * w + att::crow(i, h)]; acc[i] = x / (1.0f + __expf(-x)); }
    { att::f32x16 o0 = {}, o1 = {}; const float* w2 = ((const float*)F.a->in[I_CW2]) + (size_t)lb * 256 * 64;
#pragma unroll
      for (int s = 0; s < 2; ++s) { const bf16x8 bfr = att::packfrag(acc, s);
#pragma unroll
          for (int eb = 0; eb < 2; ++eb) { float a8[8];
#pragma unroll
              for (int j = 0; j < 8; ++j) a8[j] = w2[(size_t)(32 * w + 16 * s + 8 * (j >> 2) + 4 * h + (j & 3)) * 64 + 32 * eb + r32];
              v4u pw; pw.x = att::cvtpk(a8[0], a8[1]); pw.y = att::cvtpk(a8[2], a8[3]); pw.z = att::cvtpk(a8[4], a8[5]); pw.w = att::cvtpk(a8[6], a8[7]);
              const bf16x8 af = __builtin_bit_cast(bf16x8, pw);
              if (eb == 0) o0 = MFMA32(af, bfr, o0); else o1 = MFMA32(af, bfr, o1); } }
#pragma unroll
      for (int i = 0; i < 16; ++i) { part[(w * 64 + att::crow(i, h)) * 32 + r32] = o0[i]; part[(w * 64 + 32 + att::crow(i, h)) * 32 + r32] = o1[i]; } }
    __syncthreads();
    PHASE_END(23);
    { const int r = tid & 31, eg = tid >> 5; float o[4];
#pragma unroll
      for (int q = 0; q < 4; ++q) { float a = 0.f;
#pragma unroll
          for (int ww = 0; ww < 8; ++ww) a += part[(ww * 64 + 4 * eg + q) * 32 + r];
          o[q] = a; }
      if (br == 0) { ssl[eg * 32 + r] = (o[0] * o[0] + o[1] * o[1]) + (o[2] * o[2] + o[3] * o[3]);
          __syncthreads();
          float tot = 0.f;
#pragma unroll
          for (int e2 = 0; e2 < 16; ++e2) tot += ssl[e2 * 32 + r];
          const float rstd = 1.0f / sqrtf(tot * (1.f / 64.f) + EPS); const float* kn = ((const float*)F.a->in[I_NKN]) + l * 192 + 4 * eg;
#pragma unroll
          for (int q = 0; q < 4; ++q) o[q] *= rstd * kn[q]; }
      const int n = n0 + r; uint2 wv; wv.x = att::cvtpk(o[0], o[1]); wv.y = att::cvtpk(o[2], o[3]); if (n >= NCMP) { wv.x = 0u; wv.y = 0u; }
      *(uint2*)((bf16*)(F.ws + WS_KCV) + (size_t)br * 65536 + ((size_t)b * 128 + n) * 64 + 4 * eg) = wv; }
    __syncthreads();
}
__device__ __forceinline__ void convmix_unit(const Frame F, int l, int unit, int lane) {
    const bf16* P = (const bf16*)(F.ws + WS_P); bf16* Y = (bf16*)(F.ws + WS_Y);
    const float* cw = ((const float*)F.a->in[I_CONVW]) + l * 768; const float* cb = ((const float*)F.a->in[I_CONVB]) + l * 256; const float* onw = ((const float*)F.a->in[I_ONW]) + l * 1024;
    const int ts = lane >> 3, ch = lane & 7;
    {
        const int m = unit * 64 + F.wave * 8 + ts, t = m % SEQ; const bf16* pr = P + (size_t)m * NP;
        const float m1 = t >= 1 ? 1.f : 0.f, m2 = t >= 2 ? 1.f : 0.f; const bf16* p1 = pr - (t >= 1 ? NP : 0); const bf16* p2 = pr - (t >= 2 ? 2 * NP : 0);
        float y[4][8]; float ssy = 0.f;
#pragma unroll
        for (int sg = 0; sg < 4; ++sg) { const int col = 64 * sg + 8 * ch; v4u rv[7]; float w0[8], w1[8], w2[8], cbv[8];
            rv[0] = *(const v4u*)(pr + C_AC + col); rv[1] = *(const v4u*)(pr + C_AU + col); rv[2] = *(const v4u*)(p1 + C_AC + col); rv[3] = *(const v4u*)(p1 + C_AU + col);
            rv[4] = *(const v4u*)(p2 + C_AC + col); rv[5] = *(const v4u*)(p2 + C_AU + col); rv[6] = *(const v4u*)(pr + C_AB + col);
            ldf8(cw + col, w0); ldf8(cw + 256 + col, w1); ldf8(cw + 512 + col, w2); ldf8(cb + col, cbv);
            float u[8], v0[8], v1[8], v2[8];
            un8(rv[0], v0); un8(rv[1], u);
#pragma unroll
            for (int j = 0; j < 8; ++j) v0[j] *= u[j];
            un8(rv[2], v1); un8(rv[3], u);
#pragma unroll
            for (int j = 0; j < 8; ++j) v1[j] *= u[j] * m1;
            un8(rv[4], v2); un8(rv[5], u);
#pragma unroll
            for (int j = 0; j < 8; ++j) v2[j] *= u[j] * m2;
            un8(rv[6], u);
#pragma unroll
            for (int j = 0; j < 8; ++j) y[sg][j] = u[j] * (w0[j] * v2[j] + w1[j] * v1[j] + w2[j] * v0[j] + cbv[j]);
            ssy += ss8(y[sg]); }
        { const float rstd = 1.0f / sqrtf(red8(ssy) * (1.f / 256.f) + EPS); float go[4][8];
#pragma unroll
          for (int sg = 0; sg < 4; ++sg) ldf8(onw + 64 * sg + 8 * ch, go[sg]);
#pragma unroll
          for (int sg = 0; sg < 4; ++sg) {
#pragma unroll
              for (int j = 0; j < 8; ++j) y[sg][j] *= rstd * go[sg][j];
              st8(Y + (size_t)m * D + 64 * sg + 8 * ch, y[sg]); } }
    }
}
__device__ __forceinline__ void prep_phase(Frame F, int l) {
    OPQ_S(F.ws); OPQ_S(F.a); const int lane_ = opq_lane(), tid_ = F.wave * 64 + lane_;
    const int lane = lane_; const int gw = F.vcu * NWAVES + F.wave, NGW = F.G * NWAVES;
    const bf16* P = (const bf16*)(F.ws + WS_P);
    const float* mqn = ((const float*)F.a->in[I_MQN]) + l * 96; const float* mkn = ((const float*)F.a->in[I_MKN]) + l * 96;
    const float* nkn = ((const float*)F.a->in[I_NKN]) + l * 192;
    const float* cw = ((const float*)F.a->in[I_CONVW]) + l * 768; const float* cb = ((const float*)F.a->in[I_CONVB]) + l * 256; const float* onw = ((const float*)F.a->in[I_ONW]) + l * 1024;
    const float* cosT = (const float*)(F.ws + WS_ROPE); const float* sinT = cosT + SEQ * 16;
    GAS unsigned char* ob_ = (GAS unsigned char*)F.a->out; bf16* QM = (bf16*)(ob_ + OUT_QM); bf16* KM = (bf16*)(ob_ + OUT_KM); bf16* VM = (bf16*)(ob_ + OUT_VM);
    bf16* KSn = (bf16*)(F.ws + WS_KS); bf16* KWn = (bf16*)(F.ws + WS_KW); bf16* Y = (bf16*)(F.ws + WS_Y);
    const int ts = lane >> 3, ch = lane & 7; const bool ropelane = ch < 4, first = ch < 2;
    constexpr int LATP = 328;
    LAS unsigned char* ldsb = (LAS unsigned char*)F.lds; LAS bf16* latn = (LAS bf16*)ldsb;
    bf16* QKV = (bf16*)(F.ws + WS_QKV);
    for (int unit = F.vcu; unit < M / 64; unit += F.G) {
        const int m = unit * 64 + F.wave * 8 + ts, t = m % SEQ; const bf16* pr = P + (size_t)m * NP;
        float a[8];
        { v4u rl[5];
#pragma unroll
          for (int sg = 0; sg < 3; ++sg) rl[sg] = *(const v4u*)(pr + C_CQ + 64 * sg + 8 * ch);
#pragma unroll
          for (int sg = 0; sg < 2; ++sg) rl[3 + sg] = *(const v4u*)(pr + C_CKV + 64 * sg + 8 * ch);
          float ss = 0.f;
#pragma unroll
          for (int sg = 0; sg < 3; ++sg) { un8(rl[sg], a); ss += ss8(a); }
          const float rq = 1.0f / sqrtf(red8(ss) * (1.f / 192.f) + EPS); ss = 0.f;
#pragma unroll
          for (int sg = 0; sg < 2; ++sg) { un8(rl[3 + sg], a); ss += ss8(a); }
          const float rkv = 1.0f / sqrtf(red8(ss) * (1.f / 128.f) + EPS);
          LAS bf16* lrow = latn + (F.wave * 8 + ts) * LATP + 8 * ch;
#pragma unroll
          for (int sg = 0; sg < 5; ++sg) { un8(rl[sg], a); const float r_ = sg < 3 ? rq : rkv; v4u w;
              w.x = att::cvtpk(a[0] * r_, a[1] * r_); w.y = att::cvtpk(a[2] * r_, a[3] * r_); w.z = att::cvtpk(a[4] * r_, a[5] * r_); w.w = att::cvtpk(a[6] * r_, a[7] * r_);
              *(LAS v4u*)(lrow + 64 * sg) = w; } }
        __syncthreads();
        { const int r32 = lane & 31, h = lane >> 5;
          for (int jt = F.wave; jt < 28; jt += 8) {
              const bool isq = jt < 12;
              const bf16* wf = (isq ? (const bf16*)(F.ws + WS_WQF) + ((size_t)l * 144 + jt * 12) * 512 : (const bf16*)(F.ws + WS_WKVF) + ((size_t)l * 128 + (jt - 12) * 8) * 512) + lane * 8;
              const LAS bf16* lb = latn + r32 * LATP + (isq ? 0 : 192) + 8 * h;
              att::f32x16 c0 = {}, c1 = {};
              bf16x8 af[12];
#pragma unroll
              for (int sx = 0; sx < 12; ++sx) af[sx] = (sx < 8 || isq) ? *(const bf16x8*)(wf + (size_t)sx * 512) : af[0];
#pragma unroll
              for (int sx = 0; sx < 12; ++sx) { if (sx < 8 || isq) { const bf16x8 b0 = *(const LAS bf16x8*)(lb + 16 * sx), b1 = *(const LAS bf16x8*)(lb + 32 * LATP + 16 * sx);
                      c0 = MFMA32(af[sx], b0, c0); c1 = MFMA32(af[sx], b1, c1); } }
              bf16* q0 = QKV + (size_t)(unit * 64 + r32) * NQKV + 32 * jt + 4 * h; bf16* q1 = q0 + (size_t)32 * NQKV;
#pragma unroll
              for (int g4 = 0; g4 < 4; ++g4) { uint2 w0; w0.x = att::cvtpk(c0[4 * g4], c0[4 * g4 + 1]); w0.y = att::cvtpk(c0[4 * g4 + 2], c0[4 * g4 + 3]); *(uint2*)(q0 + 8 * g4) = w0;
                  uint2 w1; w1.x = att::cvtpk(c1[4 * g4], c1[4 * g4 + 1]); w1.y = att::cvtpk(c1[4 * g4 + 2], c1[4 * g4 + 3]); *(uint2*)(q1 + 8 * g4) = w1; } } }
        __syncthreads();
        const bf16* qk = QKV + (size_t)m * NQKV;
        v4u rkr, rh[2][4];
        rkr = *(const v4u*)(pr + C_KR + 8 * (ch & 3));
        float rc[8], rs[8]; ldf8(cosT + t * 16 + 8 * (ch & 1), rc); ldf8(sinT + t * 16 + 8 * (ch & 1), rs);
#define TOK_LOAD_HEADS(h0) do { _Pragma("unroll") for (int q_ = 0; q_ < 2; ++q_) { const int hh_ = (h0) + q_; rh[q_][0] = *(const v4u*)(qk + 96 * hh_ + 8 * ch); rh[q_][1] = *(const v4u*)(qk + 96 * hh_ + 64 + 8 * (ch & 3)); \
            rh[q_][2] = *(const v4u*)(qk + 384 + 128 * hh_ + 8 * ch); rh[q_][3] = *(const v4u*)(qk + 384 + 128 * hh_ + 64 + 8 * ch); } } while (0)
        TOK_LOAD_HEADS(0);
        float gqn[8], gqr[8], gkn[8], gkr[8]; ldf8(mqn + 8 * ch, gqn); ldf8(mqn + 64 + 8 * (ch & 3), gqr); ldf8(mkn + 8 * ch, gkn); ldf8(mkn + 64 + 8 * (ch & 3), gkr);
        float kr[8];
        un8(rkr, kr);
#pragma unroll
        for (int j = 0; j < 8; ++j) kr[j] = ropelane ? kr[j] : 0.f;
        rope8(kr, rc, rs, first);
        const float sskr = ss8(kr);
#pragma unroll
        for (int hh = 0; hh < 4; ++hh) {
            if (hh == 2) TOK_LOAD_HEADS(2);
            float qr[8];
            un8(rh[hh & 1][0], a); un8(rh[hh & 1][1], qr);
#pragma unroll
            for (int j = 0; j < 8; ++j) qr[j] = ropelane ? qr[j] : 0.f;
            rope8(qr, rc, rs, first);
            float rstd = 1.0f / sqrtf(red8(ss8(a) + ss8(qr)) * (1.f / 96.f) + EPS) * (0.10206207261596577f * LOG2E);
            bf16* qo = QM + ((size_t)m * 4 + hh) * 96;
#pragma unroll
            for (int j = 0; j < 8; ++j) { a[j] *= rstd * gqn[j]; qr[j] *= rstd * gqr[j]; }
            st8(qo + 8 * ch, a);
            if (ropelane) st8(qo + 64 + 8 * ch, qr);
            un8(rh[hh & 1][2], a);
            rstd = 1.0f / sqrtf(red8(ss8(a) + sskr) * (1.f / 96.f) + EPS);
            bf16* ko = KM + ((size_t)m * 4 + hh) * 96;
#pragma unroll
            for (int j = 0; j < 8; ++j) a[j] *= rstd * gkn[j];
            st8(ko + 8 * ch, a);
#pragma unroll
            for (int j = 0; j < 8; ++j) a[j] = kr[j] * rstd * gkr[j];
            if (ropelane) st8(ko + 64 + 8 * ch, a);
            *(v4u*)(VM + (size_t)m * 256 + 64 * hh + 8 * ch) = rh[hh & 1][3];
        }
        __syncthreads();
    }
    for (int task = gw; task < M / 8; task += NGW) {
        const int m = task * 8 + ts; const bf16* pr = P + (size_t)m * NP;
        float a[8];
        { v4u rks = *(const v4u*)(pr + C_KS + 8 * ch), rkw = *(const v4u*)(pr + C_KW + 8 * ch); float gks[8], gkw[8]; ldf8(nkn + 64 + 8 * ch, gks); ldf8(nkn + 128 + 8 * ch, gkw);
          un8(rks, a); float rstd = 1.0f / sqrtf(red8(ss8(a)) * (1.f / 64.f) + EPS);
#pragma unroll
          for (int j = 0; j < 8; ++j) a[j] *= rstd * gks[j];
          st8(KSn + (size_t)m * 64 + 8 * ch, a);
          un8(rkw, a); rstd = 1.0f / sqrtf(red8(ss8(a)) * (1.f / 64.f) + EPS);
#pragma unroll
          for (int j = 0; j < 8; ++j) a[j] *= rstd * gkw[j];
          st8(KWn + (size_t)m * 64 + 8 * ch, a); }
    }
#undef TOK_LOAD_HEADS
    __syncthreads();
    PHASE_END(20);
    for (int rep_ = 0; rep_ < (PROBE_DUP == 3 ? 2 : 1); ++rep_)
    for (int u = F.vcu; u < BATCH * 2 * 4; u += F.G) compress_unit(F, l, u);
}

constexpr int ATT_UNITS = 768, ATT_FILL_POS = 400;
__device__ const unsigned short ATT_ORDER[768] = {4127,4159,4191,4223,4255,4287,4319,4351,4126,4158,4190,4222,4254,4286,4318,4350,4125,4157,4189,4221,4253,4285,4317,4349,4124,4156,4188,4220,4252,4284,4316,4348,4123,4155,4187,4219,4251,4283,4315,4347,4122,4154,4186,4218,4250,4282,4314,4346,4121,4153,4185,4217,4249,4281,4313,4345,4120,4152,4184,4216,4248,4280,4312,4344,4119,4151,4183,4215,4247,4279,4311,4343,4118,4150,4182,4214,4246,4278,4310,4342,4117,4149,4181,4213,4245,4277,4309,4341,4116,4148,4180,4212,4244,4276,4308,4340,4115,4147,4179,4211,4243,4275,4307,4339,4114,4146,4178,4210,4242,4274,4306,4338,4113,4145,4177,4209,4241,4273,4305,4337,4112,4144,4176,4208,4240,4272,4304,4336,4111,4143,4175,4207,4239,4271,4303,4335,4110,4142,4174,4206,4238,4270,4302,4334,4109,4141,4173,4205,4237,4269,4301,4333,4108,4140,4172,4204,4236,4268,4300,4332,7,15,23,31,39,47,55,63,71,79,87,95,103,111,119,127,135,143,151,159,167,175,183,191,199,207,215,223,231,239,247,255,4107,4139,4171,4203,4235,4267,4299,4331,4106,4138,4170,4202,4234,4266,4298,4330,4105,4137,4169,4201,4233,4265,4297,4329,6,14,22,30,38,46,54,62,70,78,86,94,102,110,118,126,134,142,150,158,166,174,182,190,198,206,214,222,230,238,246,254,4104,4136,4168,4200,4232,4264,4296,4328,4103,4135,4167,4199,4231,4263,4295,4327,5,13,21,29,37,45,53,61,69,77,85,93,101,109,117,125,133,141,149,157,165,173,181,189,197,205,213,221,229,237,245,253,4102,4134,4166,4198,4230,4262,4294,4326,4101,4133,4165,4197,4229,4261,4293,4325,4,12,20,28,36,44,52,60,68,76,84,92,100,108,116,124,132,140,148,156,164,172,180,188,196,204,212,220,228,236,244,252,4100,4132,4164,4196,4228,4260,4292,4324,3,11,19,27,35,43,51,59,67,75,83,91,99,107,115,123,131,139,147,155,163,171,179,187,195,203,211,219,227,235,243,251,4099,4131,4163,4195,4227,4259,4291,4323,4098,4130,4162,4194,4226,4258,4290,4322,2,10,18,26,34,42,50,58,66,74,82,90,98,106,114,122,130,138,146,154,162,170,178,186,194,202,210,218,226,234,242,250,4097,4129,4161,4193,4225,4257,4289,4321,8199,8207,8215,8223,8231,8239,8247,8255,8263,8271,8279,8287,8295,8303,8311,8319,8327,8335,8343,8351,8359,8367,8375,8383,8391,8399,8407,8415,8423,8431,8439,8447,8198,8206,8214,8222,8230,8238,8246,8254,8262,8270,8278,8286,8294,8302,8310,8318,8326,8334,8342,8350,8358,8366,8374,8382,8390,8398,8406,8414,8422,8430,8438,8446,8197,8205,8213,8221,8229,8237,8245,8253,8261,8269,8277,8285,8293,8301,8309,8317,8325,8333,8341,8349,8357,8365,8373,8381,8389,8397,8405,8413,8421,8429,8437,8445,8196,8204,8212,8220,8228,8236,8244,8252,8260,8268,8276,8284,8292,8300,8308,8316,8324,8332,8340,8348,8356,8364,8372,8380,8388,8396,8404,8412,8420,8428,8436,8444,8195,8203,8211,8219,8227,8235,8243,8251,8259,8267,8275,8283,8291,8299,8307,8315,8323,8331,8339,8347,8355,8363,8371,8379,8387,8395,8403,8411,8419,8427,8435,8443,8194,8202,8210,8218,8226,8234,8242,8250,8258,8266,8274,8282,8290,8298,8306,8314,8322,8330,8338,8346,8354,8362,8370,8378,8386,8394,8402,8410,8418,8426,8434,8442,8193,8201,8209,8217,8225,8233,8241,8249,8257,8265,8273,8281,8289,8297,8305,8313,8321,8329,8337,8345,8353,8361,8369,8377,8385,8393,8401,8409,8417,8425,8433,8441,1,9,17,25,33,41,49,57,65,73,81,89,97,105,113,121,129,137,145,153,161,169,177,185,193,201,209,217,225,233,241,249,4096,4128,4160,4192,4224,4256,4288,4320,8192,8200,8208,8216,8224,8232,8240,8248,8256,8264,8272,8280,8288,8296,8304,8312,8320,8328,8336,8344,8352,8360,8368,8376,8384,8392,8400,8408,8416,8424,8432,8440,0,8,16,24,32,40,48,56,64,72,80,88,96,104,112,120,128,136,144,152,160,168,176,184,192,200,208,216,224,232,240,248};

__device__ __forceinline__ void attn_phase(Frame F, int l, int qslot_i = 0) {
    OPQ_S(F.ws); OPQ_S(F.a); const int lane_ = opq_lane(), tid_ = F.wave * 64 + lane_;
    const int tid = tid_;
    LAS unsigned char* lds = (LAS unsigned char*)F.lds;
    LAS float* tb2 = (LAS float*)(lds + TB_OFF);
    LAS unsigned* qslot = (LAS unsigned*)(lds + MISC_OFF) + 16;
    LAS unsigned* sbflags = (LAS unsigned*)(lds + att::NSA_END);
    for (int i = tid; i < 512; i += NWAVES * 64) tb2[i] = ((const float*)(F.ws + WS_TB))[i];
    const bf16* P = (const bf16*)(F.ws + WS_P);
    const GAS unsigned char* ob_ = (const GAS unsigned char*)F.a->out; const bf16* QM = (const bf16*)(ob_ + OUT_QM); const bf16* KM = (const bf16*)(ob_ + OUT_KM); const bf16* VM = (const bf16*)(ob_ + OUT_VM);
    const float* nqn = ((const float*)F.a->in[I_NQN]) + l * 64; const bf16* KSn = (const bf16*)(F.ws + WS_KS); const bf16* KWn = (const bf16*)(F.ws + WS_KW);
    const bf16* KC = (const bf16*)(F.ws + WS_KCV); const bf16* VC = KC + 65536;
    bf16* Y = (bf16*)(F.ws + WS_Y); float* SSQ = (float*)(F.ws + WS_SSQ); const float* onw = ((const float*)F.a->in[I_ONW]) + l * 1024;
    unsigned* qhead = (unsigned*)(F.ws + WS_CTL) + CW_QUEUE + 64 * (l + 2 * qslot_i);
    PHASE_END(27);
    const int nfill = (l == 0) ? CV_UNITS : 0;
    if (F.wave >= 4) __builtin_amdgcn_s_setprio(1);
    for (;;) {
        __syncthreads();
        if (tid == 0) qslot[0] = __hip_atomic_fetch_add(qhead, 1u, __ATOMIC_RELAXED, __HIP_MEMORY_SCOPE_AGENT);
        __syncthreads();
        int u = __builtin_amdgcn_readfirstlane((int)qslot[0]);
        if (u >= ATT_UNITS + nfill + M / 64) break;
        if (u >= ATT_UNITS + nfill) { convmix_unit(F, l, u - ATT_UNITS - nfill, opq_lane()); PHASE_END(28); continue; }
        if (u >= ATT_FILL_POS && u < ATT_FILL_POS + nfill) {
            __syncthreads(); if (tid == 0) qslot[2] = __hip_atomic_fetch_add((unsigned*)(F.ws + WS_CTL) + CW_FILL, 1u, __ATOMIC_RELAXED, __HIP_MEMORY_SCOPE_AGENT); __syncthreads();
            const int fu = __builtin_amdgcn_readfirstlane((int)qslot[2]); if (fu < CV_UNITS) { conv_unit(F, fu, opq_lane()); PHASE_END(28); }
            continue; }
        if (u >= ATT_FILL_POS) u -= nfill;
        const int code = __builtin_amdgcn_readfirstlane((int)ATT_ORDER[u]), ty = code >> 12, bb = (code >> 5) & 7;
        if (ty == 0) { att::mla_unit(bb, (code >> 3) & 3, code & 7, QM, KM, VM, Y, SSQ, lds, tid); PHASE_END(24); }
        else if (ty == 1) { att::nsa_unit(bb, code & 31, P, nqn, KSn, KWn, KC, VC, onw, Y, lds, tb2, tid); if (u < 8 && l == 1) PHASE_MAXG(29, F.ws); else PHASE_END(25); }
        else { att::sb_unit(bb, (code >> 3) & 3, code & 7, P, Y, SSQ, lds, sbflags, tid); PHASE_END(26); }
    }
    __builtin_amdgcn_s_setprio(0);
}
#ifndef PROBE_DUP
#define PROBE_DUP -1
#endif
#define IN(k) (lo <= (k) && (k) < hi)
#define SEAM() do { if (MK_ONE_LAUNCH) { XcdBarrier b2_ = bar; OPQ_S(b2_.bar); xcd_barrier(b2_, F.wave == 0 && opq_lane() == 0); } } while (0)
__device__ __forceinline__ void layer_body(const Args& args, const Frame F, const XcdBarrier& bar, LAS unsigned char* ldsl, const int lo, const int hi, const int l) {
        const int pb = 1 + 6 * l;
        if (IN(pb + 0)) {
            GAS unsigned char* ws = (GAS unsigned char*)args.ws; OPQ_S(ws);
            pg8::Gemm g{(const bf16*)(ws + WS_XB), (const bf16*)(ws + WS_WIN) + (size_t)l * NP * D, M, NP, D}; pg8::StaticOrder S; S.init(M, NP, F.G, (int)blockIdx.x);
            { LAS float* rsT_ = (LAS float*)(ldsl + RST_OFF); const int t_ = F.wave * 64 + opq_lane(); const float* sq_ = (const float*)(ws + WS_SSQX);
              if (t_ < 256) {
#pragma unroll 1
                  for (int i_ = 0; i_ < 4; ++i_) { pg8::Unit uu_; if (!S.next(i_, uu_)) break; const f32x4 q_ = *(const f32x4*)(sq_ + ((size_t)uu_.pm * 256 + t_) * 4);
                      rsT_[i_ * 256 + t_] = 1.0f / sqrtf(((q_[0] + q_[1]) + (q_[2] + q_[3])) * (1.f / 1024.f) + EPS); } }
              __syncthreads(); }
            pg8::EpiBf16S<0> E{(bf16*)(ws + WS_P), NP, (const LAS float*)(ldsl + RST_OFF)};
            pg8::gemm_phase<pg8::EpiBf16S<0>, pg8::StaticOrder, PG8_ALIGN, PG8_SP2>(ldsl + RING_OFF, g, S, E, F.wave);
            if (l == 0) { pg8::Unit tmp_; if (!S.next(2, tmp_)) {
                LAS unsigned* qs_ = (LAS unsigned*)(ldsl + MISC_OFF) + 16;
                if (F.wave == 0 && opq_lane() == 0) qs_[0] = __hip_atomic_fetch_add((unsigned*)(ws + WS_CTL) + CW_FILL, 1u, __ATOMIC_RELAXED, __HIP_MEMORY_SCOPE_AGENT);
                __syncthreads();
                const int fu = __builtin_amdgcn_readfirstlane((int)qs_[0]);
                if (fu < CV_UNITS) conv_unit(F, fu, opq_lane()); } }
            SEAM(); PHASE_END(pb + 0); }
        if (IN(pb + 1)) { prep_phase(F, l); SEAM(); if (PROBE_DUP == 1) { prep_phase(F, l); SEAM(); } PHASE_END(pb + 1); }
        if (IN(pb + 2)) { attn_phase(F, l); SEAM(); if (PROBE_DUP == 2) { attn_phase(F, l, 1); SEAM(); } PHASE_END(pb + 2); }
        if (IN(pb + 3)) {
            GAS unsigned char* ws = (GAS unsigned char*)args.ws; OPQ_S(ws);
            pg8::Gemm g{(const bf16*)(ws + WS_Y), (const bf16*)(ws + WS_WO) + (size_t)l * D * D, M, D, D}; pg8::StaticOrder S; S.init(M, D, F.G, (int)blockIdx.x);
            { LAS float* ks_ = (LAS float*)(ldsl + RST_OFF); const int t_ = F.wave * 64 + opq_lane(); pg8::Unit uu_;
              if (t_ < 256 && S.next(0, uu_)) { const float* sq_ = (const float*)(ws + WS_SSQ) + ((size_t)uu_.pm * 256 + t_) * 8; const f32x4 a_ = *(const f32x4*)sq_, b_ = *(const f32x4*)(sq_ + 4);
                  const float v2_ = ((a_[0] + a_[1]) + (a_[2] + a_[3])) * (1.f / 256.f) + EPS, v3_ = ((b_[0] + b_[1]) + (b_[2] + b_[3])) * (1.f / 256.f) + EPS;
                  const float r2_ = 1.0f / sqrtf(v2_), r3_ = 1.0f / sqrtf(v3_);
                  ks_[t_] = sqrtf(v2_); ks_[256 + t_] = r2_ * sqrtf(v3_); ks_[512 + t_] = r3_; }
              __syncthreads(); }
            pg8::EpiResNorm<false, true> E{nullptr, (bf16*)(ws + WS_XB), (float*)(ws + WS_SSQX), D, (const LAS float*)(ldsl + RST_OFF)};
            pg8::gemm_phase<pg8::EpiResNorm<false, true>, pg8::StaticOrder, false, PG8_SP2>(ldsl + RING_OFF, g, S, E, F.wave);
            SEAM(); PHASE_END(pb + 3); }
        if (IN(pb + 4)) {
            GAS unsigned char* ws = (GAS unsigned char*)args.ws; OPQ_S(ws);
            pg8::Gemm g{(const bf16*)(ws + WS_XB), (const bf16*)(ws + WS_W1) + (size_t)l * FF * D, M, FF, D}; pg8::StaticOrder S; S.init(M, FF, F.G, (int)blockIdx.x);
            { LAS float* rsT_ = (LAS float*)(ldsl + RST_OFF); const int t_ = F.wave * 64 + opq_lane(); const float* sq_ = (const float*)(ws + WS_SSQX);
              if (t_ < 256) {
#pragma unroll 1
                  for (int i_ = 0; i_ < 4; ++i_) { pg8::Unit uu_; if (!S.next(i_, uu_)) break; const f32x4 q_ = *(const f32x4*)(sq_ + ((size_t)uu_.pm * 256 + t_) * 4);
                      rsT_[i_ * 256 + t_] = 1.0f / sqrtf(((q_[0] + q_[1]) + (q_[2] + q_[3])) * (1.f / 1024.f) + EPS); } }
              __syncthreads(); }
            pg8::EpiBf16S<2> E{(bf16*)(ws + WS_H), FF, (const LAS float*)(ldsl + RST_OFF)};
            pg8::gemm_phase<pg8::EpiBf16S<2>, pg8::StaticOrder, PG8_ALIGN, PG8_SP2>(ldsl + RING_OFF, g, S, E, F.wave);
            SEAM(); PHASE_END(pb + 4); }
        if (IN(pb + 5)) {
            GAS unsigned char* ws = (GAS unsigned char*)args.ws; OPQ_S(ws);
            pg8::Gemm g{(const bf16*)(ws + WS_H), (const bf16*)(ws + WS_W2) + (size_t)l * D * FF, M, D, FF}; pg8::StaticOrder S; S.init(M, D, F.G, (int)blockIdx.x);
            if (l + 1 < DEPTH) { pg8::EpiResNorm<false> E{nullptr, (bf16*)(ws + WS_XB), (float*)(ws + WS_SSQX), D, nullptr};
                pg8::gemm_phase<pg8::EpiResNorm<false>, pg8::StaticOrder, false, PG8_SP2>(ldsl + RING_OFF, g, S, E, F.wave); SEAM(); PHASE_END(pb + 5); }
            else { pg8::EpiResNorm<true> E{args.out, (bf16*)(ws + WS_XB), nullptr, D, nullptr};
                pg8::gemm_phase<pg8::EpiResNorm<true>, pg8::StaticOrder, false, PG8_SP2>(ldsl + RING_OFF, g, S, E, F.wave); __syncthreads(); PHASE_END(pb + 5); } }
    }
constexpr int NPH = 1 + DEPTH * 6;
__global__ void __launch_bounds__(NWAVES * 64, 2) __attribute__((amdgpu_waves_per_eu(2, 2))) fwd(Args args) {
    extern __shared__ __attribute__((aligned(16))) unsigned char lds[];
    Frame F;
    F.lds = lds; F.wave = __builtin_amdgcn_readfirstlane((int)(threadIdx.x >> 6));
    F.G = gridDim.x; { const int bx = blockIdx.x; F.vcu = (F.G % 8 == 0) ? (bx % 8) * (F.G / 8) + bx / 8 : bx; }
    F.a = (ArgsP)__builtin_amdgcn_kernarg_segment_ptr(); F.ws = (GAS unsigned char*)args.ws;
    for (int u = threadIdx.x; u < (LDS_BYTES - LDSCTL_OFF) / 4; u += NWAVES * 64) ((unsigned*)(lds + LDSCTL_OFF))[u] = 0u;
    __syncthreads();
    XcdBarrier bar; bar.bar = (unsigned*)(args.ws + WS_CTL) + 1024; bar.x = 0; bar.st = nullptr;
    if (MK_ONE_LAUNCH) bar = xcd_barrier_post((unsigned*)(args.ws + WS_CTL) + 1024, (volatile LAS unsigned*)(lds + MISC_OFF) + 8);
    const int lo = args.ph_lo, hi = args.ph_hi;
    LAS unsigned char* ldsl = (LAS unsigned char*)lds;
#ifndef PROBE_DUP
#define PROBE_DUP -1
#endif
    if (PROBE_TIME_MASK != 0u) { if (threadIdx.x == 0) { volatile LAS unsigned long long* T_ = (volatile LAS unsigned long long*)((LAS unsigned char*)lds + MISC_OFF + 128); T_[0] = __builtin_amdgcn_s_memrealtime(); T_[1] = 0ull; T_[2] = __builtin_amdgcn_s_memtime(); T_[3] = 0ull; } }
    if (PROBE_CLK_BIT >= 0 && PROBE_TIME_MASK == 0u) { if (threadIdx.x == 0) { volatile LAS unsigned long long* T_ = (volatile LAS unsigned long long*)((LAS unsigned char*)lds + MISC_OFF + 128); T_[0] = 0ull; T_[1] = 0ull; T_[2] = __builtin_amdgcn_s_memtime(); T_[3] = 0ull; } }
    if (IN(0)) { p0_prologue(F); SEAM(); if (PROBE_DUP == 0) { p0_prologue(F); SEAM(); } PHASE_END(0); }
    for (int l = 0; l < DEPTH; ++l) layer_body(args, F, bar, ldsl, lo, hi, l);
    if (PROBE_TIME_MASK != 0u || PROBE_CLK_BIT >= 0) { if (blockIdx.x == 0 && F.wave == 0 && opq_lane() == 0) { volatile LAS unsigned long long* T_ = (volatile LAS unsigned long long*)((LAS unsigned char*)lds + MISC_OFF + 128); const unsigned long long w_ = 8ull * (T_[1] + (unsigned long long)__hip_atomic_load((unsigned*)(args.ws + WS_CTL) + 9000, __ATOMIC_RELAXED, __HIP_MEMORY_SCOPE_AGENT)) + (PROBE_CLK_BIT >= 0 ? T_[3] / 16ull : 0ull); const unsigned long long t0_ = __builtin_amdgcn_s_memrealtime(); while (__builtin_amdgcn_s_memrealtime() - t0_ < w_) __builtin_amdgcn_s_sleep(8); } }
#undef IN
#undef SEAM
}

extern "C" void kernel_launch(void* const* d_in, const int* in_sizes, int n_in, void* d_out, int out_size, void* d_ws, size_t ws_size, hipStream_t stream) {
    static int grid = 0;
    if (grid == 0) {
        if (n_in != N_INPUTS || in_sizes[0] != M * D || out_size != M * D || ws_size < WS_END) { fprintf(stderr, "kernel_launch: unexpected shapes (n_in %d, in0 %d, out %d, ws %zu); nothing launched\n", n_in, n_in > 0 ? in_sizes[0] : -1, out_size, ws_size); grid = -1; return; }
        int dev = 0, cus = 0, per_cu = 0;
        if (hipGetDevice(&dev) != hipSuccess || hipDeviceGetAttribute(&cus, hipDeviceAttributeMultiprocessorCount, dev) != hipSuccess) { grid = -1; return; }
        if (hipFuncSetAttribute((const void*)fwd, hipFuncAttributeMaxDynamicSharedMemorySize, LDS_BYTES) != hipSuccess) { fprintf(stderr, "kernel_launch: hipFuncSetAttribute failed\n"); grid = -1; return; }
        if (hipOccupancyMaxActiveBlocksPerMultiprocessor(&per_cu, (const void*)fwd, NWAVES * 64, LDS_BYTES) != hipSuccess || per_cu < 1) { fprintf(stderr, "kernel_launch: occupancy query reports %d\n", per_cu); }
        (void)hipGetLastError();
        grid = cus;
        if (grid != 256) { fprintf(stderr, "kernel_launch: built for 256 CUs (one 256x256 unit per workgroup in the N = 1024 GEMM phases), found %d; nothing launched\n", cus); grid = -1; return; }
    }
    if (grid < 0) return;
    if (hipMemsetAsync((char*)d_ws + WS_CTL, 0, CTL_ZERO_BYTES, stream) != hipSuccess) return;
    Args a{};
    for (int i = 0; i < N_INPUTS; ++i) a.in[i] = (const float*)d_in[i];
    a.out = (float*)d_out; a.ws = (unsigned char*)d_ws;
#if MK_ONE_LAUNCH
    a.ph_lo = 0; a.ph_hi = NPH;
    hipLaunchKernelGGL(fwd, dim3(grid), dim3(NWAVES * 64), LDS_BYTES, stream, a);
#else
    for (int p = 0; p < NPH; ++p) { a.ph_lo = p; a.ph_hi = p + 1; hipLaunchKernelGGL(fwd, dim3(grid), dim3(NWAVES * 64), LDS_BYTES, stream, a); }
#endif
}
```

```cpp
#include <hip/hip_runtime.h>
#include <cstdio>
#include <cstdint>
#include <cmath>
namespace pg8 {
#ifndef PROBE_TIME_MASK
#define PROBE_TIME_MASK 0u
#endif
#define PG8_PROBE(k) do { if (PROBE_TIME_MASK != 0u) { if (wid == 0 && lane == 0) { volatile PG8_LAS unsigned long long* T_ = (volatile PG8_LAS unsigned long long*)(lds - lds_base_off_ + 131072 + 320 + 128); const unsigned long long now_ = __builtin_amdgcn_s_memrealtime(); if ((PROBE_TIME_MASK >> (k)) & 1u) T_[1] += now_ - T_[0]; T_[0] = now_; } } } while (0)
#define PG8_LAS __attribute__((address_space(3)))
typedef unsigned short bf16_t;
typedef short bf16x8 __attribute__((ext_vector_type(8)));
typedef float f32x4 __attribute__((ext_vector_type(4)));
typedef unsigned u32x4 __attribute__((ext_vector_type(4)));
constexpr int BM = 256, BK = 64, HALF = 128, HTB = HALF * BK * 2  , STAGE_BYTES = 8 * HTB, NXCD = 8, WGM = 8;

__host__ __device__ __forceinline__ int lds_byte(int r, int c) { const int st = (r >> 4) * 2 + (c >> 5), rr = r & 15, cc = c & 31, ob = rr * 64 + cc * 2; return st * 1024 + (ob ^ (((ob >> 9) & 1) << 5)); }
__host__ __device__ __forceinline__ void stage_rc(int b, int& R, int& C) { const int st = b / 1024, sb = b % 1024, swz = sb ^ (((sb >> 9) & 1) << 5); R = (st >> 1) * 16 + swz / 64; C = (st & 1) * 32 + (swz % 64) / 2; }
__host__ __device__ __forceinline__ int perm32(int rho) { const int n = rho >> 4, i = rho & 15; return 8 * (i >> 2) + 4 * n + (i & 3); }

struct Unit { int pm, pn, idx; };
struct Gemm { const bf16_t* A; const bf16_t* Bt; int M, N, K; };

struct StaticOrder {
    int nM, nN, nwg, G, c;
    __host__ __device__ __forceinline__ void init(int M, int N, int G_, int c_) { nM = M / BM; nN = N / BM; nwg = nM * nN; G = G_; c = c_; }
    __host__ __device__ __forceinline__ bool next(int i, Unit& u) const {
        const long L = (long)i * G + c; if (L >= nwg) return false;
        int wgid = (int)L; { const int q = nwg / NXCD, r = nwg % NXCD, xcd = wgid % NXCD, off = wgid / NXCD; wgid = (xcd < r ? xcd * (q + 1) : r * (q + 1) + (xcd - r) * q) + off; }
        const int nig = WGM * nN, gid = wgid / nig, fm = gid * WGM, gsz = (nM - fm) < WGM ? (nM - fm) : WGM;
        u.pm = fm + ((wgid % nig) % gsz); u.pn = (wgid % nig) / gsz; u.idx = i; return true;
    }
    __device__ __forceinline__ void a_ready(const Unit&) const {}
    __device__ __forceinline__ void done(const Unit&) const {}
};

__device__ __forceinline__ unsigned cvt_pk_bf16(float lo, float hi) { unsigned r; asm volatile("v_cvt_pk_bf16_f32 %0, %1, %2" : "=v"(r) : "v"(lo), "v"(hi)); return r; }
typedef float f32x2 __attribute__((ext_vector_type(2)));
__device__ __forceinline__ f32x2 gelu_pk(f32x2 v) {
    const f32x2 av = __builtin_elementwise_abs(v), d = av * 0.2316418882f + 1.0f;
    f32x2 t; t.x = __builtin_amdgcn_rcpf(d.x); t.y = __builtin_amdgcn_rcpf(d.y);
    f32x2 q = t * 0.5307027145f + (-0.7265760135f); q = q * t + 0.7107068705f; q = q * t + (-0.142248368f); q = q * t + 0.127414796f; q = q * t;
    const f32x2 s = (v * v) * (-0.72134752044f);
    f32x2 e; e.x = __builtin_amdgcn_exp2f(s.x); e.y = __builtin_amdgcn_exp2f(s.y);
    const f32x2 m = v * (q * e), r = v - m;
    f32x2 o; o.x = v.x < 0.f ? m.x : r.x; o.y = v.y < 0.f ? m.y : r.y; return o;
}

template <int ACT  > struct EpiBf16 {
    static constexpr bool PERM = true, AFTER_DRAIN = false; static_assert(ACT == 0 || ACT == 1, "EpiBf16: ACT is 0 (none) or 1 (gelu_pk)");
    bf16_t* O; int ldc; const float* bias; int split_cols; size_t split_stride; float scale0;
    __device__ __forceinline__ void operator()(const f32x4 (&acc)[2][2][4][2], const Unit& u, int wr, int wc, int fr, int fq) const {
        const int row0 = u.pm * BM + wr * 64 + fr; int colt = u.pn * BM; bf16_t* base = O;
        float sc = 1.f; if (split_cols) { const int t = colt / split_cols; base += (size_t)t * split_stride; colt -= t * split_cols; if (t == 0) sc = scale0; }
        const int col0 = colt + wc * 32 + 8 * fq, bcol0 = u.pn * BM + wc * 32 + 8 * fq;
        f32x4 bv[2][2];
#pragma unroll
        for (int bj = 0; bj < 2; ++bj)
#pragma unroll
            for (int n = 0; n < 2; ++n) bv[bj][n] = bias ? *(const f32x4*)(bias + bcol0 + bj * HALF + 4 * n) : (f32x4){0.f, 0.f, 0.f, 0.f};
#pragma unroll
        for (int ai = 0; ai < 2; ++ai)
#pragma unroll
            for (int m = 0; m < 4; ++m) { bf16_t* rowp = base + (size_t)(row0 + ai * HALF + m * 16) * ldc + col0;
#pragma unroll
                for (int bj = 0; bj < 2; ++bj) { f32x4 v0 = acc[ai][bj][m][0] + bv[bj][0], v1 = acc[ai][bj][m][1] + bv[bj][1];
                    if (ACT == 1) { f32x2 a = gelu_pk((f32x2){v0[0], v0[1]}), b = gelu_pk((f32x2){v0[2], v0[3]}), c = gelu_pk((f32x2){v1[0], v1[1]}), d = gelu_pk((f32x2){v1[2], v1[3]});
                        v0 = (f32x4){a.x, a.y, b.x, b.y}; v1 = (f32x4){c.x, c.y, d.x, d.y}; }
                    v0 = v0 * sc; v1 = v1 * sc; u32x4 w; w.x = cvt_pk_bf16(v0[0], v0[1]); w.y = cvt_pk_bf16(v0[2], v0[3]); w.z = cvt_pk_bf16(v1[0], v1[1]); w.w = cvt_pk_bf16(v1[2], v1[3]);
                    *(u32x4*)(rowp + bj * HALF) = w; } }
    }
};

template <class Epi, class Sched, bool ALIGN_EPI = false, bool SP2 = false>
__device__ __forceinline__ void gemm_phase(PG8_LAS unsigned char* lds, const Gemm g, const Sched& S, const Epi& E, const int wave_index) {
    int tid_; asm volatile("v_mbcnt_lo_u32_b32 %0, -1, 0\n\tv_mbcnt_hi_u32_b32 %0, -1, %0" : "=v"(tid_)); tid_ += wave_index * 64;
    const int tid = tid_, wid = __builtin_amdgcn_readfirstlane(tid >> 6), lane = tid & 63, wr = wid >> 2, wc = wid & 3, fr = lane & 15, fq = lane >> 4;
    const int K = g.K, nt = K / BK; constexpr int lds_base_off_ = 0;
    unsigned voffA[2], voffB[2];
#pragma unroll
    for (int i = 0; i < 2; ++i) { int R, C; stage_rc(tid * 16 + i * 8192, R, C); const int Rb = Epi::PERM ? ((R & ~31) + perm32(R & 31)) : R;
        voffA[i] = (unsigned)(R * K + C) * 2u; voffB[i] = (unsigned)(Rb * K + C) * 2u; }
    const size_t kstep = (size_t)(BK * 2);
    const size_t hstep = (size_t)HALF * K * 2;
    const size_t tstep = 2 * hstep;
    const unsigned ldsw = (unsigned)wid * 1024u;
    const int aoff = lds_byte(wr * 64 + fr, fq * 8), boff = lds_byte(wc * 32 + fr, fq * 8);
#define PG8_SA(b, h) (((b) * 2 + (h)) * HTB)
#define PG8_SB(b, h) ((4 + (b) * 2 + (h)) * HTB)
#define PG8_STAGE(bufoff, gbase, voff) do { _Pragma("unroll") for (int _i = 0; _i < 2; ++_i) \
        __builtin_amdgcn_global_load_lds((const unsigned*)((const char*)(gbase) + (voff)[_i]), (PG8_LAS unsigned*)(lds + (bufoff) + ldsw + _i * 8192), 16, 0, 0); } while (0)
#define PG8_LDA(dst, b, h) do { _Pragma("unroll") for (int m = 0; m < 4; ++m) _Pragma("unroll") for (int k = 0; k < 2; ++k) dst[m][k] = *(const PG8_LAS bf16x8*)(lds + PG8_SA(b, h) + aoff + m * 2048 + k * 1024); } while (0)
#define PG8_LDB(dst, b, h) do { _Pragma("unroll") for (int n = 0; n < 2; ++n) _Pragma("unroll") for (int k = 0; k < 2; ++k) dst[n][k] = *(const PG8_LAS bf16x8*)(lds + PG8_SB(b, h) + boff + n * 2048 + k * 1024); } while (0)
#define PG8_MMA(ai, bj, At, Bt) do { __builtin_amdgcn_s_setprio(1); _Pragma("unroll") for (int m = 0; m < 4; ++m) _Pragma("unroll") for (int n = 0; n < 2; ++n) _Pragma("unroll") for (int k = 0; k < 2; ++k) \
        acc[ai][bj][m][n] = __builtin_amdgcn_mfma_f32_16x16x32_bf16(Bt[n][k], At[m][k], acc[ai][bj][m][n], 0, 0, 0); __builtin_amdgcn_s_setprio(0); } while (0)
#define PG8_WAIT_V(n) asm volatile("s_waitcnt vmcnt(" #n ")" ::: "memory")
#define PG8_WAIT_L(n) asm volatile("s_waitcnt lgkmcnt(" #n ")" ::: "memory")
#define PG8_BAR __builtin_amdgcn_s_barrier()
#define PG8_SCHED __builtin_amdgcn_sched_barrier(0)
    Unit cur, nxt; int ui = 0;
    if (!S.next(0, cur)) return;
    f32x4 acc[2][2][4][2];
#pragma unroll
    for (int a = 0; a < 2; ++a)
#pragma unroll
        for (int b = 0; b < 2; ++b)
#pragma unroll
            for (int m = 0; m < 4; ++m)
#pragma unroll
                for (int n = 0; n < 2; ++n) acc[a][b][m][n] = (f32x4){0.f, 0.f, 0.f, 0.f};
    bf16x8 At[4][2], B0[2][2], B1[2][2];
    const char* cA = (const char*)g.A + (size_t)cur.pm * tstep; const char* cB = (const char*)g.Bt + (size_t)cur.pn * tstep;
    S.a_ready(cur);
    if constexpr (SP2) {
        PG8_STAGE(PG8_SB(0, 0), cB, voffB); PG8_STAGE(PG8_SB(0, 1), cB + hstep, voffB); PG8_STAGE(PG8_SA(0, 0), cA, voffA); PG8_STAGE(PG8_SA(0, 1), cA + hstep, voffA);
        if (wr == 1) PG8_BAR;
        PG8_WAIT_V(2); PG8_BAR;
        PG8_STAGE(PG8_SB(1, 0), cB + kstep, voffB); PG8_STAGE(PG8_SA(1, 0), cA + kstep, voffA); PG8_STAGE(PG8_SB(1, 1), cB + hstep + kstep, voffB);
        PG8_WAIT_V(6); PG8_BAR;
    } else {
        PG8_STAGE(PG8_SB(0, 0), cB, voffB); PG8_STAGE(PG8_SA(0, 0), cA, voffA); PG8_STAGE(PG8_SB(0, 1), cB + hstep, voffB); PG8_STAGE(PG8_SA(0, 1), cA + hstep, voffA);
        if (wr == 1) PG8_BAR;
        PG8_WAIT_V(4); PG8_BAR;
        PG8_STAGE(PG8_SB(1, 0), cB + kstep, voffB); PG8_STAGE(PG8_SA(1, 0), cA + kstep, voffA); PG8_STAGE(PG8_SB(1, 1), cB + hstep + kstep, voffB);
        PG8_WAIT_V(6); PG8_BAR;
    }
    for (;;) {
        const bool has_next = S.next(ui + 1, nxt);
        const char* nA = has_next ? (const char*)g.A + (size_t)nxt.pm * tstep : cA; const char* nB = has_next ? (const char*)g.Bt + (size_t)nxt.pn * tstep : cB;
        for (int t = 0; t < nt; t += 2) {
            const bool last = (t == nt - 2);
            const char* a1 = cA + (size_t)(t + 1) * kstep;
            const char* a2 = last ? nA : cA + (size_t)(t + 2) * kstep; const char* b2 = last ? nB : cB + (size_t)(t + 2) * kstep;
            const char* a3 = a2 + kstep; const char* b3 = b2 + kstep;
            if (last && has_next) S.a_ready(nxt);
            if constexpr (SP2) {
            PG8_LDB(B0, 0, 0); PG8_LDB(B1, 0, 1); PG8_SCHED; PG8_LDA(At, 0, 0); PG8_STAGE(PG8_SA(1, 1), a1 + hstep, voffA);
            PG8_WAIT_V(8); PG8_WAIT_L(0); PG8_BAR; PG8_MMA(0, 0, At, B0); PG8_MMA(0, 1, At, B1); PG8_BAR; PG8_SCHED;
            PG8_LDA(At, 0, 1); PG8_STAGE(PG8_SB(0, 0), b2, voffB); PG8_STAGE(PG8_SB(0, 1), b2 + hstep, voffB); PG8_STAGE(PG8_SA(0, 0), a2, voffA);
            PG8_WAIT_V(8); PG8_WAIT_L(0); PG8_BAR; PG8_MMA(1, 0, At, B0); PG8_MMA(1, 1, At, B1); PG8_BAR; PG8_SCHED;
            PG8_LDB(B0, 1, 0); PG8_LDB(B1, 1, 1); PG8_SCHED; PG8_LDA(At, 1, 0); PG8_STAGE(PG8_SA(0, 1), a2 + hstep, voffA);
            PG8_WAIT_V(8); PG8_WAIT_L(0); PG8_BAR; PG8_MMA(0, 0, At, B0); PG8_MMA(0, 1, At, B1); PG8_BAR; PG8_SCHED;
            PG8_LDA(At, 1, 1); PG8_STAGE(PG8_SB(1, 0), b3, voffB); PG8_STAGE(PG8_SB(1, 1), b3 + hstep, voffB); PG8_STAGE(PG8_SA(1, 0), a3, voffA);
            PG8_WAIT_V(8); PG8_WAIT_L(0); PG8_BAR; PG8_MMA(1, 0, At, B0); PG8_MMA(1, 1, At, B1); PG8_BAR; PG8_SCHED;
            if constexpr (Epi::KSCALE) { if (t + 2 == 8 || t + 2 == 12) E.kscale(acc, t + 2 == 8 ? 0 : 1, wr, fr); }
            } else {
            PG8_LDB(B0, 0, 0); PG8_SCHED; PG8_LDA(At, 0, 0); PG8_STAGE(PG8_SA(1, 1), a1 + hstep, voffA);
            PG8_WAIT_L(8); PG8_BAR; PG8_WAIT_L(0); PG8_MMA(0, 0, At, B0); PG8_BAR; PG8_SCHED;
            PG8_LDB(B1, 0, 1); PG8_STAGE(PG8_SB(0, 0), b2, voffB);
            PG8_BAR; PG8_WAIT_L(0); PG8_MMA(0, 1, At, B1); PG8_BAR;
            PG8_LDA(At, 0, 1); PG8_STAGE(PG8_SA(0, 0), a2, voffA);
            PG8_BAR; PG8_WAIT_L(0); PG8_MMA(1, 0, At, B0); PG8_BAR; PG8_SCHED;
            PG8_STAGE(PG8_SB(0, 1), b2 + hstep, voffB);
            PG8_WAIT_V(6); PG8_BAR; PG8_MMA(1, 1, At, B1); PG8_BAR;
            PG8_LDB(B0, 1, 0); PG8_SCHED; PG8_LDA(At, 1, 0); PG8_STAGE(PG8_SA(0, 1), a2 + hstep, voffA);
            PG8_WAIT_L(8); PG8_BAR; PG8_WAIT_L(0); PG8_MMA(0, 0, At, B0); PG8_BAR; PG8_SCHED;
            PG8_LDB(B1, 1, 1); PG8_STAGE(PG8_SB(1, 0), b3, voffB);
            PG8_BAR; PG8_WAIT_L(0); PG8_MMA(0, 1, At, B1); PG8_BAR;
            PG8_LDA(At, 1, 1); PG8_STAGE(PG8_SA(1, 0), a3, voffA);
            PG8_BAR; PG8_WAIT_L(0); PG8_MMA(1, 0, At, B0); PG8_BAR; PG8_SCHED;
            PG8_STAGE(PG8_SB(1, 1), b3 + hstep, voffB);
            PG8_WAIT_V(6); PG8_BAR; PG8_MMA(1, 1, At, B1); PG8_BAR;
            }
        }
        if constexpr (ALIGN_EPI) { if (wr == 0) PG8_BAR; }
        if constexpr (!Epi::AFTER_DRAIN) { PG8_PROBE(30); E(acc, cur, wr, wc, fr, fq); S.done(cur); PG8_PROBE(31); }
        if (!has_next) break;
#pragma unroll
        for (int a = 0; a < 2; ++a)
#pragma unroll
            for (int b = 0; b < 2; ++b)
#pragma unroll
                for (int m = 0; m < 4; ++m)
#pragma unroll
                    for (int n = 0; n < 2; ++n) acc[a][b][m][n] = (f32x4){0.f, 0.f, 0.f, 0.f};
        cur = nxt; cA = nA; cB = nB; ++ui;
        if constexpr (ALIGN_EPI) { if (wr == 1) PG8_BAR; }
    }
    PG8_WAIT_V(0);
    if constexpr (!ALIGN_EPI) { if (wr == 0) PG8_BAR; }
    PG8_BAR;
    if constexpr (Epi::AFTER_DRAIN) { E.fused(acc, cur, wr, wc, fr, fq, lds, wid, lane); S.done(cur); }
#undef PG8_SA
#undef PG8_SB
#undef PG8_STAGE
#undef PG8_LDA
#undef PG8_LDB
#undef PG8_MMA
#undef PG8_WAIT_V
#undef PG8_WAIT_L
#undef PG8_BAR
#undef PG8_SCHED
}
}

#ifndef PG8_SP2
#define PG8_SP2 true
#endif
#ifndef PG8_ALIGN
#define PG8_ALIGN true
#endif
namespace pg8 {
template <int ACT> struct EpiBf16S {
    static constexpr bool PERM = true, AFTER_DRAIN = false, KSCALE = false;
    bf16_t* O; int ldc; const PG8_LAS float* rsT;
    __device__ __forceinline__ void operator()(const f32x4 (&acc)[2][2][4][2], const Unit& u, int wr, int wc, int fr, int fq) const {
        const int row0 = u.pm * BM + wr * 64 + fr, col0 = u.pn * BM + wc * 32 + 8 * fq;
        const PG8_LAS float* rs = rsT + u.idx * 256 + wr * 64 + fr;
#pragma unroll
        for (int ai = 0; ai < 2; ++ai)
#pragma unroll
            for (int m = 0; m < 4; ++m) { const int r = row0 + ai * HALF + m * 16; const float s = rs[ai * HALF + m * 16]; bf16_t* rowp = O + (size_t)r * ldc + col0;
#pragma unroll
                for (int bj = 0; bj < 2; ++bj) { f32x4 v0 = acc[ai][bj][m][0] * s, v1 = acc[ai][bj][m][1] * s;
                    if (ACT == 2) {
#pragma unroll
                        for (int e = 0; e < 4; ++e) { const float a = fmaxf(v0[e], 0.f), b = fmaxf(v1[e], 0.f); v0[e] = a * a; v1[e] = b * b; } }
                    u32x4 w; w.x = cvt_pk_bf16(v0[0], v0[1]); w.y = cvt_pk_bf16(v0[2], v0[3]); w.z = cvt_pk_bf16(v1[0], v1[1]); w.w = cvt_pk_bf16(v1[2], v1[3]);
                    *(u32x4*)(rowp + bj * HALF) = w; } }
    }
};
template <bool F32OUT, bool GN = false> struct EpiResNorm {
    static constexpr bool PERM = false, AFTER_DRAIN = true, KSCALE = GN;
    float* out; bf16_t* xb; float* ssq4; int ldc; const PG8_LAS float* ks;
    __device__ __forceinline__ void kscale(f32x4 (&acc)[2][2][4][2], int which, int wr, int fr) const {
        const PG8_LAS float* kp = ks + which * 256 + wr * 64 + fr;
        float fk[2][4];
#pragma unroll
        for (int ai = 0; ai < 2; ++ai)
#pragma unroll
            for (int m = 0; m < 4; ++m) fk[ai][m] = kp[ai * HALF + m * 16];
#pragma unroll
        for (int ai = 0; ai < 2; ++ai)
#pragma unroll
            for (int m = 0; m < 4; ++m)
#pragma unroll
                for (int bj = 0; bj < 2; ++bj)
#pragma unroll
                    for (int n = 0; n < 2; ++n) acc[ai][bj][m][n] *= fk[ai][m];
    }
    __device__ __forceinline__ void fused(f32x4 (&acc)[2][2][4][2], const Unit& u, int wr, int wc, int fr, int fq, PG8_LAS unsigned char* lds, int wid, int lane) const {
        PG8_LAS float* Pss = (PG8_LAS float*)lds;
        const int col0 = u.pn * BM + wc * 32 + 4 * fq;
        if (GN) kscale(acc, 2, wr, fr);
#pragma unroll
        for (int ai = 0; ai < 2; ++ai) {
            uint2 bs[4][2][2];
#pragma unroll
            for (int m = 0; m < 4; ++m) { const size_t off = (size_t)(u.pm * BM + ai * HALF + wr * 64 + m * 16 + fr) * ldc + col0;
#pragma unroll
                for (int bj = 0; bj < 2; ++bj)
#pragma unroll
                    for (int n = 0; n < 2; ++n) bs[m][bj][n] = *(const uint2*)(xb + off + bj * HALF + n * 16); }
#pragma unroll
            for (int m = 0; m < 4; ++m) { const int r = ai * HALF + wr * 64 + m * 16 + fr; const size_t off = (size_t)(u.pm * BM + r) * ldc + col0; float s = 0.f;
#pragma unroll
                for (int bj = 0; bj < 2; ++bj)
#pragma unroll
                    for (int n = 0; n < 2; ++n) { const uint2 b2 = bs[m][bj][n];
                        const f32x4 bsv = (f32x4){__uint_as_float(b2.x << 16), __uint_as_float(b2.x & 0xffff0000u), __uint_as_float(b2.y << 16), __uint_as_float(b2.y & 0xffff0000u)};
                        const f32x4 o = bsv + acc[ai][bj][m][n];
                        if (F32OUT) *(f32x4*)(out + off + bj * HALF + n * 16) = o;
                        else { uint2 w; w.x = cvt_pk_bf16(o[0], o[1]); w.y = cvt_pk_bf16(o[2], o[3]); *(uint2*)(xb + off + bj * HALF + n * 16) = w; s += (o[0] * o[0] + o[1] * o[1]) + (o[2] * o[2] + o[3] * o[3]); } }
                if (!F32OUT) { s += __shfl_xor(s, 16); s += __shfl_xor(s, 32); if (fq == 0) Pss[r * 4 + wc] = s; } }
            asm volatile("" ::: "memory");
        }
        if (!F32OUT) { asm volatile("s_waitcnt lgkmcnt(0)" ::: "memory"); __builtin_amdgcn_s_barrier(); asm volatile("" ::: "memory");
            const int t = wid * 64 + lane;
            if (t < 256) { const f32x4 p = *(const PG8_LAS f32x4*)(Pss + 4 * t); ssq4[(size_t)(u.pm * BM + t) * 4 + u.pn] = (p[0] + p[1]) + (p[2] + p[3]); } }
    }
};
}
#define GAS __attribute__((address_space(1)))
#define LAS __attribute__((address_space(3)))
typedef unsigned short bf16;
typedef unsigned v4u __attribute__((ext_vector_type(4)));
typedef float f32x4 __attribute__((ext_vector_type(4)));
typedef short bf16x8 __attribute__((ext_vector_type(8)));
typedef GAS unsigned gu32;
typedef GAS unsigned long long gu64;
#define RLX_AGENT __ATOMIC_RELAXED, __HIP_MEMORY_SCOPE_AGENT
#define LDS_WAIT() asm volatile("s_waitcnt lgkmcnt(0)" ::: "memory")
#define VM_WAIT() asm volatile("s_waitcnt vmcnt(0)" ::: "memory")
__device__ __forceinline__ unsigned long long rt() { return __builtin_amdgcn_s_memrealtime(); }
__device__ __forceinline__ unsigned f2bf(float f) { unsigned u = __builtin_bit_cast(unsigned, f); return (u + 0x7fffu + ((u >> 16) & 1u)) >> 16; }
__device__ __forceinline__ unsigned pk2(float lo, float hi) { return f2bf(lo) | (f2bf(hi) << 16); }

#define XB_TMO      128
#define XB_XCNT(j)  (256  + 64 * (j))
#define XB_XSUB(j)  (1280 + 64 * (j))
#define XB_XGEN(j)  (2304 + 64 * (j))
#define XB_TOP      3328
#define XB_TOPGEN   3392
#define XCD_BAR_WORDS 3456
#define XB_SPIN_CAP (1u << 18)

__device__ __forceinline__ unsigned xb_ld(unsigned* p)              { return __hip_atomic_load(p, __ATOMIC_RELAXED, __HIP_MEMORY_SCOPE_AGENT); }
__device__ __forceinline__ unsigned xb_add(unsigned* p, unsigned v) { return __hip_atomic_fetch_add(p, v, __ATOMIC_RELAXED, __HIP_MEMORY_SCOPE_AGENT); }
__device__ __forceinline__ unsigned xb_xcc_id() { return (unsigned)__builtin_amdgcn_s_getreg((3 << 11) | 20) & 0xFu; }
#define XB_SPIN(cond, bar) do { unsigned _sp = 0; while (cond) { __builtin_amdgcn_s_sleep(1); \
    if ((++_sp & 255u) == 0u) { if (xb_ld(&(bar)[XB_TMO])) break; if (_sp > XB_SPIN_CAP) { atomicAdd(&(bar)[XB_TMO], 1u); break; } } } } while (0)

struct XcdBarrier {
    unsigned* bar; unsigned x;
    volatile LAS unsigned* st;
};

__device__ __forceinline__ XcdBarrier xcd_barrier_post(unsigned* bar, volatile LAS unsigned* st) {
    XcdBarrier b; b.bar = bar; b.x = xb_xcc_id(); b.st = st;
    if (threadIdx.x == 0) (void)xb_add(&bar[XB_XCNT(b.x)], 1u);
    return b;
}
__device__ __forceinline__ void xcd_barrier_complete(unsigned* bar, unsigned x, unsigned& nloc, unsigned& nx) {
    const unsigned G = gridDim.x * gridDim.y * gridDim.z;
    unsigned sum, cnt, mine, sp = 0u;
    for (;;) {
        sum = 0u; cnt = 0u; mine = 0u;
#pragma unroll
        for (unsigned j = 0; j < 16; ++j) { const unsigned c = xb_ld(&bar[XB_XCNT(j)]); sum += c; cnt += (c > 0u) ? 1u : 0u; mine = (j == x) ? c : mine; }
        if (sum == G) break;
        __builtin_amdgcn_s_sleep(1);
        if ((++sp & 255u) == 0u) { if (xb_ld(&bar[XB_TMO])) break; if (sp > XB_SPIN_CAP) { atomicAdd(&bar[XB_TMO], 1u); break; } }
    }
    nloc = mine > 0u ? mine : 1u; nx = cnt > 0u ? cnt : 1u;
}

__device__ __forceinline__ void xcd_barrier(const XcdBarrier& b, const bool leader  ) {
    asm volatile("s_waitcnt vmcnt(0)" ::: "memory");
    __syncthreads();
    if (leader) {
        unsigned* bar = b.bar;
        __builtin_amdgcn_s_waitcnt(0);
        unsigned nloc = b.st[0], nx = b.st[1];
        if (nloc == 0u) { xcd_barrier_complete(bar, b.x, nloc, nx); b.st[0] = nloc; b.st[1] = nx; }
        const unsigned old = xb_add(&bar[XB_XSUB(b.x)], 1u);
        const unsigned gen = old / nloc;
        if (old + 1u == (gen + 1u) * nloc) {
            __builtin_amdgcn_fence(__ATOMIC_RELEASE, "agent");
            asm volatile("s_waitcnt vmcnt(0)" ::: "memory");
            const unsigned og = xb_add(&bar[XB_TOP], 1u);
            const unsigned tg = og / nx;
            if (og + 1u == (tg + 1u) * nx) xb_add(&bar[XB_TOPGEN], 1u);
            else XB_SPIN(xb_ld(&bar[XB_TOPGEN]) == tg, bar);
            __builtin_amdgcn_fence(__ATOMIC_ACQUIRE, "agent");
            xb_add(&bar[XB_XGEN(b.x)], 1u);
            asm volatile("s_waitcnt vmcnt(0)" ::: "memory");
        } else {
            XB_SPIN(xb_ld(&bar[XB_XGEN(b.x)]) == gen, bar);
            __builtin_amdgcn_fence(__ATOMIC_ACQUIRE, "agent");
            asm volatile("s_waitcnt vmcnt(0)" ::: "memory");
        }
    }
    __syncthreads();
}
constexpr int NWAVES = 8;
#ifndef MK_ONE_LAUNCH
#define MK_ONE_LAUNCH 1
#endif
constexpr int BATCH = 8, SEQ = 2048, D = 1024, M = BATCH * SEQ, DEPTH = 2, FF = 4096, NIN = 2540, NP = 2560;
constexpr int NCMP = 127;
constexpr float EPS = 1e-6f;
constexpr float LOG2E = 1.4426950408889634f;
constexpr int CW_FILL = 8192 + 512;
constexpr int CW_QUEUE = 8192;
constexpr int C_AB = 0, C_AC = 256, C_AU = 512, C_NQ = 768, C_KC = 1024, C_VC = 1088, C_KS = 1152, C_VS = 1216, C_KW = 1280, C_VW = 1344,
              C_CQ = 1408, C_CKV = 1600, C_KR = 1728, C_SQ = 1760, C_SK = 2016, C_SV = 2272, C_NG = 2528;
constexpr int NQKV = 896;
enum { I_X = 0, I_RELB, I_N1W, I_WIN, I_CONVW, I_CONVB, I_NQN, I_NKN, I_CPOS, I_CW1, I_CW2, I_QAN, I_KVN, I_WQB, I_WKVB, I_MQN, I_MKN, I_ONW, I_WOUT, I_N2W, I_FW1, I_FW2, N_INPUTS };
constexpr size_t MiB = 1u << 20;
constexpr size_t WS_CTL = 0, CTL_ZERO_BYTES = 64 * 1024;
constexpr size_t WS_ROPE = 1 * MiB;
constexpr size_t WS_TB = WS_ROPE + 262144;
constexpr size_t WS_CB1 = WS_TB + 4096;
constexpr size_t WS_KCV = WS_CB1 + 65536;
constexpr size_t WS_SSQ = 240 * MiB;
constexpr size_t WS_WIN = 2 * MiB, WS_WO = 16 * MiB, WS_W1 = 20 * MiB, WS_W2 = 36 * MiB;
constexpr size_t OUT_QM = 0, OUT_KM = 12 * MiB, OUT_VM = 24 * MiB;
constexpr size_t WS_WQF = 88 * MiB  , WS_WKVF = WS_WQF + 512 * 1024  , WS_QKV = 208 * MiB  ;
constexpr size_t WS_W1C = 84 * MiB, WS_KS = 92 * MiB, WS_KW = 94 * MiB;
constexpr size_t WS_XB = 52 * MiB  , WS_SSQX = WS_KCV + 262144  , WS_P = 128 * MiB, WS_Y = 96 * MiB, WS_H = 128 * MiB, WS_END = 256 * MiB;
static_assert(WS_KCV + 262144 <= WS_WIN && WS_SSQ + (size_t)M * 8 * 4 <= WS_END && WS_P + (size_t)M * NP * 2 <= WS_SSQ && WS_KW + (size_t)M * 64 * 2 <= WS_Y && WS_XB + (size_t)M * D * 2 <= WS_W1C && WS_Y + (size_t)M * D * 2 <= WS_P && WS_SSQX + (size_t)M * 16 <= WS_WIN, "d_ws map");
constexpr int RING_OFF = 0, RING_BYTES = 131072;
constexpr int LDSCTL_OFF = RING_BYTES, MISC_OFF = LDSCTL_OFF + 320, TB_OFF = RING_BYTES + 1024;
constexpr int RST_OFF = TB_OFF + 2048;
constexpr int LDS_BYTES = 147456;
constexpr int TBH_OFF = RST_OFF + 4096;
constexpr int GWT_OFF = TBH_OFF + 4096;
static_assert(GWT_OFF + 1024 <= LDS_BYTES, "LDS map");

typedef unsigned short bf16;
struct Args { const float* in[N_INPUTS]; float* out; unsigned char* ws; int ph_lo, ph_hi; };
struct ArgsG { const GAS float* in[N_INPUTS]; GAS float* out; GAS unsigned char* ws; int ph_lo, ph_hi; };
static_assert(sizeof(ArgsG) == sizeof(Args), "same layout");
typedef const __attribute__((address_space(4))) ArgsG* ArgsP;
#define OPQ_V(x) asm volatile("" : "+v"(x))
template <class T> __device__ __forceinline__ T opq_ptr(T p) { const unsigned long long u = (unsigned long long)p; unsigned lo = (unsigned)__builtin_amdgcn_readfirstlane((int)(unsigned)u), hi = (unsigned)__builtin_amdgcn_readfirstlane((int)(unsigned)(u >> 32));
    asm volatile("" : "+s"(lo), "+s"(hi)); return (T)(((unsigned long long)hi << 32) | lo); }
#define OPQ_S(x) ((x) = opq_ptr(x))

__device__ __forceinline__ float wsum(float v) {
#pragma unroll
    for (int o = 1; o < 64; o <<= 1) v += __shfl_xor(v, o);
    return v;
}
__device__ __forceinline__ float wmaxf(float v) {
#pragma unroll
    for (int o = 1; o < 64; o <<= 1) v = fmaxf(v, __shfl_xor(v, o));
    return v;
}
__device__ __forceinline__ float bf2f(bf16 b) { return __uint_as_float((unsigned)b << 16); }
__device__ __forceinline__ float bflo(unsigned w) { return __uint_as_float(w << 16); }
__device__ __forceinline__ float bfhi(unsigned w) { return __uint_as_float(w & 0xffff0000u); }
__device__ __forceinline__ bf16 f2b(float f) { return (bf16)f2bf(f); }

__device__ __forceinline__ int opq_lane() { int l; asm volatile("v_mbcnt_lo_u32_b32 %0, -1, 0\n\tv_mbcnt_hi_u32_b32 %0, -1, %0" : "=v"(l)); return l; }
struct Frame {
    unsigned char* lds; int wave, vcu, G;
    ArgsP a; GAS unsigned char* ws;
};

namespace att {
typedef float f32x16 __attribute__((ext_vector_type(16)));
typedef short s16x4 __attribute__((ext_vector_type(4)));
typedef short v4i16_t __attribute__((ext_vector_type(4)));
typedef float f32x2_t __attribute__((ext_vector_type(2)));
typedef __bf16 bf16x2_t __attribute__((ext_vector_type(2)));
#define MFMA32(a, b, c) __builtin_amdgcn_mfma_f32_32x32x16_bf16((a), (b), (c), 0, 0, 0)
constexpr int PVB = 144;
constexpr int TBUF = 24576;
constexpr int KOFF = 0, VOFF = 12288;
constexpr float L2E = 1.4426950408889634f;
constexpr float NEG_INF = -INFINITY;
__device__ __forceinline__ int crow(int r, int h) { return (r & 3) + 8 * (r >> 2) + 4 * h; }
__device__ __forceinline__ unsigned cvtpk(float lo, float hi) { f32x2_t v = {lo, hi}; bf16x2_t b = __builtin_convertvector(v, bf16x2_t); return __builtin_bit_cast(unsigned, b); }
__device__ __forceinline__ float ex2(float x) { return __builtin_amdgcn_exp2f(x); }
__device__ __forceinline__ float lg2(float x) { return __builtin_amdgcn_logf(x); }
__device__ __forceinline__ float sigm(float x) { const float e = __builtin_amdgcn_exp2f(-x * 1.4426950408889634f); float d; asm volatile("s_nop 1\n\tv_add_f32_e32 %0, 1.0, %1" : "=v"(d) : "v"(e));     return __builtin_amdgcn_rcpf(d); }
__device__ __forceinline__ float xhalf(float x, int h) { const auto r = __builtin_amdgcn_permlane32_swap(__float_as_uint(x), __float_as_uint(x), false, false); return __uint_as_float(h ? r[0] : r[1]); }
__device__ __forceinline__ float xh_sum(float x) { const auto r = __builtin_amdgcn_permlane32_swap(__float_as_uint(x), __float_as_uint(x), false, false); return __uint_as_float(r[0]) + __uint_as_float(r[1]); }
__device__ __forceinline__ float xh_max(float x) { const auto r = __builtin_amdgcn_permlane32_swap(__float_as_uint(x), __float_as_uint(x), false, false); return fmaxf(__uint_as_float(r[0]), __uint_as_float(r[1])); }
__device__ __forceinline__ bf16x8 packfrag(const f32x16& p, int s) {
    v4u w; w.x = cvtpk(p[8 * s], p[8 * s + 1]); w.y = cvtpk(p[8 * s + 2], p[8 * s + 3]); w.z = cvtpk(p[8 * s + 4], p[8 * s + 5]); w.w = cvtpk(p[8 * s + 6], p[8 * s + 7]);
    return __builtin_bit_cast(bf16x8, w);
}
struct TileRegs { v4u k0, k1, v; };
template <int DK> __device__ __forceinline__ void tile_issue(TileRegs& R, const bf16* Kg, int kpitch, const bf16* Vg, int vpitch, int tid) {
    R.k0 = *(const v4u*)(Kg + (size_t)(tid & 63) * kpitch + (tid >> 6) * 8);
    if (DK == 96) { if (tid < 256) R.k1 = *(const v4u*)(Kg + (size_t)(tid & 63) * kpitch + (8 + (tid >> 6)) * 8); }
    R.v = *(const v4u*)(Vg + (size_t)(tid >> 3) * vpitch + (tid & 7) * 8);
}
template <int DK> __device__ __forceinline__ void tile_commit(const TileRegs& R, LAS unsigned char* buf, int tid) {
    *(LAS v4u*)(buf + KOFF + (tid >> 6) * 1024 + (tid & 63) * 16) = R.k0;
    if (DK == 96) { if (tid < 256) *(LAS v4u*)(buf + KOFF + (8 + (tid >> 6)) * 1024 + (tid & 63) * 16) = R.k1; }
    *(LAS v4u*)(buf + VOFF + (tid >> 3) * PVB + (tid & 7) * 16) = R.v;
}
template <int DK> __device__ __forceinline__ void qk(f32x16& p0, f32x16& p1, const LAS unsigned char* buf, const bf16x8* qf, int r32, int h) {
    const LAS unsigned char* kb = buf + KOFF + h * 1024 + r32 * 16;
    bf16x8 a0[DK / 16], a1[DK / 16];
#pragma unroll
    for (int s = 0; s < DK / 16; ++s) { a0[s] = *(const LAS bf16x8*)(kb + s * 2048); a1[s] = *(const LAS bf16x8*)(kb + s * 2048 + 512); }
#pragma unroll
    for (int s = 0; s < DK / 16; ++s) { p0 = MFMA32(a0[s], qf[s], p0); p1 = MFMA32(a1[s], qf[s], p1); }
}
__device__ __forceinline__ void pv(f32x16& o0, f32x16& o1, const LAS unsigned char* buf, const bf16x8 (&pf)[4], int lane) {
    const int h = lane >> 5, blk = (lane >> 4) & 1, q4 = (lane & 15) >> 2, p = lane & 3;
    const LAS unsigned char* vb = buf + VOFF + (4 * h + q4) * PVB + (16 * blk + 4 * p) * 2;
    s16x4 lo[4][2], hi[4][2];
#pragma unroll
    for (int s = 0; s < 4; ++s)
#pragma unroll
        for (int c = 0; c < 2; ++c) {
            lo[s][c] = __builtin_bit_cast(s16x4, __builtin_amdgcn_ds_read_tr16_b64_v4i16((LAS v4i16_t*)(vb + (16 * s) * PVB + c * 64)));
            hi[s][c] = __builtin_bit_cast(s16x4, __builtin_amdgcn_ds_read_tr16_b64_v4i16((LAS v4i16_t*)(vb + (16 * s + 8) * PVB + c * 64))); }
#pragma unroll
    for (int s = 0; s < 4; ++s) {
        const bf16x8 v0 = (bf16x8){lo[s][0][0], lo[s][0][1], lo[s][0][2], lo[s][0][3], hi[s][0][0], hi[s][0][1], hi[s][0][2], hi[s][0][3]};
        const bf16x8 v1 = (bf16x8){lo[s][1][0], lo[s][1][1], lo[s][1][2], lo[s][1][3], hi[s][1][0], hi[s][1][1], hi[s][1][2], hi[s][1][3]};
        o0 = MFMA32(v0, pf[s], o0); o1 = MFMA32(v1, pf[s], o1);
    }
}
__device__ __forceinline__ float max16(const f32x16& p) {
    float r;
    asm volatile("s_nop 15\n\ts_nop 7\n\tv_max3_f32 %0, %1, %2, %3\n\tv_max3_f32 %0, %0, %4, %5\n\tv_max3_f32 %0, %0, %6, %7\n\tv_max3_f32 %0, %0, %8, %9\n\t"
                 "v_max3_f32 %0, %0, %10, %11\n\tv_max3_f32 %0, %0, %12, %13\n\tv_max3_f32 %0, %0, %14, %15\n\tv_max_f32_e32 %0, %0, %16"
                 : "=&v"(r) : "v"(p[0]), "v"(p[1]), "v"(p[2]), "v"(p[3]), "v"(p[4]), "v"(p[5]), "v"(p[6]), "v"(p[7]), "v"(p[8]), "v"(p[9]), "v"(p[10]), "v"(p[11]), "v"(p[12]), "v"(p[13]), "v"(p[14]), "v"(p[15]));
    return r;
}
__device__ __forceinline__ float max32(const f32x16& p0, const f32x16& p1) { const float a = max16(p0), b = max16(p1); return fmaxf(a, b); }
typedef float f32x2p __attribute__((ext_vector_type(2)));
__device__ __forceinline__ void softmax_step(f32x16& p0, f32x16& p1, float& m, float& l, f32x16& o0, f32x16& o1) {
    float mx = max32(p0, p1); mx = xh_max(mx);
    const float mn = fmaxf(m, mx), mu = (mn == NEG_INF) ? 0.f : mn, f = ex2(m - mu);
    const f32x2p nmu = {-mu, -mu}; f32x2p s2 = {0.f, 0.f};
#pragma unroll
    for (int r = 0; r < 16; r += 2) { f32x2p a = (f32x2p){p0[r], p0[r + 1]} + nmu, b = (f32x2p){p1[r], p1[r + 1]} + nmu;
        a.x = ex2(a.x); a.y = ex2(a.y); b.x = ex2(b.x); b.y = ex2(b.y); s2 += a; s2 += b; p0[r] = a.x; p0[r + 1] = a.y; p1[r] = b.x; p1[r + 1] = b.y; }
    l = l * f + (s2.x + s2.y); m = mn;
    if (__any(f != 1.0f)) { const f32x2p f2 = {f, f};
#pragma unroll
        for (int r = 0; r < 16; r += 2) { const f32x2p a = (f32x2p){o0[r], o0[r + 1]} * f2, b = (f32x2p){o1[r], o1[r + 1]} * f2; o0[r] = a.x; o0[r + 1] = a.y; o1[r] = b.x; o1[r + 1] = b.y; } }
}
__device__ __forceinline__ void pack_pv(f32x16& o0, f32x16& o1, const f32x16& p0, const f32x16& p1, const LAS unsigned char* buf, int lane) {
    bf16x8 pf[4]; pf[0] = packfrag(p0, 0); pf[1] = packfrag(p0, 1); pf[2] = packfrag(p1, 0); pf[3] = packfrag(p1, 1);
    pv(o0, o1, buf, pf, lane);
}
__device__ __forceinline__ void store_o(bf16* yrow, const f32x16& o0, const f32x16& o1, int h) {
#pragma unroll
    for (int g = 0; g < 4; ++g) {
        uint2 w0; w0.x = cvtpk(o0[4 * g], o0[4 * g + 1]); w0.y = cvtpk(o0[4 * g + 2], o0[4 * g + 3]); *(uint2*)(yrow + 8 * g + 4 * h) = w0;
        uint2 w1; w1.x = cvtpk(o1[4 * g], o1[4 * g + 1]); w1.y = cvtpk(o1[4 * g + 2], o1[4 * g + 3]); *(uint2*)(yrow + 32 + 8 * g + 4 * h) = w1;
    }
}
__device__ __forceinline__ float sumsq(const f32x16& o0, const f32x16& o1) {
    float s = 0.f;
#pragma unroll
    for (int r = 0; r < 16; ++r) s += o0[r] * o0[r] + o1[r] * o1[r];
    return s;
}

struct SmState { float m, l; f32x16 o0, o1; };
#define RBAR() asm volatile("s_waitcnt lgkmcnt(0)\n\ts_barrier" ::: "memory")
__device__ __forceinline__ void mla_step(int kt, int NT, int ktd, int R0, const bf16* Kg, const bf16* Vg, const bf16x8 (&qf)[6], SmState& st, const TileRegs& Rc, TileRegs& Ri, LAS unsigned char* lds, int tid, int lane, int r32, int h) {
    const LAS unsigned char* cur = lds + (kt & 1) * TBUF;
    if (kt + 2 < NT) tile_issue<96>(Ri, Kg + (size_t)(kt + 2) * 64 * 384, 384, Vg + (size_t)(kt + 2) * 64 * 256, 256, tid);
    if (kt <= ktd) {
        f32x16 p0 = {}, p1 = {};
        qk<96>(p0, p1, cur, qf, r32, h);
        if (kt == ktd) { const int trel = R0 + r32 - 64 * kt;
#pragma unroll
            for (int r = 0; r < 16; ++r) { const int kk = crow(r, h); if (kk > trel) p0[r] = NEG_INF; if (kk + 32 > trel) p1[r] = NEG_INF; } }
        softmax_step(p0, p1, st.m, st.l, st.o0, st.o1);
        pack_pv(st.o0, st.o1, p0, p1, cur, lane);
    }
    if (kt + 1 < NT) tile_commit<96>(Rc, lds + ((kt + 1) & 1) * TBUF, tid);
    RBAR();
}
__device__ __forceinline__ void mla_unit(int b, int hd, int qb, const bf16* QM, const bf16* KM, const bf16* VM, bf16* Y, float* SSQ, LAS unsigned char* lds, int tid) {
    OPQ_V(tid);
    const int lane = tid & 63, w = __builtin_amdgcn_readfirstlane(tid >> 6), r32 = lane & 31, h = lane >> 5;
    const int R0 = 256 * qb + 32 * w; const size_t tok0 = (size_t)b * SEQ;
    bf16x8 qf[6];
    { const bf16* qp = QM + ((tok0 + R0 + r32) * 4 + hd) * 96 + 8 * h;
#pragma unroll
      for (int s = 0; s < 6; ++s) qf[s] = *(const bf16x8*)(qp + 16 * s); }
    const bf16* Kg = KM + (tok0 * 4 + hd) * 96; const bf16* Vg = VM + tok0 * 256 + hd * 64;
    const int NT = 4 * qb + 4, ktd = 4 * qb + (w >> 1);
    TileRegs Ra, Rb; tile_issue<96>(Ra, Kg, 384, Vg, 256, tid); tile_issue<96>(Rb, Kg + (size_t)64 * 384, 384, Vg + (size_t)64 * 256, 256, tid); tile_commit<96>(Ra, lds, tid);
    __syncthreads();
    SmState st; st.m = NEG_INF; st.l = 0.f; st.o0 = f32x16{}; st.o1 = f32x16{};
    for (int kt = 0; kt < NT; kt += 2) {
        mla_step(kt, NT, ktd, R0, Kg, Vg, qf, st, Rb, Ra, lds, tid, lane, r32, h);
        mla_step(kt + 1, NT, ktd, R0, Kg, Vg, qf, st, Ra, Rb, lds, tid, lane, r32, h);
    }
    float l = st.l; f32x16 o0 = st.o0, o1 = st.o1;
    l = xh_sum(l); const float inv = 1.0f / l;
#pragma unroll
    for (int r = 0; r < 16; ++r) { o0[r] *= inv; o1[r] *= inv; }
    float ss = sumsq(o0, o1); ss = xh_sum(ss);
    const size_t tok = tok0 + R0 + r32;
    if (h == 0) SSQ[tok * 8 + hd] = ss;
    store_o(Y + tok * D + 512 + hd * 64, o0, o1, h);
}

#ifndef SB_EARLY
#define SB_EARLY 1
#endif
constexpr float SB_THR = -160.0f;
struct SbState { float carry; f32x16 o0, o1; bool wdone; };
__device__ __forceinline__ bool sb_step(int i, int NT, int ktd, int R0, const bf16* Kg, const bf16* Vg, const bf16x8 (&qf)[4], SbState& st, const TileRegs& Rc, TileRegs& Ri, LAS unsigned char* lds, LAS unsigned* flags, int tid, int lane, int w, int r32, int h) {
    const int kt = NT - 1 - i;
    const LAS unsigned char* cur = lds + (i & 1) * TBUF;
    if (kt >= 2) tile_issue<64>(Ri, Kg + (size_t)(kt - 2) * 64 * NP, NP, Vg + (size_t)(kt - 2) * 64 * NP, NP, tid);
    float carry = st.carry; f32x16 o0 = st.o0, o1 = st.o1;
        if (kt <= ktd && !(SB_EARLY && st.wdone)) {
            f32x16 p0 = {}, p1 = {};
            qk<64>(p0, p1, cur, qf, r32, h);
            const int trel = (kt == ktd) ? (R0 + r32 - 64 * kt) : 1000;
            f32x16 l0, l1;
#pragma unroll
            for (int r = 0; r < 16; ++r) { const int kk = crow(r, h);
                const float z0 = p0[r], z1 = p1[r];
                const float a0 = -(fmaxf(z0, 0.f) + lg2(1.0f + ex2(-fabsf(z0)))), a1 = -(fmaxf(z1, 0.f) + lg2(1.0f + ex2(-fabsf(z1))));
                l0[r] = (kk < trel) ? a0 : 0.f; l1[r] = (kk + 32 < trel) ? a1 : 0.f; }
            float tg[8], tp[8];
#pragma unroll
            for (int g = 0; g < 4; ++g) { tg[g] = (l0[4 * g] + l0[4 * g + 1]) + (l0[4 * g + 2] + l0[4 * g + 3]); tg[4 + g] = (l1[4 * g] + l1[4 * g + 1]) + (l1[4 * g + 2] + l1[4 * g + 3]); }
#pragma unroll
            for (int g = 0; g < 8; ++g) tp[g] = xhalf(tg[g], h);
            float suf = carry;
#pragma unroll
            for (int g = 7; g >= 0; --g) {
                const float base = suf + (h == 0 ? tp[g] : 0.f);
                if (g >= 4) { const int q = 4 * (g - 4);
                    const float r3 = base, r2 = r3 + l1[q + 3], r1 = r2 + l1[q + 2], r0 = r1 + l1[q + 1];
                    const float e0 = ex2(p1[q] + l1[q] + r0), e1 = ex2(p1[q + 1] + l1[q + 1] + r1), e2 = ex2(p1[q + 2] + l1[q + 2] + r2), e3 = ex2(p1[q + 3] + l1[q + 3] + r3);
                    const int kk = crow(q, h) + 32;
                    p1[q] = (kk < trel) ? e0 : 0.f; p1[q + 1] = (kk + 1 < trel) ? e1 : 0.f; p1[q + 2] = (kk + 2 < trel) ? e2 : 0.f; p1[q + 3] = (kk + 3 < trel) ? e3 : 0.f;
                } else { const int q = 4 * g;
                    const float r3 = base, r2 = r3 + l0[q + 3], r1 = r2 + l0[q + 2], r0 = r1 + l0[q + 1];
                    const float e0 = ex2(p0[q] + l0[q] + r0), e1 = ex2(p0[q + 1] + l0[q + 1] + r1), e2 = ex2(p0[q + 2] + l0[q + 2] + r2), e3 = ex2(p0[q + 3] + l0[q + 3] + r3);
                    const int kk = crow(q, h);
                    p0[q] = (kk < trel) ? e0 : 0.f; p0[q + 1] = (kk + 1 < trel) ? e1 : 0.f; p0[q + 2] = (kk + 2 < trel) ? e2 : 0.f; p0[q + 3] = (kk + 3 < trel) ? e3 : 0.f;
                }
                suf += tg[g] + tp[g];
            }
            carry = suf;
            pack_pv(o0, o1, p0, p1, cur, lane);
        }
    st.carry = carry; st.o0 = o0; st.o1 = o1;
#if SB_EARLY
    { const bool done = (kt <= ktd) && (carry < SB_THR);
      const unsigned long long bal = __ballot(done);
      st.wdone = (bal == ~0ull);
      if (lane == 0) flags[(i & 1) * 8 + w] = st.wdone ? 1u : 0u; }
#endif
    if (kt >= 1) tile_commit<64>(Rc, lds + ((i + 1) & 1) * TBUF, tid);
    RBAR();
#if SB_EARLY
    { unsigned all = 1u;
#pragma unroll
      for (int ww = 0; ww < 8; ++ww) all &= flags[(i & 1) * 8 + ww];
      if (__builtin_amdgcn_readfirstlane((int)all)) return true; }
#endif
    return kt == 0;
}
__device__ __forceinline__ void sb_unit(int b, int hd, int qb, const bf16* P, bf16* Y, float* SSQ, LAS unsigned char* lds, LAS unsigned* flags, int tid) {
    OPQ_V(tid);
    const int lane = tid & 63, w = __builtin_amdgcn_readfirstlane(tid >> 6), r32 = lane & 31, h = lane >> 5;
    const int R0 = 256 * qb + 32 * w; const size_t tok0 = (size_t)b * SEQ;
    bf16x8 qf[4];
    { const bf16* qp = P + (tok0 + R0 + r32) * NP + C_SQ + hd * 64 + 8 * h;
#pragma unroll
      for (int s = 0; s < 4; ++s) qf[s] = *(const bf16x8*)(qp + 16 * s); }
    const bf16* Kg = P + tok0 * NP + C_SK + hd * 64; const bf16* Vg = P + tok0 * NP + C_SV + hd * 64;
    const int NT = 4 * qb + 4, ktd = 4 * qb + (w >> 1);
    TileRegs Ra, Rb; tile_issue<64>(Ra, Kg + (size_t)(NT - 1) * 64 * NP, NP, Vg + (size_t)(NT - 1) * 64 * NP, NP, tid); tile_issue<64>(Rb, Kg + (size_t)(NT - 2) * 64 * NP, NP, Vg + (size_t)(NT - 2) * 64 * NP, NP, tid);
    tile_commit<64>(Ra, lds, tid);
    __syncthreads();
    SbState st; st.carry = 0.f; st.o0 = f32x16{}; st.o1 = f32x16{}; st.wdone = false;
    for (int i = 0; i < NT; i += 2) {
        if (sb_step(i, NT, ktd, R0, Kg, Vg, qf, st, Rb, Ra, lds, flags, tid, lane, w, r32, h)) break;
        if (sb_step(i + 1, NT, ktd, R0, Kg, Vg, qf, st, Ra, Rb, lds, flags, tid, lane, w, r32, h)) break;
    }
    f32x16 o0 = st.o0, o1 = st.o1;
    float ss = sumsq(o0, o1); ss = xh_sum(ss);
    const size_t tok = tok0 + R0 + r32;
    if (h == 0) SSQ[tok * 8 + 4 + hd] = ss;
    store_o(Y + tok * D + 768 + hd * 64, o0, o1, h);
}

constexpr int SCP = 33;
constexpr int NSA_SC = 2 * TBUF, NSA_SEL = NSA_SC + 4 * 64 * SCP * 4, NSA_UNI = NSA_SEL + 256, NSA_SS = NSA_UNI + 16, NSA_ACC2 = NSA_SS + 1024, NSA_END = NSA_ACC2 + 32768;
constexpr int RSLOT = 8192, RING_K = 0, RING_V = 3 * RSLOT;
constexpr float NSA_THR = 8.0f;
#define NSBAR() __builtin_amdgcn_sched_barrier(0)
#define NPIN(x) asm volatile("" : "+v"(x))
#define NWAIT_BAR(N) asm volatile("s_waitcnt vmcnt(" #N ") lgkmcnt(0)\n\ts_barrier" ::: "memory")
__device__ __forceinline__ void glds16(const void* g, unsigned lds_base) {
    unsigned sv; asm volatile("s_mov_b32 %0, m0\n\ts_mov_b32 m0, %2\n\ts_nop 0\n\tglobal_load_lds_dwordx4 %1, off\n\ts_mov_b32 m0, %0" : "=&s"(sv) : "v"(g), "s"(lds_base) : "memory"); }
__device__ __forceinline__ void kload2(bf16x8* kf, const LAS unsigned char* kp, int d0) { kf[2 * d0] = *(const LAS bf16x8*)(kp + d0 * 2048); kf[2 * d0 + 1] = *(const LAS bf16x8*)(kp + d0 * 2048 + 512); }
__device__ __forceinline__ s16x4 vtr(const LAS unsigned char* p) { return __builtin_bit_cast(s16x4, __builtin_amdgcn_ds_read_tr16_b64_v4i16((LAS v4i16_t*)p)); }
#define NMX3(a, b, c) __builtin_fmaxf(__builtin_fmaxf((a), (b)), (c))
__device__ __forceinline__ float rowmax(const f32x16& p0, const f32x16& p1) {
    float a = NMX3(p0[0], p0[1], p1[0]), b = NMX3(p0[2], p0[3], p1[1]); a = NMX3(a, p1[2], p1[3]);
#pragma unroll
    for (int r = 4; r < 16; r += 4) { a = NMX3(a, p0[r], p0[r + 1]); b = NMX3(b, p0[r + 2], p0[r + 3]); a = NMX3(a, p1[r], p1[r + 1]); b = NMX3(b, p1[r + 2], p1[r + 3]); }
    return xh_max(__builtin_fmaxf(a, b)); }
__device__ __forceinline__ void nsa_near(f32x16& p0, f32x16& p1, int dbase, const LAS float* tb2, int hd, int h) {
    const LAS float* bp = tb2 + hd * 256 + (dbase - 4 * h + 5);
    float b0[16], b1[16];
#pragma unroll
    for (int r = 0; r < 16; ++r) { const int c = (r & 3) + 8 * (r >> 2); b0[r] = bp[59 - c]; b1[r] = bp[27 - c]; }
#pragma unroll
    for (int r = 0; r < 16; ++r) { p0[r] += b0[r]; p1[r] += b1[r]; }
}
__device__ __forceinline__ void nsa_low(f32x16& p0, f32x16& p1, int trow, int h) {
#pragma unroll
    for (int r = 0; r < 16; ++r) { const int kk = crow(r, h); if (kk <= trow) p0[r] = NEG_INF; if (kk + 32 <= trow) p1[r] = NEG_INF; }
}
template <bool WIN> __device__ __forceinline__ void nsa_ring_pass(unsigned mask, unsigned selmask, int tblk, int trow, int hd, const bf16* Kg, const bf16* Vg,
                                                                  const bf16x8* qf, const LAS float* tb2, f32x16& oo0, f32x16& oo1, float& lsum, LAS unsigned char* lds, int tid) {
    const int lane = tid & 63, r32 = lane & 31, hi = lane >> 5, wid = __builtin_amdgcn_readfirstlane(tid >> 6);
    const float cb = tb2[hd * 256 + 191];
    const unsigned lds0 = (unsigned)(size_t)lds;
    const bf16* ksrc = Kg + (size_t)lane * 64 + wid * 8;
    const bf16* vsrc = Vg + (size_t)(16 * (wid & 3) + (lane >> 2)) * NP + (wid >> 2) * 32 + (lane & 3) * 8;
    const unsigned kdst = lds0 + RING_K + wid * 1024, vdst = lds0 + RING_V + wid * 1024;
    const LAS unsigned char* kp0 = lds + RING_K + hi * 1024 + r32 * 16;
    const LAS unsigned char* vp0 = lds + RING_V + ((lane >> 4) & 1) * 32 + (lane & 3) * 8 + (4 * hi + ((lane & 15) >> 2)) * 64;
    unsigned mk = mask, mv = mask, mc = mask; const int kdum = __builtin_ctz(mask);
#define DMA_K(slot) do { const int t_ = mk ? __builtin_ctz(mk) : kdum; mk &= mk - 1u; glds16(ksrc + (size_t)t_ * 64 * 64, (unsigned)__builtin_amdgcn_readfirstlane(kdst + (slot))); } while (0)
#define DMA_V(slot) do { const int t_ = mv ? __builtin_ctz(mv) : kdum; mv &= mv - 1u; glds16(vsrc + (size_t)t_ * 64 * NP, (unsigned)__builtin_amdgcn_readfirstlane(vdst + (slot))); } while (0)
    const int NT = __builtin_popcount(mask);
    DMA_K(0); DMA_V(0); DMA_K(RSLOT); DMA_K(2 * RSLOT);
    float mhat, l_reg = 0.f, f = 1.f; bool resc = false;
    f32x16 o0 = oo0, o1 = oo1;
    const f32x16 zero16 = {};
    f32x16 pA0, pA1, pB0, pB1; bf16x8 kf[8]; s16x4 vlo[8], vhi[8]; v4u pw0, pw1, pw2, pw3;
    int sl_prev = 0, sl_cur = 0, sl_next = RSLOT;
#define ROT() do { sl_prev = sl_cur; sl_cur = sl_next; sl_next = (sl_next == 2 * RSLOT) ? 0 : sl_next + RSLOT; } while (0)
#define EX(v) ex2((v) + nmh)
#define RESC() do { if (resc) { _Pragma("unroll") for (int r = 0; r < 16; ++r) { o0[r] *= f; o1[r] *= f; } } } while (0)
    NWAIT_BAR(3);
    { const int kt = __builtin_ctz(mc); mc &= mc - 1u; const bool nearb = (kt + 2 >= tblk);
      const float badd = (WIN || ((selmask >> kt) & 1u)) ? (nearb ? 0.f : cb) : NEG_INF;
#pragma unroll
      for (int d0 = 0; d0 < 4; ++d0) kload2(kf, kp0, d0);
      pA0 = MFMA32(kf[0], qf[0], zero16); pA1 = MFMA32(kf[1], qf[0], zero16); pA0 = MFMA32(kf[2], qf[1], pA0); pA1 = MFMA32(kf[3], qf[1], pA1);
      pA0 = MFMA32(kf[4], qf[2], pA0); pA1 = MFMA32(kf[5], qf[2], pA1); pA0 = MFMA32(kf[6], qf[3], pA0); pA1 = MFMA32(kf[7], qf[3], pA1);
      if (nearb) nsa_near(pA0, pA1, 64 * (tblk - kt) + trow, tb2, hd, hi);
      if (WIN) { if (kt + 8 == tblk) nsa_low(pA0, pA1, trow, hi); }
      const float rm = rowmax(pA0, pA1) + badd; mhat = (rm == NEG_INF) ? -126.f : rm; const float nmh = badd - mhat;
#pragma unroll
      for (int r = 0; r < 16; ++r) { pA0[r] = EX(pA0[r]); pA1[r] = EX(pA1[r]); } }
    NWAIT_BAR(0);
    DMA_K(0); DMA_V(RSLOT); ROT();
#pragma unroll
    for (int d0 = 0; d0 < 4; ++d0) kload2(kf, kp0 + sl_cur, d0);
    NWAIT_BAR(2);
#define PKW(P, i) cvtpk(P[i], P[i + 1])
#define PAF(k) __builtin_bit_cast(bf16x8, pw##k)
#define VFR(i) (bf16x8){vlo[i][0], vlo[i][1], vlo[i][2], vlo[i][3], vhi[i][0], vhi[i][1], vhi[i][2], vhi[i][3]}
#define VRD(i) do { vlo[i] = vtr(vp_ + (((i) >> 2) * 4096 + ((i) & 3) * 1024)); vhi[i] = vtr(vp_ + (((i) >> 2) * 4096 + ((i) & 3) * 1024 + 512)); } while (0)
#define KRD(d0) do { kload2(kf, kp0 + sl_next, d0); NSBAR(); } while (0)
#define GAPA(MF, a0, a1, a2, a3, W0, W1, PW) do { MF; sacc += a0; sacc += a1; sacc += a2; sacc += a3; W0; W1; NPIN(PW); NPIN(sacc); NSBAR(); } while (0)
#define GAPB(MF, X, i) do { MF; X[i] = EX(X[i]); X[i + 1] = EX(X[i + 1]); X[i + 2] = EX(X[i + 2]); X[i + 3] = EX(X[i + 3]); NPIN(X); NSBAR(); } while (0)
#define NSTEP(C0, C1, P0, P1) do { NSBAR(); \
    const int kt = __builtin_ctz(mc); mc &= mc - 1u; const bool nearb = (kt + 2 >= tblk); \
    const float badd = (WIN || ((selmask >> kt) & 1u)) ? (nearb ? 0.f : cb) : NEG_INF; \
    const LAS unsigned char* vp_ = vp0 + sl_prev; \
    VRD(0); NSBAR(); float sacc = P0[0] + P0[1]; \
                     GAPA(C0 = MFMA32(kf[0], qf[0], zero16), P0[2], P0[3], P0[4], P0[5],     pw0[0] = PKW(P0, 0),  pw0[1] = PKW(P0, 2),  pw0); \
    VRD(4); NSBAR(); GAPA(C1 = MFMA32(kf[1], qf[0], zero16), P0[6], P0[7], P0[8], P0[9],     pw0[2] = PKW(P0, 4),  pw0[3] = PKW(P0, 6),  pw0); \
    VRD(1); NSBAR(); GAPA(C0 = MFMA32(kf[2], qf[1], C0),    P0[10], P0[11], P0[12], P0[13], pw1[0] = PKW(P0, 8),  pw1[1] = PKW(P0, 10), pw1); \
    VRD(5); NSBAR(); GAPA(C1 = MFMA32(kf[3], qf[1], C1),    P0[14], P0[15], P1[0], P1[1],   pw1[2] = PKW(P0, 12), pw1[3] = PKW(P0, 14), pw1); \
    VRD(2); NSBAR(); GAPA(C0 = MFMA32(kf[4], qf[2], C0),    P1[2], P1[3], P1[4], P1[5],     pw2[0] = PKW(P1, 0),  pw2[1] = PKW(P1, 2),  pw2); \
    VRD(6); NSBAR(); GAPA(C1 = MFMA32(kf[5], qf[2], C1),    P1[6], P1[7], P1[8], P1[9],     pw2[2] = PKW(P1, 4),  pw2[3] = PKW(P1, 6),  pw2); \
    VRD(3); NSBAR(); GAPA(C0 = MFMA32(kf[6], qf[3], C0),    P1[10], P1[11], P1[12], P1[13], pw3[0] = PKW(P1, 8),  pw3[1] = PKW(P1, 10), pw3); \
    VRD(7); NSBAR(); GAPA(C1 = MFMA32(kf[7], qf[3], C1),    P1[14], P1[15], 0.f, 0.f,       pw3[2] = PKW(P1, 12), pw3[3] = PKW(P1, 14), pw3); \
    l_reg += sacc; \
    DMA_K(sl_cur); DMA_V(sl_next); \
    if (nearb) nsa_near(C0, C1, 64 * (tblk - kt) + trow, tb2, hd, hi); \
    if (WIN) { if (kt + 8 == tblk) nsa_low(C0, C1, trow, hi); } \
    { const float rm = rowmax(C0, C1) + badd - mhat; resc = false; \
      if (__builtin_expect(__any(rm > NSA_THR), 0)) { const float dl = __builtin_fmaxf(rm, 0.f); mhat += dl; f = ex2(-dl); l_reg *= f; resc = true; } } \
    const float nmh = badd - mhat; NSBAR(); \
    GAPB(o0 = MFMA32(VFR(0), PAF(0), o0), C0, 0);           GAPB(o1 = MFMA32(VFR(4), PAF(0), o1), C0, 4); \
    KRD(0); GAPB(o0 = MFMA32(VFR(1), PAF(1), o0), C0, 8);   KRD(1); GAPB(o1 = MFMA32(VFR(5), PAF(1), o1), C0, 12); \
    KRD(2); GAPB(o0 = MFMA32(VFR(2), PAF(2), o0), C1, 0);   KRD(3); GAPB(o1 = MFMA32(VFR(6), PAF(2), o1), C1, 4); \
    GAPB(o0 = MFMA32(VFR(3), PAF(3), o0), C1, 8);           GAPB(o1 = MFMA32(VFR(7), PAF(3), o1), C1, 12); \
    } while (0)
#define NDRAIN(P0, P1) do { float sacc = P0[0] + P0[1]; \
      _Pragma("unroll") for (int r = 2; r < 16; ++r) sacc += P0[r]; \
      _Pragma("unroll") for (int r = 0; r < 16; ++r) sacc += P1[r]; \
      l_reg += sacc; \
      pw0 = (v4u){PKW(P0, 0), PKW(P0, 2), PKW(P0, 4), PKW(P0, 6)}; pw1 = (v4u){PKW(P0, 8), PKW(P0, 10), PKW(P0, 12), PKW(P0, 14)}; \
      pw2 = (v4u){PKW(P1, 0), PKW(P1, 2), PKW(P1, 4), PKW(P1, 6)}; pw3 = (v4u){PKW(P1, 8), PKW(P1, 10), PKW(P1, 12), PKW(P1, 14)}; \
      const LAS unsigned char* vp_ = vp0 + sl_prev; _Pragma("unroll") for (int i = 0; i < 8; ++i) VRD(i); \
      o0 = MFMA32(VFR(0), PAF(0), o0); o1 = MFMA32(VFR(4), PAF(0), o1); o0 = MFMA32(VFR(1), PAF(1), o0); o1 = MFMA32(VFR(5), PAF(1), o1); \
      o0 = MFMA32(VFR(2), PAF(2), o0); o1 = MFMA32(VFR(6), PAF(2), o1); o0 = MFMA32(VFR(3), PAF(3), o0); o1 = MFMA32(VFR(7), PAF(3), o1); } while (0)
    int t = 1;
    for (; t + 1 < NT; t += 2) {
        NSTEP(pB0, pB1, pA0, pA1); NWAIT_BAR(2); RESC(); ROT();
        NSTEP(pA0, pA1, pB0, pB1); NWAIT_BAR(2); RESC(); ROT();
    }
    if (t < NT) { NSTEP(pB0, pB1, pA0, pA1); NWAIT_BAR(2); RESC(); ROT(); NDRAIN(pB0, pB1); }
    else NDRAIN(pA0, pA1);
    NWAIT_BAR(0);
#undef DMA_K
#undef DMA_V
#undef ROT
#undef EX
#undef RESC
#undef PKW
#undef PAF
#undef VFR
#undef VRD
#undef KRD
#undef GAPA
#undef GAPB
#undef NSTEP
#undef NDRAIN
    oo0 = o0; oo1 = o1;
    lsum = xh_sum(l_reg);
}
constexpr int MSLOTK = 12288, MRING_V = 3 * MSLOTK;
__device__ __forceinline__ void mla_cmask(f32x16& p0, f32x16& p1, int trel, int h) {
#pragma unroll
    for (int r = 0; r < 16; ++r) { const int kk = crow(r, h); if (kk > trel) p0[r] = NEG_INF; if (kk + 32 > trel) p1[r] = NEG_INF; }
}
__device__ __forceinline__ void mla_ring_unit(int b, int hd, int qb, const bf16* QM, const bf16* KM, const bf16* VM, bf16* Y, float* SSQ, LAS unsigned char* lds, int tid) {
    OPQ_V(tid);
    const int lane = tid & 63, wid = __builtin_amdgcn_readfirstlane(tid >> 6), r32 = lane & 31, hi = lane >> 5;
    const int R0 = 256 * qb + 32 * wid; const size_t tok0 = (size_t)b * SEQ;
    const bf16* Kg = KM + (tok0 * 4 + hd) * 96; const bf16* Vg = VM + tok0 * 256 + hd * 64;
    const int NT = 4 * qb + 4, tband = 4 * qb;
    const unsigned lds0 = (unsigned)(size_t)lds;
    const bf16* ksrc = Kg + (size_t)lane * 384 + wid * 8;
    const bf16* ksrc2 = Kg + (size_t)lane * 384 + (8 + (wid & 3)) * 8;
    const bf16* vsrc = Vg + (size_t)(16 * (wid & 3) + (lane >> 2)) * 256 + (wid >> 2) * 32 + (lane & 3) * 8;
    const unsigned kdst = lds0 + wid * 1024, kdst2 = lds0 + (8 + (wid & 3)) * 1024, vdst = lds0 + MRING_V + wid * 1024;
    const LAS unsigned char* kp0 = lds + hi * 1024 + r32 * 16;
    const LAS unsigned char* vp0 = lds + MRING_V + ((lane >> 4) & 1) * 32 + (lane & 3) * 8 + (4 * hi + ((lane & 15) >> 2)) * 64;
#define DMA_K(t, slot) do { const int t_ = (t) < NT ? (t) : 0; glds16(ksrc + (size_t)t_ * 64 * 384, (unsigned)__builtin_amdgcn_readfirstlane(kdst + (slot))); \
                            glds16(ksrc2 + (size_t)t_ * 64 * 384, (unsigned)__builtin_amdgcn_readfirstlane(kdst2 + (slot))); } while (0)
#define DMA_V(t, slot) do { const int t_ = (t) < NT ? (t) : 0; glds16(vsrc + (size_t)t_ * 64 * 256, (unsigned)__builtin_amdgcn_readfirstlane(vdst + (slot))); } while (0)
    DMA_K(0, 0); DMA_V(0, 0); DMA_K(1, MSLOTK); DMA_K(2, 2 * MSLOTK);
    bf16x8 qf[6];
    { const bf16* qp = QM + ((tok0 + R0 + r32) * 4 + hd) * 96 + 8 * hi;
#pragma unroll
      for (int s = 0; s < 6; ++s) qf[s] = *(const bf16x8*)(qp + 16 * s); }
    float mhat, l_reg = 0.f, f = 1.f; bool resc = false;
    f32x16 o0 = {}, o1 = {};
    const f32x16 zero16 = {};
    f32x16 pA0, pA1, pB0, pB1; bf16x8 kf[12]; s16x4 vlo[4], vhi[4]; v4u pw0, pw1, pw2, pw3;
    int slk_cur = 0, slk_next = MSLOTK, slv_prev = 0, slv_cur = 0, slv_next = RSLOT;
#define ROT() do { slk_cur = slk_next; slk_next = (slk_next == 2 * MSLOTK) ? 0 : slk_next + MSLOTK; slv_prev = slv_cur; slv_cur = slv_next; slv_next = (slv_next == 2 * RSLOT) ? 0 : slv_next + RSLOT; } while (0)
#define EX(v) ex2((v) + nmh)
#define RESC() do { if (resc) { _Pragma("unroll") for (int r = 0; r < 16; ++r) { o0[r] *= f; o1[r] *= f; } } } while (0)
    asm volatile("s_waitcnt vmcnt(0)" ::: "memory");
    __builtin_amdgcn_s_barrier();
    {
#pragma unroll
      for (int d0 = 0; d0 < 6; ++d0) kload2(kf, kp0, d0);
      pA0 = MFMA32(kf[0], qf[0], zero16); pA1 = MFMA32(kf[1], qf[0], zero16);
#pragma unroll
      for (int d0 = 1; d0 < 6; ++d0) { pA0 = MFMA32(kf[2 * d0], qf[d0], pA0); pA1 = MFMA32(kf[2 * d0 + 1], qf[d0], pA1); }
      if (0 >= tband) mla_cmask(pA0, pA1, R0 + r32, hi);
      mhat = rowmax(pA0, pA1); const float nmh = -mhat;
#pragma unroll
      for (int r = 0; r < 16; ++r) { pA0[r] = EX(pA0[r]); pA1[r] = EX(pA1[r]); } }
    NWAIT_BAR(0);
    DMA_K(3, 0); DMA_V(1, RSLOT); ROT();
#pragma unroll
    for (int d0 = 0; d0 < 6; ++d0) kload2(kf, kp0 + slk_cur, d0);
    NWAIT_BAR(3);
#define PKW(P, i) cvtpk(P[i], P[i + 1])
#define PAF(k) __builtin_bit_cast(bf16x8, pw##k)
#define VFR(i) (bf16x8){vlo[(i) & 3][0], vlo[(i) & 3][1], vlo[(i) & 3][2], vlo[(i) & 3][3], vhi[(i) & 3][0], vhi[(i) & 3][1], vhi[(i) & 3][2], vhi[(i) & 3][3]}
#define VRD(i) do { vlo[(i) & 3] = vtr(vp_ + (((i) >> 2) * 4096 + ((i) & 3) * 1024)); vhi[(i) & 3] = vtr(vp_ + (((i) >> 2) * 4096 + ((i) & 3) * 1024 + 512)); } while (0)
#define KRD(d0) do { kload2(kf, kp0 + slk_next, d0); NSBAR(); } while (0)
#define GAPA3(MF, a0, a1, a2, W0, W1, PW) do { MF; sacc += a0; sacc += a1; sacc += a2; W0; W1; NPIN(PW); NPIN(sacc); NSBAR(); } while (0)
#define GAPA2(MF, a0, a1) do { MF; sacc += a0; sacc += a1; NPIN(sacc); NSBAR(); } while (0)
#define GAPB(MF, X, i) do { MF; X[i] = EX(X[i]); X[i + 1] = EX(X[i + 1]); X[i + 2] = EX(X[i + 2]); X[i + 3] = EX(X[i + 3]); NPIN(X); NSBAR(); } while (0)
#define MSTEP(C0, C1, P0, P1, t) do { NSBAR(); \
    const LAS unsigned char* vp_ = vp0 + slv_prev; \
    VRD(0); NSBAR(); float sacc = P0[0] + P0[1]; \
                     GAPA3(C0 = MFMA32(kf[0], qf[0], zero16), P0[2], P0[3], P0[4],    pw0[0] = PKW(P0, 0),  pw0[1] = PKW(P0, 2),  pw0); \
                     GAPA3(C1 = MFMA32(kf[1], qf[0], zero16), P0[5], P0[6], P0[7],    pw0[2] = PKW(P0, 4),  pw0[3] = PKW(P0, 6),  pw0); \
    VRD(1); NSBAR(); GAPA3(C0 = MFMA32(kf[2], qf[1], C0),    P0[8], P0[9], P0[10],   pw1[0] = PKW(P0, 8),  pw1[1] = PKW(P0, 10), pw1); \
                     GAPA3(C1 = MFMA32(kf[3], qf[1], C1),    P0[11], P0[12], P0[13], pw1[2] = PKW(P0, 12), pw1[3] = PKW(P0, 14), pw1); \
    VRD(2); NSBAR(); GAPA3(C0 = MFMA32(kf[4], qf[2], C0),    P0[14], P0[15], P1[0],  pw2[0] = PKW(P1, 0),  pw2[1] = PKW(P1, 2),  pw2); \
                     GAPA3(C1 = MFMA32(kf[5], qf[2], C1),    P1[1], P1[2], P1[3],    pw2[2] = PKW(P1, 4),  pw2[3] = PKW(P1, 6),  pw2); \
    VRD(3); NSBAR(); GAPA3(C0 = MFMA32(kf[6], qf[3], C0),    P1[4], P1[5], P1[6],    pw3[0] = PKW(P1, 8),  pw3[1] = PKW(P1, 10), pw3); \
                     GAPA3(C1 = MFMA32(kf[7], qf[3], C1),    P1[7], P1[8], P1[9],    pw3[2] = PKW(P1, 12), pw3[3] = PKW(P1, 14), pw3); \
    GAPA2(C0 = MFMA32(kf[8], qf[4], C0), P1[10], P1[11]); \
    GAPA2(C1 = MFMA32(kf[9], qf[4], C1), P1[12], P1[13]); \
    GAPA2(C0 = MFMA32(kf[10], qf[5], C0), P1[14], P1[15]); \
    C1 = MFMA32(kf[11], qf[5], C1); NSBAR(); \
    l_reg += sacc; \
    DMA_K((t) + 3, slk_cur); DMA_V((t) + 1, slv_next); \
    if ((t) >= tband) mla_cmask(C0, C1, R0 + r32 - 64 * (t), hi); \
    { const float rm = rowmax(C0, C1) - mhat; resc = false; \
      if (__builtin_expect(__any(rm > NSA_THR), 0)) { const float dl = __builtin_fmaxf(rm, 0.f); mhat += dl; f = ex2(-dl); l_reg *= f; resc = true; } } \
    const float nmh = -mhat; NSBAR(); \
    GAPB(o0 = MFMA32(VFR(0), PAF(0), o0), C0, 0);   VRD(4); NSBAR(); \
    GAPB(o0 = MFMA32(VFR(1), PAF(1), o0), C0, 4);   VRD(5); NSBAR(); \
    GAPB(o0 = MFMA32(VFR(2), PAF(2), o0), C0, 8);   VRD(6); NSBAR(); KRD(0); \
    GAPB(o0 = MFMA32(VFR(3), PAF(3), o0), C0, 12);  VRD(7); NSBAR(); KRD(1); \
    GAPB(o1 = MFMA32(VFR(4), PAF(0), o1), C1, 0);   KRD(2); \
    GAPB(o1 = MFMA32(VFR(5), PAF(1), o1), C1, 4);   KRD(3); \
    GAPB(o1 = MFMA32(VFR(6), PAF(2), o1), C1, 8);   KRD(4); \
    GAPB(o1 = MFMA32(VFR(7), PAF(3), o1), C1, 12);  KRD(5); \
    } while (0)
    int t = 1;
    for (; t + 1 < NT; t += 2) {
        MSTEP(pB0, pB1, pA0, pA1, t);     NWAIT_BAR(3); RESC(); ROT();
        MSTEP(pA0, pA1, pB0, pB1, t + 1); NWAIT_BAR(3); RESC(); ROT();
    }
    MSTEP(pB0, pB1, pA0, pA1, t); NWAIT_BAR(3); RESC(); ROT();
    { float sacc = pB0[0] + pB0[1];
#pragma unroll
      for (int r = 2; r < 16; ++r) sacc += pB0[r];
#pragma unroll
      for (int r = 0; r < 16; ++r) sacc += pB1[r];
      l_reg += sacc;
      pw0 = (v4u){PKW(pB0, 0), PKW(pB0, 2), PKW(pB0, 4), PKW(pB0, 6)}; pw1 = (v4u){PKW(pB0, 8), PKW(pB0, 10), PKW(pB0, 12), PKW(pB0, 14)};
      pw2 = (v4u){PKW(pB1, 0), PKW(pB1, 2), PKW(pB1, 4), PKW(pB1, 6)}; pw3 = (v4u){PKW(pB1, 8), PKW(pB1, 10), PKW(pB1, 12), PKW(pB1, 14)};
      const LAS unsigned char* vp_ = vp0 + slv_prev;
#pragma unroll
      for (int i = 0; i < 4; ++i) VRD(i);
      o0 = MFMA32(VFR(0), PAF(0), o0); o0 = MFMA32(VFR(1), PAF(1), o0); o0 = MFMA32(VFR(2), PAF(2), o0); o0 = MFMA32(VFR(3), PAF(3), o0); NSBAR();
#pragma unroll
      for (int i = 4; i < 8; ++i) VRD(i);
      o1 = MFMA32(VFR(4), PAF(0), o1); o1 = MFMA32(VFR(5), PAF(1), o1); o1 = MFMA32(VFR(6), PAF(2), o1); o1 = MFMA32(VFR(7), PAF(3), o1); }
    NWAIT_BAR(0);
#undef DMA_K
#undef DMA_V
#undef ROT
#undef EX
#undef RESC
#undef PKW
#undef PAF
#undef VFR
#undef VRD
#undef KRD
#undef GAPA3
#undef GAPA2
#undef GAPB
#undef MSTEP
    float l = xh_sum(l_reg); const float inv = 1.0f / l;
#pragma unroll
    for (int r = 0; r < 16; ++r) { o0[r] *= inv; o1[r] *= inv; }
    float ss = sumsq(o0, o1); ss = xh_sum(ss);
    const size_t tok = tok0 + R0 + r32;
    if (hi == 0) SSQ[tok * 8 + hd] = ss;
    store_o(Y + tok * D + 512 + hd * 64, o0, o1, hi);
}
__device__ __forceinline__ void nsa_unit(int b, int qblk, const bf16* P, const float* nqn, const bf16* KSn, const bf16* KWn, const bf16* KC, const bf16* VC, const LAS float* gwT, bf16* Y,
                                         LAS unsigned char* lds, const LAS float* tb2, int tid, int skip = 0  ) {
    OPQ_V(tid);
    const int lane = tid & 63, w = __builtin_amdgcn_readfirstlane(tid >> 6), r32 = lane & 31, h = lane >> 5;
    const int hd = w >> 1, trow = 32 * (w & 1) + r32, t = 64 * qblk + trow, tblk = qblk; const size_t tok0 = (size_t)b * SEQ, tok = tok0 + t;
    LAS float* SC = (LAS float*)(lds + NSA_SC); LAS unsigned* SEL = (LAS unsigned*)(lds + NSA_SEL); LAS unsigned* UNI = (LAS unsigned*)(lds + NSA_UNI); LAS float* SS4 = (LAS float*)(lds + NSA_SS);
    bf16x8 qf[4];
    { const bf16* qp = P + tok * NP + C_NQ + hd * 64 + 8 * h; v4u raw[4]; float ss = 0.f;
#pragma unroll
      for (int s = 0; s < 4; ++s) { raw[s] = *(const v4u*)(qp + 16 * s);
          const float a0 = bflo(raw[s].x), a1 = bfhi(raw[s].x), a2 = bflo(raw[s].y), a3 = bfhi(raw[s].y), a4 = bflo(raw[s].z), a5 = bfhi(raw[s].z), a6 = bflo(raw[s].w), a7 = bfhi(raw[s].w);
          ss += ((a0 * a0 + a1 * a1) + (a2 * a2 + a3 * a3)) + ((a4 * a4 + a5 * a5) + (a6 * a6 + a7 * a7)); }
      ss = xh_sum(ss);
      const float rstd = (1.0f / sqrtf(ss * (1.f / 64.f) + EPS)) * (0.125f * L2E);
#pragma unroll
      for (int s = 0; s < 4; ++s) { const f32x4 g0 = *(const f32x4*)(nqn + 16 * s + 8 * h), g1 = *(const f32x4*)(nqn + 16 * s + 8 * h + 4); v4u wq;
          wq.x = cvtpk(bflo(raw[s].x) * rstd * g0.x, bfhi(raw[s].x) * rstd * g0.y); wq.y = cvtpk(bflo(raw[s].y) * rstd * g0.z, bfhi(raw[s].y) * rstd * g0.w);
          wq.z = cvtpk(bflo(raw[s].z) * rstd * g1.x, bfhi(raw[s].z) * rstd * g1.y); wq.w = cvtpk(bflo(raw[s].w) * rstd * g1.z, bfhi(raw[s].w) * rstd * g1.w);
          qf[s] = __builtin_bit_cast(bf16x8, wq); } }
    if (tid == 0) UNI[0] = 0u;
    const bf16* gp_ = P + tok * NP + C_NG + hd * 3; const float gl0 = bf2f(gp_[0]), gl1 = bf2f(gp_[1]), gl2 = bf2f(gp_[2]);
    { TileRegs R0_, R1_; const bf16* kc = KC + (size_t)b * 128 * 64; const bf16* vc = VC + (size_t)b * 128 * 64;
      tile_issue<64>(R0_, kc, 64, vc, 64, tid); tile_issue<64>(R1_, kc + 64 * 64, 64, vc + 64 * 64, 64, tid);
      tile_commit<64>(R0_, lds, tid); tile_commit<64>(R1_, lds + TBUF, tid); }
    __syncthreads();
    LAS float* AC0 = (LAS float*)(lds + NSA_SC) + w * 64 + lane; LAS float* AC1 = (LAS float*)(lds + NSA_ACC2) + w * 64 + lane;
#ifndef PROBE_NSA
#define PROBE_NSA 0
#endif
    f32x16 pc[4] = {{}, {}, {}, {}};
    float cinv;
    _Pragma("unroll 1") for (int rep_ = 0; rep_ < ((PROBE_NSA & 4) ? 2 : 1); ++rep_) {
        if (PROBE_NSA & 4) { pc[0] = f32x16{}; pc[1] = f32x16{}; pc[2] = f32x16{}; pc[3] = f32x16{}; }
        qk<64>(pc[0], pc[1], lds, qf, r32, h); qk<64>(pc[2], pc[3], lds + TBUF, qf, r32, h);
        const LAS float* th = tb2 + hd * 256; const int cl = t + 33 - 64 * h;
#pragma unroll
        for (int i = 0; i < 4; ++i) { float bv[16];
#pragma unroll
            for (int r = 0; r < 16; ++r) { const int ix = cl - 16 * (32 * i + (r & 3) + 8 * (r >> 2)); bv[r] = th[ix < 63 ? 63 : (ix > 191 ? 191 : ix)]; }
#pragma unroll
            for (int r = 0; r < 16; ++r) pc[i][r] += bv[r]; }
        if (h) pc[3][15] = NEG_INF;
        const float mx = fmaxf(rowmax(pc[0], pc[1]), rowmax(pc[2], pc[3]));
        const float mu = (mx == NEG_INF) ? 0.f : mx; float s = 0.f;
#pragma unroll
        for (int i = 0; i < 4; ++i)
#pragma unroll
            for (int r = 0; r < 16; ++r) { pc[i][r] = ex2(pc[i][r] - mu); s += pc[i][r]; }
        s = xh_sum(s);
        cinv = s > 0.f ? 1.0f / s : 0.f;
        float own[16], cry[16];
#pragma unroll
        for (int i = 0; i < 4; ++i)
#pragma unroll
            for (int g = 0; g < 4; ++g) { const float hv = 0.5f * pc[i][4 * g + 3]; own[4 * i + g] = (pc[i][4 * g] + pc[i][4 * g + 1]) + (pc[i][4 * g + 2] + hv); cry[4 * i + g] = hv; }
#pragma unroll
        for (int jj = 0; jj < 16; ++jj) cry[jj] = xhalf(cry[jj], h);
#pragma unroll
        for (int jj = 0; jj < 16; ++jj) { const float fromh0 = cry[jj], fromh1 = jj > 0 ? cry[jj - 1] : 0.f; own[jj] += h ? fromh0 : fromh1; }
#pragma unroll
        for (int jj = 0; jj < 16; ++jj) SC[(hd * 64 + trow) * SCP + 2 * jj + h] = own[jj] * cinv;
    }
    __syncthreads();
    _Pragma("unroll 1") for (int rep_ = 0; rep_ < ((PROBE_NSA & 8) ? 2 : 1); ++rep_) { const int hw = tid >> 5, j = tid & 31; unsigned uacc = 0u;
      LAS unsigned* KEYS = (LAS unsigned*)(lds + NSA_ACC2);
      unsigned key[4];
#pragma unroll
      for (int rr = 0; rr < 4; ++rr) { const int row = hw * 4 + rr;
          const float sc = (SC[(0 * 64 + row) * SCP + j] + SC[(1 * 64 + row) * SCP + j]) + (SC[(2 * 64 + row) * SCP + j] + SC[(3 * 64 + row) * SCP + j]);
          const bool forced = (j == 0) || (j == tblk) || (j == tblk - 1), validb = j <= tblk;
          key[rr] = (forced ? 0xffffffe0u : (validb ? (__float_as_uint(sc) & 0xffffffe0u) : 0u)) | (unsigned)(31 - j);
          KEYS[row * 32 + j] = key[rr]; }
#pragma unroll
      for (int rr = 0; rr < 4; ++rr) { const int row = hw * 4 + rr; int rank = 0;
#pragma unroll
          for (int q4 = 0; q4 < 8; ++q4) { const v4u kk = *(const LAS v4u*)(KEYS + row * 32 + 4 * q4);
              rank += (kk.x > key[rr]) ? 1 : 0; rank += (kk.y > key[rr]) ? 1 : 0; rank += (kk.z > key[rr]) ? 1 : 0; rank += (kk.w > key[rr]) ? 1 : 0; }
          const unsigned long long bal = __ballot(rank < 16 && j <= tblk);
          const unsigned msk = (lane < 32) ? (unsigned)bal : (unsigned)(bal >> 32);
          if (j == 0) SEL[row] = msk; uacc |= msk; }
      if (j == 0) __hip_atomic_fetch_or(UNI, uacc, __ATOMIC_RELAXED, __HIP_MEMORY_SCOPE_WORKGROUP); }
    __syncthreads();
    const unsigned selmask = SEL[trow]; const unsigned uni = (unsigned)__builtin_amdgcn_readfirstlane((int)UNI[0]);
    { f32x16 oc0 = {}, oc1 = {};
      pack_pv(oc0, oc1, pc[0], pc[1], lds, lane); pack_pv(oc0, oc1, pc[2], pc[3], lds + TBUF, lane);
      const float g0 = sigm(gl0) * cinv;
#pragma unroll
      for (int r = 0; r < 16; ++r) { AC0[r * 512] = g0 * oc0[r]; AC1[r * 512] = g0 * oc1[r]; } }
    __syncthreads();
    _Pragma("unroll 1") for (int rep_ = 0; rep_ < ((PROBE_NSA & 1) ? 2 : 1); ++rep_) { f32x16 o0 = {}, o1 = {}; float ls;
      if (!(skip & 1)) nsa_ring_pass<false>(uni, selmask, tblk, trow, hd, KSn + tok0 * 64, P + tok0 * NP + C_VS, qf, tb2, o0, o1, ls, lds, tid); else ls = 1.f;
      const float gl = gl1; const float g1 = ((PROBE_NSA & 1) ? (rep_ == 0 ? 1.f : 0.f) : 1.f) * sigm(gl) / ls;
#pragma unroll
      for (int r = 0; r < 16; ++r) { AC0[r * 512] += g1 * o0[r]; AC1[r * 512] += g1 * o1[r]; } }
    f32x16 acc0, acc1;
#if PROBE_NSA & 2
    { f32x16 o0 = {}, o1 = {}; float ls;
      const int c0 = tblk >= 8 ? tblk - 8 : 0; const unsigned upto = tblk == 31 ? 0xffffffffu : ((2u << tblk) - 1u); const unsigned wmask = upto & ~((1u << c0) - 1u);
      nsa_ring_pass<true>(wmask, 0u, tblk, trow, hd, KWn + tok0 * 64, P + tok0 * NP + C_VW, qf, tb2, o0, o1, ls, lds, tid);
      const float gl = gl2; const float g2 = (float)(tblk >> 20) * sigm(gl) / ls;
#pragma unroll
      for (int r = 0; r < 16; ++r) { AC0[r * 512] += g2 * o0[r]; AC1[r * 512] += g2 * o1[r]; } }
#endif
    { f32x16 o0 = {}, o1 = {}; float ls;
      const int c0 = tblk >= 8 ? tblk - 8 : 0; const unsigned upto = tblk == 31 ? 0xffffffffu : ((2u << tblk) - 1u); const unsigned wmask = upto & ~((1u << c0) - 1u);
      if (!(skip & 2)) nsa_ring_pass<true>(wmask, 0u, tblk, trow, hd, KWn + tok0 * 64, P + tok0 * NP + C_VW, qf, tb2, o0, o1, ls, lds, tid); else ls = 1.f;
      const float g2 = sigm(gl2) / ls;
#pragma unroll
      for (int r = 0; r < 16; ++r) { o0[r] = AC0[r * 512] + g2 * o0[r]; o1[r] = AC1[r * 512] + g2 * o1[r]; }
      acc0 = o0; acc1 = o1; }
    { float ss = sumsq(acc0, acc1); ss = xh_sum(ss); if (h == 0) SS4[hd * 64 + trow] = ss; }
    __syncthreads();
    { const float tot = (SS4[trow] + SS4[64 + trow]) + (SS4[128 + trow] + SS4[192 + trow]); const float rstd = 1.0f / sqrtf(tot * (1.f / 256.f) + EPS);
      const LAS float* gw = gwT + hd * 64;
#pragma unroll
      for (int g = 0; g < 4; ++g)
#pragma unroll
          for (int e = 0; e < 4; ++e) { acc0[4 * g + e] *= rstd * gw[8 * g + 4 * h + e]; acc1[4 * g + e] *= rstd * gw[32 + 8 * g + 4 * h + e]; }
      store_o(Y + tok * D + 256 + hd * 64, acc0, acc1, h); }
    __syncthreads();
}
}
#ifndef PROBE_TIME_MASK
#define PROBE_TIME_MASK 0u
#endif
#define PHASE_MAXG(k, wsptr) do { if (PROBE_TIME_MASK != 0u) { if (F.wave == 0 && opq_lane() == 0) { volatile LAS unsigned long long* T_ = (volatile LAS unsigned long long*)((LAS unsigned char*)F.lds + MISC_OFF + 128); const unsigned long long now_ = __builtin_amdgcn_s_memrealtime(); if ((PROBE_TIME_MASK >> (k)) & 1u) atomicMax((unsigned*)((wsptr) + WS_CTL) + 9000, (unsigned)(now_ - T_[0])); T_[0] = now_; } } } while (0)
#ifndef PROBE_CLK_BIT
#define PROBE_CLK_BIT -1
#endif
#define PHASE_CLK(k) do { if (PROBE_CLK_BIT >= 0) { if (F.wave == 0 && opq_lane() == 0) { volatile LAS unsigned long long* T_ = (volatile LAS unsigned long long*)((LAS unsigned char*)F.lds + MISC_OFF + 128); const unsigned long long c_ = __builtin_amdgcn_s_memtime(); if ((k) == PROBE_CLK_BIT) T_[3] += c_ - T_[2]; T_[2] = c_; } } } while (0)
#define PHASE_END(k) do { PHASE_CLK(k); if (PROBE_TIME_MASK != 0u) { if (F.wave == 0 && opq_lane() == 0) { volatile LAS unsigned long long* T_ = (volatile LAS unsigned long long*)((LAS unsigned char*)F.lds + MISC_OFF + 128); const unsigned long long now_ = __builtin_amdgcn_s_memrealtime(); if ((PROBE_TIME_MASK >> (k)) & 1u) T_[1] += now_ - T_[0]; T_[0] = now_; } } } while (0)
#ifndef PROBE_DUP
#define PROBE_DUP -1
#endif
__device__ __forceinline__ int win_dst(int n) { return n < 1408 ? n : (n < 1420 ? 2528 + (n - 1408) : n - 12); }
template <bool WINMAP, bool FRAG = false> __device__ __forceinline__ void transpose_item(const float* W, int K, int N, bf16* WT, float* scr, int item, int lane, const float* gk = nullptr  , int gk0 = 0  ) {
    const int nblk = (N + 31) / 32, kb = item / nblk, nb = item % nblk, k0 = 64 * kb, n0 = 32 * nb;
    { const int n = n0 + (lane & 31); const float cs = (WINMAP && n >= 1772 && n < 2028) ? 0.125f * LOG2E : 1.0f;
      float v[32];
#pragma unroll
      for (int i = 0; i < 32; ++i) { const int kk = 2 * i + (lane >> 5); v[i] = n < N ? W[(size_t)(k0 + kk) * N + n] : 0.f; }
#pragma unroll
      for (int i = 0; i < 32; ++i) { const int kk = 2 * i + (lane >> 5); scr[kk * 33 + (lane & 31)] = v[i] * ((gk && k0 + kk >= gk0) ? cs * gk[k0 + kk] : cs); } }
    LDS_WAIT(); asm volatile("" ::: "memory");
    const int c = lane & 7;
#pragma unroll
    for (int j = 0; j < 4; ++j) { const int nl = (lane >> 3) + 8 * j, n = n0 + nl; const float* s = scr + (8 * c) * 33 + nl;
        v4u o; o.x = pk2(s[0 * 33], s[1 * 33]); o.y = pk2(s[2 * 33], s[3 * 33]); o.z = pk2(s[4 * 33], s[5 * 33]); o.w = pk2(s[6 * 33], s[7 * 33]);
        if (n < N) { const int dn = WINMAP ? win_dst(n) : n; const int kp = k0 + 8 * c;
            if (FRAG) *(v4u*)(WT + ((size_t)((dn >> 5) * (K >> 4) + (kp >> 4)) * 64 + ((kp >> 3) & 1) * 32 + (dn & 31)) * 8) = o;
            else *(v4u*)(WT + (size_t)dn * K + kp) = o; } }
    LDS_WAIT(); asm volatile("" ::: "memory");
}
__device__ __forceinline__ void sincos_d(float angf, float& c, float& s) {
    const double a = (double)angf; const double kq = __builtin_rint(a * 0.63661977236758134308); const int q = (int)kq;
    double r = __builtin_fma(-kq, 1.5707963267948966192, a); r = __builtin_fma(-kq, 6.123233995736766e-17, r);
    const double r2 = r * r;
    double sp = -1.0 / 39916800.0; sp = sp * r2 + 1.0 / 362880.0; sp = sp * r2 - 1.0 / 5040.0; sp = sp * r2 + 1.0 / 120.0; sp = sp * r2 - 1.0 / 6.0; sp = sp * r2 + 1.0; sp *= r;
    double cp = 1.0 / 479001600.0; cp = cp * r2 - 1.0 / 3628800.0; cp = cp * r2 + 1.0 / 40320.0; cp = cp * r2 - 1.0 / 720.0; cp = cp * r2 + 1.0 / 24.0; cp = cp * r2 - 0.5; cp = cp * r2 + 1.0;
    const int qq = q & 3;
    const double sv = (qq == 0) ? sp : (qq == 1) ? cp : (qq == 2) ? -sp : -cp;
    const double cv = (qq == 0) ? cp : (qq == 1) ? -sp : (qq == 2) ? -cp : sp;
    c = (float)cv; s = (float)sv;
}
__device__ __forceinline__ int t5_bucket(int d) {
    if (d < 16) return d;
    int b = 16 + (int)(logf((float)d / 16.0f) / logf(8.0f) * 16.0f);
    return b < 31 ? b : 31;
}

constexpr int CV_IN = (D / 64) * ((NIN + 31) / 32), CV_O = (D / 64) * (D / 32), CV_1 = (D / 64) * (FF / 32), CV_2 = (FF / 64) * (D / 32);
__device__ __forceinline__ void conv_transpose(const Frame F, float* scr, int lane_, int kind, int l, int r) {
    if (kind == 0) transpose_item<true>(((const float*)F.a->in[I_WIN]) + (size_t)l * D * NIN, D, NIN, (bf16*)(F.ws + WS_WIN) + (size_t)l * NP * D, scr, r, lane_, ((const float*)F.a->in[I_N1W]) + l * D);
    else if (kind == 1) transpose_item<false>(((const float*)F.a->in[I_WOUT]) + (size_t)l * D * D, D, D, (bf16*)(F.ws + WS_WO) + (size_t)l * D * D, scr, r, lane_, ((const float*)F.a->in[I_ONW]) + l * D, 512);
    else if (kind == 2) transpose_item<false>(((const float*)F.a->in[I_FW1]) + (size_t)l * D * FF, D, FF, (bf16*)(F.ws + WS_W1) + (size_t)l * FF * D, scr, r, lane_, ((const float*)F.a->in[I_N2W]) + l * D);
    else if (kind == 3) transpose_item<false>(((const float*)F.a->in[I_FW2]) + (size_t)l * FF * D, FF, D, (bf16*)(F.ws + WS_W2) + (size_t)l * D * FF, scr, r, lane_);
    else transpose_item<false, true>(((const float*)F.a->in[I_CW1]) + (size_t)l * 2048 * 256, 2048, 256, (bf16*)(F.ws + WS_W1C) + (size_t)l * 256 * 2048, scr, r, lane_);
}
constexpr int MLAW_Q = 12 * 12 * 64, MLAW_KV = 16 * 8 * 64, MLAW_L = MLAW_Q + MLAW_KV;
__device__ __forceinline__ void conv_mlaw(const Frame F, int it) {
    const int l = it / MLAW_L; int r = it % MLAW_L; const bool isq = r < MLAW_Q; if (!isq) r -= MLAW_Q;
    const int ln = r & 63, fr = r >> 6, KS = isq ? 12 : 8, jt = fr / KS, sx = fr % KS, j = 32 * jt + (ln & 31), c0 = 16 * sx + 8 * (ln >> 5), ldb = isq ? 384 : 512;
    const float* src = (isq ? ((const float*)F.a->in[I_WQB]) + (size_t)l * 192 * 384 : ((const float*)F.a->in[I_WKVB]) + (size_t)l * 128 * 512) + j;
    const float* g = (isq ? ((const float*)F.a->in[I_QAN]) + l * 192 : ((const float*)F.a->in[I_KVN]) + l * 128) + c0;
    float v[8];
#pragma unroll
    for (int i = 0; i < 8; ++i) v[i] = src[(size_t)(c0 + i) * ldb];
    const f32x4 g0 = *(const f32x4*)g, g1 = *(const f32x4*)(g + 4);
    v4u o; o.x = pk2(v[0] * g0[0], v[1] * g0[1]); o.y = pk2(v[2] * g0[2], v[3] * g0[3]); o.z = pk2(v[4] * g1[0], v[5] * g1[1]); o.w = pk2(v[6] * g1[2], v[7] * g1[3]);
    bf16* dst = (bf16*)(F.ws + (isq ? WS_WQF : WS_WKVF)) + (size_t)l * (isq ? 12 * 12 : 16 * 8) * 512;
    *(v4u*)(dst + ((size_t)fr * 64 + ln) * 8) = o;
}

constexpr int CV_TB = 2 * CV_O + 2 * CV_1 + 2 * CV_2 + CV_IN + 2 * 256, CV_TU = (CV_TB + 31) / 32, CV_UNITS = CV_TU;
__device__ __forceinline__ void conv_unit(const Frame F, int cu, int lane_) {
    float* scr = (float*)(F.lds + RING_OFF + F.wave * 16384);
    if (cu < CV_TU) {
        for (int i = 0; i < 4; ++i) { int idx = cu * 32 + F.wave * 4 + i; if (idx >= CV_TB) break;
            if (idx < 2 * CV_O) { conv_transpose(F, scr, lane_, 1, idx / CV_O, idx % CV_O); continue; } idx -= 2 * CV_O;
            if (idx < 2 * CV_1) { conv_transpose(F, scr, lane_, 2, idx / CV_1, idx % CV_1); continue; } idx -= 2 * CV_1;
            if (idx < 2 * CV_2) { conv_transpose(F, scr, lane_, 3, idx / CV_2, idx % CV_2); continue; } idx -= 2 * CV_2;
            if (idx < CV_IN) { conv_transpose(F, scr, lane_, 0, 1, idx); continue; } idx -= CV_IN;
            conv_transpose(F, scr, lane_, 4, 2 + (idx >> 8), idx & 255); }
    }
}
__device__ __forceinline__ void p0_prologue(Frame F) {
    OPQ_S(F.ws); OPQ_S(F.a); const int lane_ = opq_lane(), tid_ = F.wave * 64 + lane_;
    float* scr = (float*)(F.lds + RING_OFF + F.wave * 16384);
    const int gw = F.vcu * NWAVES + F.wave, NGW = F.G * NWAVES;
    const int gt = F.vcu * (NWAVES * 64) + tid_, NT = F.G * NWAVES * 64;
    for (int it = gw; it < CV_IN + 2 * 256; it += NGW) { if (it < CV_IN) conv_transpose(F, scr, lane_, 0, 0, it); else conv_transpose(F, scr, lane_, 4, (it - CV_IN) >> 8, (it - CV_IN) & 255); }
    for (int it = gt; it < DEPTH * MLAW_L; it += NT) conv_mlaw(F, it);
    for (int i = gt; i < DEPTH * 20 * D / 8; i += NT) { const int l = i / (20 * D / 8), r = i % (20 * D / 8);
        *(v4u*)((bf16*)(F.ws + WS_WIN) + (size_t)l * NP * D + (size_t)NIN * D + (size_t)r * 8) = (v4u){0u, 0u, 0u, 0u}; }
    for (int i = gt; i < SEQ * 16; i += NT) { const int t = i >> 4, j = i & 15;
        const double pb = (j & 3) == 0 ? 1.0 : (j & 3) == 1 ? 0.56234132519034908 : (j & 3) == 2 ? 0.31622776601683794 : 0.17782794100389228;
        const int e = j >> 2; const double ps = e == 0 ? 1.0 : e == 1 ? 0.1 : e == 2 ? 0.01 : 0.001;
        const float inv = (float)(pb * ps); const float ang = (float)t * inv; float c, s; sincos_d(ang, c, s);
        ((float*)(F.ws + WS_ROPE))[i] = c; ((float*)(F.ws + WS_ROPE))[SEQ * 16 + i] = s; }
    for (int i = gt; i < 128 * 4; i += NT) { const int d = i >> 2, h = i & 3; ((float*)(F.ws + WS_TB))[i] = ((const float*)F.a->in[I_RELB])[t5_bucket(d) * 4 + h] * LOG2E; }
    for (int it = gw; it < DEPTH * 2 * 16 * 4; it += NGW) { const int hb = it & 3, ks = (it >> 2) & 15, lb = it >> 6;
        const float* pos = ((const float*)F.a->in[I_CPOS]) + (size_t)lb * 2048; const float* w1 = ((const float*)F.a->in[I_CW1]) + (size_t)lb * 2048 * 256 + hb * 64 + lane_; float a = 0.f;
        for (int k0 = ks * 128; k0 < ks * 128 + 128; k0 += 16) { float wv[16];
#pragma unroll
            for (int q = 0; q < 16; ++q) wv[q] = w1[(size_t)(k0 + q) * 256];
#pragma unroll
            for (int q = 0; q < 16; ++q) a += pos[k0 + q] * wv[q]; }
        ((float*)(F.ws + WS_CB1))[(lb * 16 + ks) * 256 + hb * 64 + lane_] = a; }
    for (int m0 = gw; m0 < M; m0 += 2 * NGW) {
        f32x4 v[2][4]; float sq[2] = {0.f, 0.f};
#pragma unroll
        for (int q = 0; q < 2; ++q) { const f32x4* xr = (const f32x4*)(((const float*)F.a->in[I_X]) + (size_t)(m0 + q * NGW) * D) + lane_;
#pragma unroll
            for (int j = 0; j < 4; ++j) v[q][j] = xr[64 * j]; }
#pragma unroll
        for (int q = 0; q < 2; ++q) { const int m = m0 + q * NGW; unsigned long long* o8 = (unsigned long long*)((bf16*)(F.ws + WS_XB) + (size_t)m * D) + lane_;
#pragma unroll
            for (int j = 0; j < 4; ++j) { sq[q] += (v[q][j].x * v[q][j].x + v[q][j].y * v[q][j].y) + (v[q][j].z * v[q][j].z + v[q][j].w * v[q][j].w);
                o8[64 * j] = (unsigned long long)pk2(v[q][j].x, v[q][j].y) | ((unsigned long long)pk2(v[q][j].z, v[q][j].w) << 32); }
            const float t = wsum(sq[q]); if (lane_ == 0) *(f32x4*)((float*)(F.ws + WS_SSQX) + (size_t)m * 4) = (f32x4){t, 0.f, 0.f, 0.f}; }
    }
}
__device__ __forceinline__ float red8(float v) { v += __shfl_xor(v, 1); v += __shfl_xor(v, 2); v += __shfl_xor(v, 4); return v; }
__device__ __forceinline__ void un8(const v4u w, float (&f)[8]) { f[0] = bflo(w.x); f[1] = bfhi(w.x); f[2] = bflo(w.y); f[3] = bfhi(w.y); f[4] = bflo(w.z); f[5] = bfhi(w.z); f[6] = bflo(w.w); f[7] = bfhi(w.w); }
__device__ __forceinline__ void ldf8(const float* p, float (&f)[8]) { const f32x4 a = *(const f32x4*)p, b = *(const f32x4*)(p + 4); f[0] = a.x; f[1] = a.y; f[2] = a.z; f[3] = a.w; f[4] = b.x; f[5] = b.y; f[6] = b.z; f[7] = b.w; }
__device__ __forceinline__ void st8(bf16* p, const float (&f)[8]) { v4u w; w.x = att::cvtpk(f[0], f[1]); w.y = att::cvtpk(f[2], f[3]); w.z = att::cvtpk(f[4], f[5]); w.w = att::cvtpk(f[6], f[7]); *(v4u*)p = w; }
__device__ __forceinline__ float ss8(const float (&f)[8]) { return ((f[0] * f[0] + f[1] * f[1]) + (f[2] * f[2] + f[3] * f[3])) + ((f[4] * f[4] + f[5] * f[5]) + (f[6] * f[6] + f[7] * f[7])); }
__device__ __forceinline__ void rope8(float (&x)[8], const float (&c)[8], const float (&s)[8], bool first) {
#pragma unroll
    for (int j = 0; j < 8; ++j) { const float o = __shfl_xor(x[j], 2); x[j] = first ? x[j] * c[j] - o * s[j] : o * s[j] + x[j] * c[j]; }
}
__device__ __forceinline__ void compress_unit(const Frame F, int l, int u) {
    const int lane = opq_lane(), tid = F.wave * 64 + lane, w = F.wave, r32 = lane & 31, h = lane >> 5;
    const int g4 = u & 3, br = (u >> 2) & 1, b = u >> 3, n0 = 32 * g4, lb = l * 2 + br;
    LAS unsigned char* lds = (LAS unsigned char*)F.lds;
    LAS float* biasL = (LAS float*)lds; LAS float* part = (LAS float*)(lds + 1024); LAS float* ssl = (LAS float*)(lds + 1024 + 65536);
    const bf16* P = (const bf16*)(F.ws + WS_P);
    if (tid < 256) { const float* cb1 = (const float*)(F.ws + WS_CB1) + (size_t)lb * 16 * 256 + tid; float bs = 0.f;
        float t16[16];
#pragma unroll
        for (int ks = 0; ks < 16; ++ks) t16[ks] = cb1[ks * 256];
#pragma unroll
        for (int ks = 0; ks < 16; ++ks) bs += t16[ks];
        biasL[tid] = bs; }
    att::f32x16 acc = {};
    {
        const bf16* w1f = (const bf16*)(F.ws + WS_W1C) + (size_t)lb * 256 * 2048 + ((size_t)w * 128 * 64 + lane) * 8;
        const bf16* tkb = P + ((size_t)b * SEQ + 16 * n0) * NP + (br ? C_VC : C_KC);
        LAS unsigned char* tb = lds + 1024;
        v4u rg[4];
#define CMP_ISSUE(c) do { _Pragma("unroll") for (int i = 0; i < 4; ++i) { const int idx = tid + 512 * i, p8 = idx & 7, rid = idx >> 3, rr = rid & 31, tq = rid >> 5; \
            rg[i] = *(const v4u*)(tkb + (size_t)(16 * rr + 8 * (c) + tq) * NP + 8 * p8); } } while (0)
#define CMP_COMMIT(c) do { _Pragma("unroll") for (int i = 0; i < 4; ++i) { const int idx = tid + 512 * i, p8 = idx & 7, rid = idx >> 3, rr = rid & 31, tq = rid >> 5; \
            *(LAS v4u*)(tb + ((c) & 1) * 32768 + ((tq * 8 + p8) * 32 + rr) * 16) = rg[i]; } } while (0)
        CMP_ISSUE(0); CMP_COMMIT(0);
        __syncthreads();
        PHASE_END(21);
        for (int c = 0; c < 4; ++c) {
            if (c < 3) CMP_ISSUE(c + 1);
            const LAS unsigned char* cb = tb + (c & 1) * 32768 + r32 * 16;
#pragma unroll
            for (int s8 = 0; s8 < 4; ++s8) { bf16x8 af[8], bfr[8];
#pragma unroll
                for (int q = 0; q < 8; ++q) { const int sl = 8 * s8 + q; af[q] = *(const bf16x8*)(w1f + (size_t)(32 * c + sl) * 512); }
#pragma unroll
                for (int q = 0; q < 8; ++q) { const int sl = 8 * s8 + q; bfr[q] = *(const LAS bf16x8*)(cb + (((sl >> 2) * 8 + (sl & 3) * 2 + h) * 32) * 16); }
#pragma unroll
                for (int q = 0; q < 8; ++q) acc = MFMA32(af[q], bfr[q], acc); }
            if (c < 3) CMP_COMMIT(c + 1);
            __syncthreads();
        }
#undef CMP_ISSUE
#undef CMP_COMMIT
    }
    PHASE_END(22);
#pragma unroll
    for (int i = 0; i < 16; ++i) { const float x = acc[i] + biasL[32 * w + att::crow(i, h)]; acc[i] = x / (1.0f + __expf(-x)); }
    { att::f32x16 o0 = {}, o1 = {}; const float* w2 = ((const float*)F.a->in[I_CW2]) + (size_t)lb * 256 * 64;
#pragma unroll
      for (int s = 0; s < 2; ++s) { const bf16x8 bfr = att::packfrag(acc, s);
#pragma unroll
          for (int eb = 0; eb < 2; ++eb) { float a8[8];
#pragma unroll
              for (int j = 0; j < 8; ++j) a8[j] = w2[(size_t)(32 * w + 16 * s + 8 * (j >> 2) + 4 * h + (j & 3)) * 64 + 32 * eb + r32];
              v4u pw; pw.x = att::cvtpk(a8[0], a8[1]); pw.y = att::cvtpk(a8[2], a8[3]); pw.z = att::cvtpk(a8[4], a8[5]); pw.w = att::cvtpk(a8[6], a8[7]);
              const bf16x8 af = __builtin_bit_cast(bf16x8, pw);
              if (eb == 0) o0 = MFMA32(af, bfr, o0); else o1 = MFMA32(af, bfr, o1); } }
#pragma unroll
      for (int i = 0; i < 16; ++i) { part[(w * 64 + att::crow(i, h)) * 32 + r32] = o0[i]; part[(w * 64 + 32 + att::crow(i, h)) * 32 + r32] = o1[i]; } }
    __syncthreads();
    PHASE_END(23);
    { const int r = tid & 31, eg = tid >> 5; float o[4];
#pragma unroll
      for (int q = 0; q < 4; ++q) { float a = 0.f;
#pragma unroll
          for (int ww = 0; ww < 8; ++ww) a += part[(ww * 64 + 4 * eg + q) * 32 + r];
          o[q] = a; }
      if (br == 0) { ssl[eg * 32 + r] = (o[0] * o[0] + o[1] * o[1]) + (o[2] * o[2] + o[3] * o[3]);
          __syncthreads();
          float tot = 0.f;
#pragma unroll
          for (int e2 = 0; e2 < 16; ++e2) tot += ssl[e2 * 32 + r];
          const float rstd = 1.0f / sqrtf(tot * (1.f / 64.f) + EPS); const float* kn = ((const float*)F.a->in[I_NKN]) + l * 192 + 4 * eg;
#pragma unroll
          for (int q = 0; q < 4; ++q) o[q] *= rstd * kn[q]; }
      const int n = n0 + r; uint2 wv; wv.x = att::cvtpk(o[0], o[1]); wv.y = att::cvtpk(o[2], o[3]); if (n >= NCMP) { wv.x = 0u; wv.y = 0u; }
      *(uint2*)((bf16*)(F.ws + WS_KCV) + (size_t)br * 65536 + ((size_t)b * 128 + n) * 64 + 4 * eg) = wv; }
    __syncthreads();
}
__device__ __forceinline__ void convmix_unit(const Frame F, int l, int unit, int lane) {
    const bf16* P = (const bf16*)(F.ws + WS_P); bf16* Y = (bf16*)(F.ws + WS_Y);
    const float* cw = ((const float*)F.a->in[I_CONVW]) + l * 768; const float* cb = ((const float*)F.a->in[I_CONVB]) + l * 256; const float* onw = ((const float*)F.a->in[I_ONW]) + l * 1024;
    const int ts = lane >> 3, ch = lane & 7;
    {
        const int m = unit * 64 + F.wave * 8 + ts, t = m % SEQ; const bf16* pr = P + (size_t)m * NP;
        const float m1 = t >= 1 ? 1.f : 0.f, m2 = t >= 2 ? 1.f : 0.f; const bf16* p1 = pr - (t >= 1 ? NP : 0); const bf16* p2 = pr - (t >= 2 ? 2 * NP : 0);
        float y[4][8]; float ssy = 0.f;
#pragma unroll
        for (int sg = 0; sg < 4; ++sg) { const int col = 64 * sg + 8 * ch; v4u rv[7]; float w0[8], w1[8], w2[8], cbv[8];
            rv[0] = *(const v4u*)(pr + C_AC + col); rv[1] = *(const v4u*)(pr + C_AU + col); rv[2] = *(const v4u*)(p1 + C_AC + col); rv[3] = *(const v4u*)(p1 + C_AU + col);
            rv[4] = *(const v4u*)(p2 + C_AC + col); rv[5] = *(const v4u*)(p2 + C_AU + col); rv[6] = *(const v4u*)(pr + C_AB + col);
            ldf8(cw + col, w0); ldf8(cw + 256 + col, w1); ldf8(cw + 512 + col, w2); ldf8(cb + col, cbv);
            float u[8], v0[8], v1[8], v2[8];
            un8(rv[0], v0); un8(rv[1], u);
#pragma unroll
            for (int j = 0; j < 8; ++j) v0[j] *= u[j];
            un8(rv[2], v1); un8(rv[3], u);
#pragma unroll
            for (int j = 0; j < 8; ++j) v1[j] *= u[j] * m1;
            un8(rv[4], v2); un8(rv[5], u);
#pragma unroll
            for (int j = 0; j < 8; ++j) v2[j] *= u[j] * m2;
            un8(rv[6], u);
#pragma unroll
            for (int j = 0; j < 8; ++j) y[sg][j] = u[j] * (w0[j] * v2[j] + w1[j] * v1[j] + w2[j] * v0[j] + cbv[j]);
            ssy += ss8(y[sg]); }
        { const float rstd = 1.0f / sqrtf(red8(ssy) * (1.f / 256.f) + EPS); float go[4][8];
#pragma unroll
          for (int sg = 0; sg < 4; ++sg) ldf8(onw + 64 * sg + 8 * ch, go[sg]);
#pragma unroll
          for (int sg = 0; sg < 4; ++sg) {
#pragma unroll
              for (int j = 0; j < 8; ++j) y[sg][j] *= rstd * go[sg][j];
              st8(Y + (size_t)m * D + 64 * sg + 8 * ch, y[sg]); } }
    }
}
__device__ __forceinline__ void prep_phase(Frame F, int l) {
    OPQ_S(F.ws); OPQ_S(F.a); const int lane_ = opq_lane(), tid_ = F.wave * 64 + lane_;
    const int lane = lane_; const int gw = F.vcu * NWAVES + F.wave, NGW = F.G * NWAVES;
    const bf16* P = (const bf16*)(F.ws + WS_P);
    const float* mqn = ((const float*)F.a->in[I_MQN]) + l * 96; const float* mkn = ((const float*)F.a->in[I_MKN]) + l * 96;
    const float* nkn = ((const float*)F.a->in[I_NKN]) + l * 192;
    const float* cw = ((const float*)F.a->in[I_CONVW]) + l * 768; const float* cb = ((const float*)F.a->in[I_CONVB]) + l * 256; const float* onw = ((const float*)F.a->in[I_ONW]) + l * 1024;
    const float* cosT = (const float*)(F.ws + WS_ROPE); const float* sinT = cosT + SEQ * 16;
    GAS unsigned char* ob_ = (GAS unsigned char*)F.a->out; bf16* QM = (bf16*)(ob_ + OUT_QM); bf16* KM = (bf16*)(ob_ + OUT_KM); bf16* VM = (bf16*)(ob_ + OUT_VM);
    bf16* KSn = (bf16*)(F.ws + WS_KS); bf16* KWn = (bf16*)(F.ws + WS_KW); bf16* Y = (bf16*)(F.ws + WS_Y);
    const int ts = lane >> 3, ch = lane & 7; const bool ropelane = ch < 4, first = ch < 2;
    constexpr int LATP = 328;
    LAS unsigned char* ldsb = (LAS unsigned char*)F.lds; LAS bf16* latn = (LAS bf16*)ldsb;
    bf16* QKV = (bf16*)(F.ws + WS_QKV);
    for (int unit = F.vcu; unit < M / 64; unit += F.G) {
        const int m = unit * 64 + F.wave * 8 + ts, t = m % SEQ; const bf16* pr = P + (size_t)m * NP;
        float a[8];
        { v4u rl[5];
#pragma unroll
          for (int sg = 0; sg < 3; ++sg) rl[sg] = *(const v4u*)(pr + C_CQ + 64 * sg + 8 * ch);
#pragma unroll
          for (int sg = 0; sg < 2; ++sg) rl[3 + sg] = *(const v4u*)(pr + C_CKV + 64 * sg + 8 * ch);
          float ss = 0.f;
#pragma unroll
          for (int sg = 0; sg < 3; ++sg) { un8(rl[sg], a); ss += ss8(a); }
          const float rq = 1.0f / sqrtf(red8(ss) * (1.f / 192.f) + EPS); ss = 0.f;
#pragma unroll
          for (int sg = 0; sg < 2; ++sg) { un8(rl[3 + sg], a); ss += ss8(a); }
          const float rkv = 1.0f / sqrtf(red8(ss) * (1.f / 128.f) + EPS);
          LAS bf16* lrow = latn + (F.wave * 8 + ts) * LATP + 8 * ch;
#pragma unroll
          for (int sg = 0; sg < 5; ++sg) { un8(rl[sg], a); const float r_ = sg < 3 ? rq : rkv; v4u w;
              w.x = att::cvtpk(a[0] * r_, a[1] * r_); w.y = att::cvtpk(a[2] * r_, a[3] * r_); w.z = att::cvtpk(a[4] * r_, a[5] * r_); w.w = att::cvtpk(a[6] * r_, a[7] * r_);
              *(LAS v4u*)(lrow + 64 * sg) = w; } }
        __syncthreads();
        { const int r32 = lane & 31, h = lane >> 5;
          for (int jt = F.wave; jt < 28; jt += 8) {
              const bool isq = jt < 12;
              const bf16* wf = (isq ? (const bf16*)(F.ws + WS_WQF) + ((size_t)l * 144 + jt * 12) * 512 : (const bf16*)(F.ws + WS_WKVF) + ((size_t)l * 128 + (jt - 12) * 8) * 512) + lane * 8;
              const LAS bf16* lb = latn + r32 * LATP + (isq ? 0 : 192) + 8 * h;
              att::f32x16 c0 = {}, c1 = {};
              bf16x8 af[12];
#pragma unroll
              for (int sx = 0; sx < 12; ++sx) af[sx] = (sx < 8 || isq) ? *(const bf16x8*)(wf + (size_t)sx * 512) : af[0];
#pragma unroll
              for (int sx = 0; sx < 12; ++sx) { if (sx < 8 || isq) { const bf16x8 b0 = *(const LAS bf16x8*)(lb + 16 * sx), b1 = *(const LAS bf16x8*)(lb + 32 * LATP + 16 * sx);
                      c0 = MFMA32(af[sx], b0, c0); c1 = MFMA32(af[sx], b1, c1); } }
              bf16* q0 = QKV + (size_t)(unit * 64 + r32) * NQKV + 32 * jt + 4 * h; bf16* q1 = q0 + (size_t)32 * NQKV;
#pragma unroll
              for (int g4 = 0; g4 < 4; ++g4) { uint2 w0; w0.x = att::cvtpk(c0[4 * g4], c0[4 * g4 + 1]); w0.y = att::cvtpk(c0[4 * g4 + 2], c0[4 * g4 + 3]); *(uint2*)(q0 + 8 * g4) = w0;
                  uint2 w1; w1.x = att::cvtpk(c1[4 * g4], c1[4 * g4 + 1]); w1.y = att::cvtpk(c1[4 * g4 + 2], c1[4 * g4 + 3]); *(uint2*)(q1 + 8 * g4) = w1; } } }
        __syncthreads();
        const bf16* qk = QKV + (size_t)m * NQKV;
        v4u rkr, rh[2][4];
        rkr = *(const v4u*)(pr + C_KR + 8 * (ch & 3));
        float rc[8], rs[8]; ldf8(cosT + t * 16 + 8 * (ch & 1), rc); ldf8(sinT + t * 16 + 8 * (ch & 1), rs);
#define TOK_LOAD_HEADS(h0) do { _Pragma("unroll") for (int q_ = 0; q_ < 2; ++q_) { const int hh_ = (h0) + q_; rh[q_][0] = *(const v4u*)(qk + 96 * hh_ + 8 * ch); rh[q_][1] = *(const v4u*)(qk + 96 * hh_ + 64 + 8 * (ch & 3)); \
            rh[q_][2] = *(const v4u*)(qk + 384 + 128 * hh_ + 8 * ch); rh[q_][3] = *(const v4u*)(qk + 384 + 128 * hh_ + 64 + 8 * ch); } } while (0)
        TOK_LOAD_HEADS(0);
        float gqn[8], gqr[8], gkn[8], gkr[8]; ldf8(mqn + 8 * ch, gqn); ldf8(mqn + 64 + 8 * (ch & 3), gqr); ldf8(mkn + 8 * ch, gkn); ldf8(mkn + 64 + 8 * (ch & 3), gkr);
        float kr[8];
        un8(rkr, kr);
#pragma unroll
        for (int j = 0; j < 8; ++j) kr[j] = ropelane ? kr[j] : 0.f;
        rope8(kr, rc, rs, first);
        const float sskr = ss8(kr);
#pragma unroll
        for (int hh = 0; hh < 4; ++hh) {
            if (hh == 2) TOK_LOAD_HEADS(2);
            float qr[8];
            un8(rh[hh & 1][0], a); un8(rh[hh & 1][1], qr);
#pragma unroll
            for (int j = 0; j < 8; ++j) qr[j] = ropelane ? qr[j] : 0.f;
            rope8(qr, rc, rs, first);
            float rstd = 1.0f / sqrtf(red8(ss8(a) + ss8(qr)) * (1.f / 96.f) + EPS) * (0.10206207261596577f * LOG2E);
            bf16* qo = QM + ((size_t)m * 4 + hh) * 96;
#pragma unroll
            for (int j = 0; j < 8; ++j) { a[j] *= rstd * gqn[j]; qr[j] *= rstd * gqr[j]; }
            st8(qo + 8 * ch, a);
            if (ropelane) st8(qo + 64 + 8 * ch, qr);
            un8(rh[hh & 1][2], a);
            rstd = 1.0f / sqrtf(red8(ss8(a) + sskr) * (1.f / 96.f) + EPS);
            bf16* ko = KM + ((size_t)m * 4 + hh) * 96;
#pragma unroll
            for (int j = 0; j < 8; ++j) a[j] *= rstd * gkn[j];
            st8(ko + 8 * ch, a);
#pragma unroll
            for (int j = 0; j < 8; ++j) a[j] = kr[j] * rstd * gkr[j];
            if (ropelane) st8(ko + 64 + 8 * ch, a);
            *(v4u*)(VM + (size_t)m * 256 + 64 * hh + 8 * ch) = rh[hh & 1][3];
        }
        __syncthreads();
    }
    for (int task = gw; task < M / 8; task += NGW) {
        const int m = task * 8 + ts; const bf16* pr = P + (size_t)m * NP;
        float a[8];
        { v4u rks = *(const v4u*)(pr + C_KS + 8 * ch), rkw = *(const v4u*)(pr + C_KW + 8 * ch); float gks[8], gkw[8]; ldf8(nkn + 64 + 8 * ch, gks); ldf8(nkn + 128 + 8 * ch, gkw);
          un8(rks, a); float rstd = 1.0f / sqrtf(red8(ss8(a)) * (1.f / 64.f) + EPS);
#pragma unroll
          for (int j = 0; j < 8; ++j) a[j] *= rstd * gks[j];
          st8(KSn + (size_t)m * 64 + 8 * ch, a);
          un8(rkw, a); rstd = 1.0f / sqrtf(red8(ss8(a)) * (1.f / 64.f) + EPS);
#pragma unroll
          for (int j = 0; j < 8; ++j) a[j] *= rstd * gkw[j];
          st8(KWn + (size_t)m * 64 + 8 * ch, a); }
    }
#undef TOK_LOAD_HEADS
    __syncthreads();
    PHASE_END(20);
    for (int rep_ = 0; rep_ < (PROBE_DUP == 3 ? 2 : 1); ++rep_)
    for (int u = F.vcu; u < BATCH * 2 * 4; u += F.G) compress_unit(F, l, u);
}

constexpr int ATT_UNITS = 768, ATT_FILL_POS = 400;
__device__ const unsigned short ATT_ORDER[768] = {4127,4159,4191,4223,4255,4287,4319,4351,4126,4158,4190,4222,4254,4286,4318,4350,4125,4157,4189,4221,4253,4285,4317,4349,4124,4156,4188,4220,4252,4284,4316,4348,4123,4155,4187,4219,4251,4283,4315,4347,4122,4154,4186,4218,4250,4282,4314,4346,4121,4153,4185,4217,4249,4281,4313,4345,4120,4152,4184,4216,4248,4280,4312,4344,4119,4151,4183,4215,4247,4279,4311,4343,4118,4150,4182,4214,4246,4278,4310,4342,4117,4149,4181,4213,4245,4277,4309,4341,4116,4148,4180,4212,4244,4276,4308,4340,4115,4147,4179,4211,4243,4275,4307,4339,4114,4146,4178,4210,4242,4274,4306,4338,4113,4145,4177,4209,4241,4273,4305,4337,4112,4144,4176,4208,4240,4272,4304,4336,4111,4143,4175,4207,4239,4271,4303,4335,4110,4142,4174,4206,4238,4270,4302,4334,4109,4141,4173,4205,4237,4269,4301,4333,4108,4140,4172,4204,4236,4268,4300,4332,7,15,23,31,39,47,55,63,71,79,87,95,103,111,119,127,135,143,151,159,167,175,183,191,199,207,215,223,231,239,247,255,4107,4139,4171,4203,4235,4267,4299,4331,4106,4138,4170,4202,4234,4266,4298,4330,4105,4137,4169,4201,4233,4265,4297,4329,6,14,22,30,38,46,54,62,70,78,86,94,102,110,118,126,134,142,150,158,166,174,182,190,198,206,214,222,230,238,246,254,4104,4136,4168,4200,4232,4264,4296,4328,4103,4135,4167,4199,4231,4263,4295,4327,5,13,21,29,37,45,53,61,69,77,85,93,101,109,117,125,133,141,149,157,165,173,181,189,197,205,213,221,229,237,245,253,4102,4134,4166,4198,4230,4262,4294,4326,4101,4133,4165,4197,4229,4261,4293,4325,4,12,20,28,36,44,52,60,68,76,84,92,100,108,116,124,132,140,148,156,164,172,180,188,196,204,212,220,228,236,244,252,4100,4132,4164,4196,4228,4260,4292,4324,3,11,19,27,35,43,51,59,67,75,83,91,99,107,115,123,131,139,147,155,163,171,179,187,195,203,211,219,227,235,243,251,4099,4131,4163,4195,4227,4259,4291,4323,4098,4130,4162,4194,4226,4258,4290,4322,2,10,18,26,34,42,50,58,66,74,82,90,98,106,114,122,130,138,146,154,162,170,178,186,194,202,210,218,226,234,242,250,4097,4129,4161,4193,4225,4257,4289,4321,8199,8207,8215,8223,8231,8239,8247,8255,8263,8271,8279,8287,8295,8303,8311,8319,8327,8335,8343,8351,8359,8367,8375,8383,8391,8399,8407,8415,8423,8431,8439,8447,8198,8206,8214,8222,8230,8238,8246,8254,8262,8270,8278,8286,8294,8302,8310,8318,8326,8334,8342,8350,8358,8366,8374,8382,8390,8398,8406,8414,8422,8430,8438,8446,8197,8205,8213,8221,8229,8237,8245,8253,8261,8269,8277,8285,8293,8301,8309,8317,8325,8333,8341,8349,8357,8365,8373,8381,8389,8397,8405,8413,8421,8429,8437,8445,8196,8204,8212,8220,8228,8236,8244,8252,8260,8268,8276,8284,8292,8300,8308,8316,8324,8332,8340,8348,8356,8364,8372,8380,8388,8396,8404,8412,8420,8428,8436,8444,8195,8203,8211,8219,8227,8235,8243,8251,8259,8267,8275,8283,8291,8299,8307,8315,8323,8331,8339,8347,8355,8363,8371,8379,8387,8395,8403,8411,8419,8427,8435,8443,8194,8202,8210,8218,8226,8234,8242,8250,8258,8266,8274,8282,8290,8298,8306,8314,8322,8330,8338,8346,8354,8362,8370,8378,8386,8394,8402,8410,8418,8426,8434,8442,8193,8201,8209,8217,8225,8233,8241,8249,8257,8265,8273,8281,8289,8297,8305,8313,8321,8329,8337,8345,8353,8361,8369,8377,8385,8393,8401,8409,8417,8425,8433,8441,1,9,17,25,33,41,49,57,65,73,81,89,97,105,113,121,129,137,145,153,161,169,177,185,193,201,209,217,225,233,241,249,4096,4128,4160,4192,4224,4256,4288,4320,8192,8200,8208,8216,8224,8232,8240,8248,8256,8264,8272,8280,8288,8296,8304,8312,8320,8328,8336,8344,8352,8360,8368,8376,8384,8392,8400,8408,8416,8424,8432,8440,0,8,16,24,32,40,48,56,64,72,80,88,96,104,112,120,128,136,144,152,160,168,176,184,192,200,208,216,224,232,240,248};

__device__ __forceinline__ void attn_phase(Frame F, int l, int qslot_i = 0) {
    OPQ_S(F.ws); OPQ_S(F.a); const int lane_ = opq_lane(), tid_ = F.wave * 64 + lane_;
    LAS unsigned char* lds = (LAS unsigned char*)F.lds;
    LAS float* tb2 = (LAS float*)(lds + TBH_OFF); LAS float* gwT = (LAS float*)(lds + GWT_OFF);
    LAS unsigned* qslot = (LAS unsigned*)(lds + MISC_OFF) + 16;
    LAS unsigned* sbflags = (LAS unsigned*)(lds + att::NSA_END);
    for (int i = tid_; i < 1024; i += NWAVES * 64) { const int hd_ = i >> 8, d_ = (i & 255) - 64;
        tb2[i] = d_ < 0 ? -INFINITY : ((const float*)(F.ws + WS_TB))[(d_ > 127 ? 127 : d_) * 4 + hd_]; }
    if (tid_ < 256) gwT[tid_] = ((const float*)F.a->in[I_ONW])[l * 1024 + 256 + tid_];
    const bf16* P = (const bf16*)(F.ws + WS_P);
    const GAS unsigned char* ob_ = (const GAS unsigned char*)F.a->out; const bf16* QM = (const bf16*)(ob_ + OUT_QM); const bf16* KM = (const bf16*)(ob_ + OUT_KM); const bf16* VM = (const bf16*)(ob_ + OUT_VM);
    const float* nqn = ((const float*)F.a->in[I_NQN]) + l * 64; const bf16* KSn = (const bf16*)(F.ws + WS_KS); const bf16* KWn = (const bf16*)(F.ws + WS_KW);
    const bf16* KC = (const bf16*)(F.ws + WS_KCV); const bf16* VC = KC + 65536;
    bf16* Y = (bf16*)(F.ws + WS_Y); float* SSQ = (float*)(F.ws + WS_SSQ); const float* onw = ((const float*)F.a->in[I_ONW]) + l * 1024;
    unsigned* qhead = (unsigned*)(F.ws + WS_CTL) + CW_QUEUE + 64 * (l + 2 * qslot_i);
    PHASE_END(27);
    const int nfill = (l == 0) ? CV_UNITS : 0;
    if (F.wave >= 4) __builtin_amdgcn_s_setprio(1);
    for (;;) {
        const int tid = F.wave * 64 + opq_lane();
        __syncthreads();
        if (tid == 0) qslot[0] = __hip_atomic_fetch_add(qhead, 1u, __ATOMIC_RELAXED, __HIP_MEMORY_SCOPE_AGENT);
        __syncthreads();
        int u = __builtin_amdgcn_readfirstlane((int)qslot[0]);
        if (u >= ATT_UNITS + nfill + M / 64) break;
        if (u >= ATT_UNITS + nfill) { convmix_unit(F, l, u - ATT_UNITS - nfill, opq_lane()); PHASE_END(28); continue; }
        if (u >= ATT_FILL_POS && u < ATT_FILL_POS + nfill) {
            __syncthreads(); if (tid == 0) qslot[2] = __hip_atomic_fetch_add((unsigned*)(F.ws + WS_CTL) + CW_FILL, 1u, __ATOMIC_RELAXED, __HIP_MEMORY_SCOPE_AGENT); __syncthreads();
            const int fu = __builtin_amdgcn_readfirstlane((int)qslot[2]); if (fu < CV_UNITS) { conv_unit(F, fu, opq_lane()); PHASE_END(28); }
            continue; }
        if (u >= ATT_FILL_POS) u -= nfill;
        const int code = __builtin_amdgcn_readfirstlane((int)ATT_ORDER[u]), ty = code >> 12, bb = (code >> 5) & 7;
#ifndef PROBE_DUPU
#define PROBE_DUPU 0
#endif
#ifndef PROBE_SKIP
#define PROBE_SKIP 0
#endif
        if (ty == 0) { att::mla_ring_unit(bb, (code >> 3) & 3, code & 7, QM, KM, VM, Y, SSQ, lds, tid); if (PROBE_DUPU & 1) { __syncthreads(); att::mla_ring_unit(bb, (code >> 3) & 3, code & 7, QM, KM, VM, Y, SSQ, lds, F.wave * 64 + opq_lane()); } PHASE_END(24); }
        else if (ty == 1) { _Pragma("unroll 1") for (int rep_ = 0; rep_ < ((PROBE_DUPU & 2) ? 2 : 1); ++rep_) { att::nsa_unit(bb, code & 31, P, nqn, KSn, KWn, KC, VC, gwT, Y, lds, tb2, (PROBE_DUPU & 2) ? F.wave * 64 + opq_lane() : tid, (PROBE_DUPU & 2) ? (rep_ == 0 ? PROBE_SKIP : 0) : 0); } if (u < 8 && l == 1) PHASE_MAXG(29, F.ws); else PHASE_END(25); }
        else { _Pragma("unroll 1") for (int rep_ = 0; rep_ < ((PROBE_DUPU & 4) ? 2 : 1); ++rep_) { att::sb_unit(bb, (code >> 3) & 3, code & 7, P, Y, SSQ, lds, sbflags, (PROBE_DUPU & 4) ? F.wave * 64 + opq_lane() : tid); if (PROBE_DUPU & 4) __syncthreads(); } PHASE_END(26); }
    }
    __builtin_amdgcn_s_setprio(0);
}
#ifndef PROBE_DUP
#define PROBE_DUP -1
#endif
#define IN(k) (lo <= (k) && (k) < hi)
#define SEAM() do { if (MK_ONE_LAUNCH) { XcdBarrier b2_ = bar; OPQ_S(b2_.bar); xcd_barrier(b2_, F.wave == 0 && opq_lane() == 0); } } while (0)
__device__ __forceinline__ void layer_body(const Args& args, const Frame F, const XcdBarrier& bar, LAS unsigned char* ldsl, const int lo, const int hi, const int l) {
        const int pb = 1 + 6 * l;
        if (IN(pb + 0)) {
            GAS unsigned char* ws = (GAS unsigned char*)args.ws; OPQ_S(ws);
            pg8::Gemm g{(const bf16*)(ws + WS_XB), (const bf16*)(ws + WS_WIN) + (size_t)l * NP * D, M, NP, D}; pg8::StaticOrder S; S.init(M, NP, F.G, (int)blockIdx.x);
            { LAS float* rsT_ = (LAS float*)(ldsl + RST_OFF); const int t_ = F.wave * 64 + opq_lane(); const float* sq_ = (const float*)(ws + WS_SSQX);
              if (t_ < 256) {
#pragma unroll 1
                  for (int i_ = 0; i_ < 4; ++i_) { pg8::Unit uu_; if (!S.next(i_, uu_)) break; const f32x4 q_ = *(const f32x4*)(sq_ + ((size_t)uu_.pm * 256 + t_) * 4);
                      rsT_[i_ * 256 + t_] = 1.0f / sqrtf(((q_[0] + q_[1]) + (q_[2] + q_[3])) * (1.f / 1024.f) + EPS); } }
              __syncthreads(); }
            pg8::EpiBf16S<0> E{(bf16*)(ws + WS_P), NP, (const LAS float*)(ldsl + RST_OFF)};
            pg8::gemm_phase<pg8::EpiBf16S<0>, pg8::StaticOrder, PG8_ALIGN, PG8_SP2>(ldsl + RING_OFF, g, S, E, F.wave);
            if (l == 0) { pg8::Unit tmp_; if (!S.next(2, tmp_)) {
                LAS unsigned* qs_ = (LAS unsigned*)(ldsl + MISC_OFF) + 16;
                if (F.wave == 0 && opq_lane() == 0) qs_[0] = __hip_atomic_fetch_add((unsigned*)(ws + WS_CTL) + CW_FILL, 1u, __ATOMIC_RELAXED, __HIP_MEMORY_SCOPE_AGENT);
                __syncthreads();
                const int fu = __builtin_amdgcn_readfirstlane((int)qs_[0]);
                if (fu < CV_UNITS) conv_unit(F, fu, opq_lane()); } }
            SEAM(); PHASE_END(pb + 0); }
        if (IN(pb + 1)) { prep_phase(F, l); SEAM(); if (PROBE_DUP == 1) { prep_phase(F, l); SEAM(); } PHASE_END(pb + 1); }
        if (IN(pb + 2)) { attn_phase(F, l); SEAM(); if (PROBE_DUP == 2) { attn_phase(F, l, 1); SEAM(); } PHASE_END(pb + 2); }
        if (IN(pb + 3)) {
            GAS unsigned char* ws = (GAS unsigned char*)args.ws; OPQ_S(ws);
            pg8::Gemm g{(const bf16*)(ws + WS_Y), (const bf16*)(ws + WS_WO) + (size_t)l * D * D, M, D, D}; pg8::StaticOrder S; S.init(M, D, F.G, (int)blockIdx.x);
            { LAS float* ks_ = (LAS float*)(ldsl + RST_OFF); const int t_ = F.wave * 64 + opq_lane(); pg8::Unit uu_;
              if (t_ < 256 && S.next(0, uu_)) { const float* sq_ = (const float*)(ws + WS_SSQ) + ((size_t)uu_.pm * 256 + t_) * 8; const f32x4 a_ = *(const f32x4*)sq_, b_ = *(const f32x4*)(sq_ + 4);
                  const float v2_ = ((a_[0] + a_[1]) + (a_[2] + a_[3])) * (1.f / 256.f) + EPS, v3_ = ((b_[0] + b_[1]) + (b_[2] + b_[3])) * (1.f / 256.f) + EPS;
                  const float r2_ = 1.0f / sqrtf(v2_), r3_ = 1.0f / sqrtf(v3_);
                  ks_[t_] = sqrtf(v2_); ks_[256 + t_] = r2_ * sqrtf(v3_); ks_[512 + t_] = r3_; }
              __syncthreads(); }
            pg8::EpiResNorm<false, true> E{nullptr, (bf16*)(ws + WS_XB), (float*)(ws + WS_SSQX), D, (const LAS float*)(ldsl + RST_OFF)};
            pg8::gemm_phase<pg8::EpiResNorm<false, true>, pg8::StaticOrder, false, PG8_SP2>(ldsl + RING_OFF, g, S, E, F.wave);
            SEAM(); PHASE_END(pb + 3); }
        if (IN(pb + 4)) {
            GAS unsigned char* ws = (GAS unsigned char*)args.ws; OPQ_S(ws);
            pg8::Gemm g{(const bf16*)(ws + WS_XB), (const bf16*)(ws + WS_W1) + (size_t)l * FF * D, M, FF, D}; pg8::StaticOrder S; S.init(M, FF, F.G, (int)blockIdx.x);
            { LAS float* rsT_ = (LAS float*)(ldsl + RST_OFF); const int t_ = F.wave * 64 + opq_lane(); const float* sq_ = (const float*)(ws + WS_SSQX);
              if (t_ < 256) {
#pragma unroll 1
                  for (int i_ = 0; i_ < 4; ++i_) { pg8::Unit uu_; if (!S.next(i_, uu_)) break; const f32x4 q_ = *(const f32x4*)(sq_ + ((size_t)uu_.pm * 256 + t_) * 4);
                      rsT_[i_ * 256 + t_] = 1.0f / sqrtf(((q_[0] + q_[1]) + (q_[2] + q_[3])) * (1.f / 1024.f) + EPS); } }
              __syncthreads(); }
            pg8::EpiBf16S<2> E{(bf16*)(ws + WS_H), FF, (const LAS float*)(ldsl + RST_OFF)};
            pg8::gemm_phase<pg8::EpiBf16S<2>, pg8::StaticOrder, PG8_ALIGN, PG8_SP2>(ldsl + RING_OFF, g, S, E, F.wave);
            SEAM(); PHASE_END(pb + 4); }
        if (IN(pb + 5)) {
            GAS unsigned char* ws = (GAS unsigned char*)args.ws; OPQ_S(ws);
            pg8::Gemm g{(const bf16*)(ws + WS_H), (const bf16*)(ws + WS_W2) + (size_t)l * D * FF, M, D, FF}; pg8::StaticOrder S; S.init(M, D, F.G, (int)blockIdx.x);
            if (l + 1 < DEPTH) { pg8::EpiResNorm<false> E{nullptr, (bf16*)(ws + WS_XB), (float*)(ws + WS_SSQX), D, nullptr};
                pg8::gemm_phase<pg8::EpiResNorm<false>, pg8::StaticOrder, false, PG8_SP2>(ldsl + RING_OFF, g, S, E, F.wave); SEAM(); PHASE_END(pb + 5); }
            else { pg8::EpiResNorm<true> E{args.out, (bf16*)(ws + WS_XB), nullptr, D, nullptr};
                pg8::gemm_phase<pg8::EpiResNorm<true>, pg8::StaticOrder, false, PG8_SP2>(ldsl + RING_OFF, g, S, E, F.wave); __syncthreads(); PHASE_END(pb + 5); } }
    }
constexpr int NPH = 1 + DEPTH * 6;
__global__ void __launch_bounds__(NWAVES * 64, 2) __attribute__((amdgpu_waves_per_eu(2, 2))) fwd(Args args) {
    extern __shared__ __attribute__((aligned(16))) unsigned char lds[];
    Frame F;
    F.lds = lds; F.wave = __builtin_amdgcn_readfirstlane((int)(threadIdx.x >> 6));
    F.G = gridDim.x; { const int bx = blockIdx.x; F.vcu = (F.G % 8 == 0) ? (bx % 8) * (F.G / 8) + bx / 8 : bx; }
    F.a = (ArgsP)__builtin_amdgcn_kernarg_segment_ptr(); F.ws = (GAS unsigned char*)args.ws;
    for (int u = threadIdx.x; u < (LDS_BYTES - LDSCTL_OFF) / 4; u += NWAVES * 64) ((unsigned*)(lds + LDSCTL_OFF))[u] = 0u;
    __syncthreads();
    XcdBarrier bar; bar.bar = (unsigned*)(args.ws + WS_CTL) + 1024; bar.x = 0; bar.st = nullptr;
    if (MK_ONE_LAUNCH) bar = xcd_barrier_post((unsigned*)(args.ws + WS_CTL) + 1024, (volatile LAS unsigned*)(lds + MISC_OFF) + 8);
    const int lo = args.ph_lo, hi = args.ph_hi;
    LAS unsigned char* ldsl = (LAS unsigned char*)lds;
#ifndef PROBE_DUP
#define PROBE_DUP -1
#endif
    if (PROBE_TIME_MASK != 0u) { if (threadIdx.x == 0) { volatile LAS unsigned long long* T_ = (volatile LAS unsigned long long*)((LAS unsigned char*)lds + MISC_OFF + 128); T_[0] = __builtin_amdgcn_s_memrealtime(); T_[1] = 0ull; T_[2] = __builtin_amdgcn_s_memtime(); T_[3] = 0ull; } }
    if (PROBE_CLK_BIT >= 0 && PROBE_TIME_MASK == 0u) { if (threadIdx.x == 0) { volatile LAS unsigned long long* T_ = (volatile LAS unsigned long long*)((LAS unsigned char*)lds + MISC_OFF + 128); T_[0] = 0ull; T_[1] = 0ull; T_[2] = __builtin_amdgcn_s_memtime(); T_[3] = 0ull; } }
    if (IN(0)) { p0_prologue(F); SEAM(); if (PROBE_DUP == 0) { p0_prologue(F); SEAM(); } PHASE_END(0); }
    for (int l = 0; l < DEPTH; ++l) layer_body(args, F, bar, ldsl, lo, hi, l);
    if (PROBE_TIME_MASK != 0u || PROBE_CLK_BIT >= 0) { if (blockIdx.x == 0 && F.wave == 0 && opq_lane() == 0) { volatile LAS unsigned long long* T_ = (volatile LAS unsigned long long*)((LAS unsigned char*)lds + MISC_OFF + 128); const unsigned long long w_ = 8ull * (T_[1] + (unsigned long long)__hip_atomic_load((unsigned*)(args.ws + WS_CTL) + 9000, __ATOMIC_RELAXED, __HIP_MEMORY_SCOPE_AGENT)) + (PROBE_CLK_BIT >= 0 ? T_[3] / 16ull : 0ull); const unsigned long long t0_ = __builtin_amdgcn_s_memrealtime(); while (__builtin_amdgcn_s_memrealtime() - t0_ < w_) __builtin_amdgcn_s_sleep(8); } }
#undef IN
#undef SEAM
}

extern "C" void kernel_launch(void* const* d_in, const int* in_sizes, int n_in, void* d_out, int out_size, void* d_ws, size_t ws_size, hipStream_t stream) {
    static int grid = 0;
    if (grid == 0) {
        if (n_in != N_INPUTS || in_sizes[0] != M * D || out_size != M * D || ws_size < WS_END) { fprintf(stderr, "kernel_launch: unexpected shapes (n_in %d, in0 %d, out %d, ws %zu); nothing launched\n", n_in, n_in > 0 ? in_sizes[0] : -1, out_size, ws_size); grid = -1; return; }
        int dev = 0, cus = 0, per_cu = 0;
        if (hipGetDevice(&dev) != hipSuccess || hipDeviceGetAttribute(&cus, hipDeviceAttributeMultiprocessorCount, dev) != hipSuccess) { grid = -1; return; }
        if (hipFuncSetAttribute((const void*)fwd, hipFuncAttributeMaxDynamicSharedMemorySize, LDS_BYTES) != hipSuccess) { fprintf(stderr, "kernel_launch: hipFuncSetAttribute failed\n"); grid = -1; return; }
        if (hipOccupancyMaxActiveBlocksPerMultiprocessor(&per_cu, (const void*)fwd, NWAVES * 64, LDS_BYTES) != hipSuccess || per_cu < 1) { fprintf(stderr, "kernel_launch: occupancy query reports %d\n", per_cu); }
        (void)hipGetLastError();
        grid = cus;
        if (grid != 256) { fprintf(stderr, "kernel_launch: built for 256 CUs (one 256x256 unit per workgroup in the N = 1024 GEMM phases), found %d; nothing launched\n", cus); grid = -1; return; }
    }
    if (grid < 0) return;
    if (hipMemsetAsync((char*)d_ws + WS_CTL, 0, CTL_ZERO_BYTES, stream) != hipSuccess) return;
    Args a{};
    for (int i = 0; i < N_INPUTS; ++i) a.in[i] = (const float*)d_in[i];
    a.out = (float*)d_out; a.ws = (unsigned char*)d_ws;
#if MK_ONE_LAUNCH
    a.ph_lo = 0; a.ph_hi = NPH;
    hipLaunchKernelGGL(fwd, dim3(grid), dim3(NWAVES * 64), LDS_BYTES, stream, a);
#else
    for (int p = 0; p < NPH; ++p) { a.ph_lo = p; a.ph_hi = p + 1; hipLaunchKernelGGL(fwd, dim3(grid), dim3(NWAVES * 64), LDS_BYTES, stream, a); }
#endif
}
```
